# Optimizing an MI355X kernel written in HIP

```python
import jax, jax.numpy as jnp
from jax import lax
import numpy as np

D_MODEL = 1024
BATCH = 4
SEQ = 4096
DEPTH = 2

GLA_HEADS = 4
GLA_KEY = D_MODEL // 4
GLA_VAL = D_MODEL // 2
GLA_DK = GLA_KEY // GLA_HEADS
GLA_DV = GLA_VAL // GLA_HEADS
GLA_RANK = 16
GLA_TAU = 16.0
GLA_CHUNK = 64
SGU_GROUPS = 4
SGU_WIDTH = D_MODEL // 4
SGU_GD = SGU_WIDTH // SGU_GROUPS
SGU_CHUNK = 128
POOL_WINDOWS = (2, 4, 8, 16)
POOL_WIDTH = D_MODEL // 4
POOL_GD = POOL_WIDTH // len(POOL_WINDOWS)
N_BRANCH = 3
IN_SIZES = (GLA_KEY, GLA_KEY, GLA_VAL, GLA_VAL, GLA_RANK, 2 * SGU_WIDTH, POOL_WIDTH, N_BRANCH * D_MODEL)
IN_SPLITS = tuple(sum(IN_SIZES[:i + 1]) for i in range(len(IN_SIZES) - 1))
N_IN = sum(IN_SIZES)
MEM_LEN = 256
XA_HEADS = 4
XA_DH = D_MODEL // XA_HEADS
N_EXPERTS = 32
TOP_K = 4
EXPERT_FF = D_MODEL
SWIGLU_LIMIT = 7.0
SWIGLU_ALPHA = 1.702
MOE_BLOCK = 128
DEEPNORM_ALPHA = (2 * DEPTH) ** 0.25
DEEPNORM_BETA = (8 * DEPTH) ** -0.25
LN_EPS = 1e-5

kernel_name = 'hybrid_gla_sgu_pool_moe_block'


def layer_norm(x, g, b):
    xf = x.astype(jnp.float32)
    mu = xf.mean(-1, keepdims=True)
    var = jnp.square(xf - mu).mean(-1, keepdims=True)
    return ((xf - mu) * lax.rsqrt(var + LN_EPS) * g + b).astype(x.dtype)


def rms_norm(x, g):
    xf = x.astype(jnp.float32)
    return xf * lax.rsqrt(jnp.square(xf).mean(-1, keepdims=True) + LN_EPS) * g


def gla_chunked(q, k, v, log_a):
    B, S, H, dk = q.shape
    dv = v.shape[-1]
    C = GLA_CHUNK
    N = S // C
    f32 = jnp.float32
    q = q.astype(f32).reshape(B, N, C, H, dk) * (dk ** -0.5)
    k = k.astype(f32).reshape(B, N, C, H, dk)
    v = v.astype(f32).reshape(B, N, C, H, dv)
    b = jnp.cumsum(log_a.astype(f32).reshape(B, N, C, H, dk), axis=2)
    b_last = b[:, :, -1:]
    q_dec = q * jnp.exp(b)
    k_dec = k * jnp.exp(-b)
    k_tail = k * jnp.exp(b_last - b)
    causal = jnp.tril(jnp.ones((C, C), bool))
    scores = jnp.einsum('bnthd,bnshd->bnhts', q_dec, k_dec)
    scores = jnp.where(causal, scores, 0.0)
    o_intra = jnp.einsum('bnhts,bnshe->bnthe', scores, v)
    chunk_kv = jnp.einsum('bnshd,bnshe->nbhde', k_tail, v)
    chunk_decay = jnp.exp(jnp.moveaxis(b_last[:, :, 0], 1, 0))

    def step(state, inp):
        dec, kv = inp
        return dec[..., None] * state + kv, state

    _, s_in = lax.scan(step, jnp.zeros((B, H, dk, dv), f32), (chunk_decay, chunk_kv))
    o_inter = jnp.einsum('bnthd,nbhde->bnthe', q_dec, s_in)
    return (o_intra + o_inter).reshape(B, S, H, dv)


def spatial_gating(uv_pre, ln_g, ln_b, ws, bs):
    B, S, _ = uv_pre.shape
    z = jax.nn.gelu(uv_pre, approximate=False)
    u, v = jnp.split(z, 2, axis=-1)
    v = layer_norm(v, ln_g, ln_b)
    N = S // SGU_CHUNK
    v = v.reshape(B, N, SGU_CHUNK, SGU_GROUPS, SGU_GD)
    ws_causal = jnp.tril(ws)
    s = jnp.einsum('gts,bnsgd->bntgd', ws_causal, v) + bs.T[:, :, None]
    return u * s.reshape(B, S, SGU_WIDTH)


def pool_mixer(xc, pool_w, pool_scale):
    B, S, _ = xc.shape
    G = len(POOL_WINDOWS)
    xg = xc.astype(jnp.float32).reshape(B, S, G, POOL_GD)
    csum = jnp.cumsum(xg, axis=1)
    t = jnp.arange(S)
    pooled = []
    for i, w in enumerate(POOL_WINDOWS):
        c_i = csum[:, :, i]
        c_prev = jnp.pad(c_i, ((0, 0), (w, 0), (0, 0)))[:, :S]
        count = jnp.minimum(t + 1, w).astype(jnp.float32)[None, :, None]
        pooled.append((c_i - c_prev) / count)
    y = jnp.stack(pooled, axis=2) - xg
    y = jnp.einsum('bsgc,gcd->bsgd', y, pool_w.astype(jnp.float32))
    return (y.reshape(B, S, POOL_WIDTH) * pool_scale).astype(xc.dtype)


def hybrid_mixer(x, w_in, b_in, gla_wg2, gla_bg, gla_norm_g, sgu_ln_g, sgu_ln_b, sgu_ws, sgu_bs,
                 pool_w, pool_scale, w_up_a, w_up_b, w_up_c, w_o):
    B, S, D = x.shape
    p = x @ w_in + b_in
    q, k, v, r, g_low, uv, xc, gate_pre = jnp.split(p, IN_SPLITS, axis=-1)
    log_a = jax.nn.log_sigmoid((g_low @ gla_wg2 + gla_bg).astype(jnp.float32)) / GLA_TAU
    o = gla_chunked(q.reshape(B, S, GLA_HEADS, GLA_DK), k.reshape(B, S, GLA_HEADS, GLA_DK),
                    v.reshape(B, S, GLA_HEADS, GLA_DV), log_a.reshape(B, S, GLA_HEADS, GLA_DK))
    o = rms_norm(o, gla_norm_g.reshape(GLA_HEADS, GLA_DV))
    y_a = o.reshape(B, S, GLA_VAL).astype(x.dtype) * jax.nn.silu(r)
    y_b = spatial_gating(uv, sgu_ln_g, sgu_ln_b, sgu_ws, sgu_bs)
    y_c = pool_mixer(xc, pool_w, pool_scale)
    gates = jax.nn.sigmoid(gate_pre.reshape(B, S, N_BRANCH, D))
    merged = (gates[:, :, 0] * (y_a @ w_up_a) + gates[:, :, 1] * (y_b @ w_up_b)
              + gates[:, :, 2] * (y_c @ w_up_c))
    return merged @ w_o


def memory_cross_attention(x, mem, wq, wk, wv, wo):
    B, S, D = x.shape
    M = mem.shape[1]
    q = (x @ wq).reshape(B, S, XA_HEADS, XA_DH)
    k = (mem @ wk).reshape(B, M, XA_HEADS, XA_DH)
    v = (mem @ wv).reshape(B, M, XA_HEADS, XA_DH)
    s = jnp.einsum('bshd,bmhd->bhsm', q, k).astype(jnp.float32) * (XA_DH ** -0.5)
    p = jax.nn.softmax(s, axis=-1).astype(v.dtype)
    o = jnp.einsum('bhsm,bmhd->bshd', p, v).reshape(B, S, D)
    return o @ wo


def moe_ffn(x, router_w, router_b, w_gu, b_gu, w_down, b_down):
    B, S, D = x.shape
    x2 = x.reshape(-1, D)
    N = x2.shape[0]
    logits = (x2 @ router_w).astype(jnp.float32) + router_b
    top_vals, top_idx = lax.top_k(logits, TOP_K)
    gate = jax.nn.softmax(top_vals, axis=-1)
    A = N * TOP_K
    flat_e = top_idx.reshape(-1)
    flat_tok = jnp.repeat(jnp.arange(N, dtype=jnp.int32), TOP_K)
    flat_g = gate.reshape(-1)
    order = jnp.argsort(flat_e)
    se, st, sg = flat_e[order], flat_tok[order], flat_g[order]
    counts = jnp.bincount(flat_e, length=N_EXPERTS)
    padded = ((counts + MOE_BLOCK - 1) // MOE_BLOCK) * MOE_BLOCK
    pad_end = jnp.cumsum(padded)
    pad_start = pad_end - padded
    start = jnp.cumsum(counts) - counts
    dest = pad_start[se] + (jnp.arange(A) - start[se])
    n_blocks = -(-A // MOE_BLOCK) + N_EXPERTS
    slot_tok = jnp.zeros((n_blocks * MOE_BLOCK,), jnp.int32).at[dest].set(st)
    slot_gate = jnp.zeros((n_blocks * MOE_BLOCK,), jnp.float32).at[dest].set(sg)
    block_expert = jnp.minimum(jnp.searchsorted(pad_end, jnp.arange(n_blocks) * MOE_BLOCK, side='right'),
                               N_EXPERTS - 1)

    def expert_block(args):
        e, tok, g = args
        h = x2[tok] @ w_gu[e] + b_gu[e]
        h_glu = jnp.minimum(h[:, :EXPERT_FF], SWIGLU_LIMIT)
        h_lin = jnp.clip(h[:, EXPERT_FF:], -SWIGLU_LIMIT, SWIGLU_LIMIT)
        a = h_glu * jax.nn.sigmoid(SWIGLU_ALPHA * h_glu) * (h_lin + 1.0)
        out = a @ w_down[e] + b_down[e]
        return out * g.astype(out.dtype)[:, None]

    ys = lax.map(expert_block, (block_expert, slot_tok.reshape(n_blocks, MOE_BLOCK),
                                slot_gate.reshape(n_blocks, MOE_BLOCK)))
    y = jnp.zeros_like(x2).at[slot_tok].add(ys.reshape(-1, D).astype(x2.dtype))
    return y.reshape(B, S, D)


def setup_inputs(seed: int = 0) -> dict:
    key = jax.random.key(seed)
    ks = iter(jax.random.split(key, 40))
    f32 = jnp.float32
    L, D = DEPTH, D_MODEL
    beta = DEEPNORM_BETA

    def nrm(shape, scale):
        return jax.random.normal(next(ks), shape, f32) * scale

    return {
        'x': nrm((BATCH, SEQ, D), 1.0),
        'mem': nrm((BATCH, MEM_LEN, D), 1.0),
        'w_in': nrm((L, D, N_IN), D ** -0.5),
        'b_in': nrm((L, N_IN), 0.02),
        'gla_wg2': nrm((L, GLA_RANK, GLA_KEY), GLA_RANK ** -0.5),
        'gla_bg': nrm((L, GLA_KEY), 0.1),
        'gla_norm_g': 1.0 + nrm((L, GLA_VAL), 0.02),
        'sgu_ln_g': 1.0 + nrm((L, SGU_WIDTH), 0.02),
        'sgu_ln_b': nrm((L, SGU_WIDTH), 0.02),
        'sgu_ws': nrm((L, SGU_GROUPS, SGU_CHUNK, SGU_CHUNK), SGU_CHUNK ** -0.5),
        'sgu_bs': 1.0 + nrm((L, SGU_GROUPS, SGU_CHUNK), 0.1),
        'pool_w': nrm((L, len(POOL_WINDOWS), POOL_GD, POOL_GD), POOL_GD ** -0.5),
        'pool_scale': 1.0 + nrm((L, POOL_WIDTH), 0.1),
        'w_up_a': nrm((L, GLA_VAL, D), beta * GLA_VAL ** -0.5),
        'w_up_b': nrm((L, SGU_WIDTH, D), beta * SGU_WIDTH ** -0.5),
        'w_up_c': nrm((L, POOL_WIDTH, D), beta * POOL_WIDTH ** -0.5),
        'w_o': nrm((L, D, D), beta * D ** -0.5),
        'ln1_g': 1.0 + nrm((L, D), 0.02),
        'ln1_b': nrm((L, D), 0.02),
        'xa_wq': nrm((L, D, D), D ** -0.5),
        'xa_wk': nrm((L, D, D), D ** -0.5),
        'xa_wv': nrm((L, D, D), beta * D ** -0.5),
        'xa_wo': nrm((L, D, D), beta * D ** -0.5),
        'ln2_g': 1.0 + nrm((L, D), 0.02),
        'ln2_b': nrm((L, D), 0.02),
        'router_w': nrm((L, D, N_EXPERTS), D ** -0.5),
        'router_b': nrm((L, N_EXPERTS), 0.01),
        'exp_w_gu': nrm((L, N_EXPERTS, D, 2 * EXPERT_FF), beta * D ** -0.5),
        'exp_b_gu': nrm((L, N_EXPERTS, 2 * EXPERT_FF), 0.02),
        'exp_w_down': nrm((L, N_EXPERTS, EXPERT_FF, D), beta * EXPERT_FF ** -0.5),
        'exp_b_down': nrm((L, N_EXPERTS, D), 0.02),
        'ln3_g': 1.0 + nrm((L, D), 0.02),
        'ln3_b': nrm((L, D), 0.02),
    }


def reference(x, mem, w_in, b_in, gla_wg2, gla_bg, gla_norm_g, sgu_ln_g, sgu_ln_b, sgu_ws, sgu_bs,
              pool_w, pool_scale, w_up_a, w_up_b, w_up_c, w_o, ln1_g, ln1_b,
              xa_wq, xa_wk, xa_wv, xa_wo, ln2_g, ln2_b,
              router_w, router_b, exp_w_gu, exp_b_gu, exp_w_down, exp_b_down, ln3_g, ln3_b):
    alpha = DEEPNORM_ALPHA
    for l in range(DEPTH):
        h = hybrid_mixer(x, w_in[l], b_in[l], gla_wg2[l], gla_bg[l], gla_norm_g[l], sgu_ln_g[l], sgu_ln_b[l],
                         sgu_ws[l], sgu_bs[l], pool_w[l], pool_scale[l], w_up_a[l], w_up_b[l], w_up_c[l], w_o[l])
        x = layer_norm(alpha * x + h, ln1_g[l], ln1_b[l])
        h = memory_cross_attention(x, mem, xa_wq[l], xa_wk[l], xa_wv[l], xa_wo[l])
        x = layer_norm(alpha * x + h, ln2_g[l], ln2_b[l])
        h = moe_ffn(x, router_w[l], router_b[l], exp_w_gu[l], exp_b_gu[l], exp_w_down[l], exp_b_down[l])
        x = layer_norm(alpha * x + h, ln3_g[l], ln3_b[l])
    return x
```

```cpp
#include <hip/hip_runtime.h>
#include <hip/hip_cooperative_groups.h>
#include <cstdio>
namespace cg = cooperative_groups;

#define LAS __attribute__((address_space(3)))
typedef unsigned short bf16_t;
typedef short bf16x8 __attribute__((ext_vector_type(8)));
typedef float f32x4 __attribute__((ext_vector_type(4)));
typedef unsigned u32x4 __attribute__((ext_vector_type(4)));
typedef unsigned u32x2 __attribute__((ext_vector_type(2)));

constexpr int NTOK = 16384, DM = 1024, SEQL = 4096, NP = 5632;
constexpr int COL_K = 256, COL_V = 512, COL_R = 1024, COL_UV = 1536, COL_XC = 2048, COL_GATE = 2304, COL_GL = 5376, NIN = 5392;
constexpr float LN_EPS = 1e-5f;
constexpr float ALPHA = 1.41421356237f;
constexpr int ECAP = 16384;
constexpr int LDS_BYTES = 131072 + 1024;
#ifndef PH_HI
#define PH_HI 31
#endif

constexpr size_t al256(size_t x) { return (x + 255) & ~(size_t)255; }
constexpr size_t WS_CTL = 0;
constexpr size_t WS_WIN = 32768;
constexpr size_t SZ_WIN = (size_t)NP * 1024 * 2;
constexpr size_t WS_WUP = WS_WIN + 2 * SZ_WIN;
constexpr size_t SZ_SQ = (size_t)1024 * 1024 * 2;
constexpr size_t WS_WO = WS_WUP + 2 * SZ_SQ;
constexpr size_t WS_WQ = WS_WO + 2 * SZ_SQ;
constexpr size_t WS_WK = WS_WQ + 2 * SZ_SQ;
constexpr size_t WS_WV = WS_WK + 2 * SZ_SQ;
constexpr size_t WS_WXO = WS_WV + 2 * SZ_SQ;
constexpr size_t WS_WGU = WS_WXO + 2 * SZ_SQ;
constexpr size_t SZ_WGU = (size_t)32 * 2048 * 1024 * 2;
constexpr size_t WS_WD = WS_WGU + 2 * SZ_WGU;
constexpr size_t SZ_WD = (size_t)32 * 1024 * 1024 * 2;
constexpr size_t WS_XB = WS_WD + 2 * SZ_WD;
constexpr size_t SZ_ACTB = (size_t)NTOK * 1024 * 2;
constexpr size_t SZ_ACTF = (size_t)NTOK * 1024 * 4;
constexpr size_t WS_MEMB = WS_XB + SZ_ACTB;
constexpr size_t WS_XF = WS_MEMB + SZ_SQ;
constexpr size_t WS_YBUF = WS_XF + SZ_ACTF;
constexpr size_t WS_P = WS_YBUF + SZ_ACTF;
constexpr size_t WS_YCAT = WS_P + (size_t)NTOK * NP * 2;
constexpr size_t WS_BCUM = WS_YCAT + SZ_ACTB;
constexpr size_t WS_KVT = WS_BCUM + (size_t)NTOK * 256 * 4;
constexpr size_t WS_CDEC = WS_KVT + (size_t)1024 * 8192 * 4;
constexpr size_t WS_ST = WS_CDEC + (size_t)1024 * 64 * 4;
constexpr size_t WS_MRGF = WS_ST + (size_t)1024 * 8192 * 2;
constexpr size_t WS_MRGB = WS_MRGF + SZ_ACTF;
constexpr size_t WS_QB = WS_MRGB + SZ_ACTB;
constexpr size_t WS_OB = WS_QB + SZ_ACTB;
constexpr size_t WS_KM = WS_OB + SZ_ACTB;
constexpr size_t WS_VT = WS_KM + 2 * SZ_SQ;
constexpr size_t WS_ELIST = WS_VT + 8 * SZ_SQ;
constexpr size_t WS_TGATE = WS_ELIST + (size_t)32 * ECAP * 4;
constexpr size_t WS_ABUF = WS_TGATE + (size_t)NTOK * 4 * 4;
constexpr size_t WS_YS = WS_ABUF + (size_t)73728 * 1024 * 2;
constexpr size_t WS_STATS = WS_YS + (size_t)65536 * 1024 * 2;
constexpr size_t WS_END = WS_STATS + (size_t)64 * 4 * 256 * 2 * 4;

__device__ __forceinline__ float bf2f(bf16_t b) { return __uint_as_float(((unsigned)b) << 16); }
__device__ __forceinline__ unsigned pk2(float lo, float hi) { unsigned r; asm("v_cvt_pk_bf16_f32 %0, %1, %2" : "=v"(r) : "v"(lo), "v"(hi)); return r; }
__device__ __forceinline__ bf16_t f2bf(float f) { return (bf16_t)(pk2(f, 0.f) & 0xffffu); }
__device__ __forceinline__ float bflo(unsigned u) { return __uint_as_float(u << 16); }
__device__ __forceinline__ float bfhi(unsigned u) { return __uint_as_float(u & 0xffff0000u); }
__device__ __forceinline__ float wave_sum(float v) {
#pragma unroll
    for (int o = 32; o; o >>= 1) v += __shfl_xor(v, o);
    return v;
}
__device__ __forceinline__ float wave_max(float v) {
#pragma unroll
    for (int o = 32; o; o >>= 1) v = fmaxf(v, __shfl_xor(v, o));
    return v;
}
__device__ __forceinline__ float gelu_f(float v) {
    const float av = fabsf(v), t = __builtin_amdgcn_rcpf(av * 0.2316418882f + 1.0f);
    float q = t * 0.5307027145f + (-0.7265760135f); q = q * t + 0.7107068705f; q = q * t + (-0.142248368f); q = q * t + 0.127414796f; q = q * t;
    const float e = __builtin_amdgcn_exp2f((v * v) * (-0.72134752044f));
    const float m = v * (q * e);
    return v < 0.f ? m : v - m;
}
__device__ __forceinline__ float sigmoid_f(float x) { return 1.f / (1.f + __expf(-x)); }
__device__ __forceinline__ int ltid() { int t = threadIdx.x; asm volatile("" : "+v"(t)); return t; }
#define WBAR() do { asm volatile("" ::: "memory"); __builtin_amdgcn_wave_barrier(); asm volatile("" ::: "memory"); } while (0)

struct Params { const float* in[33]; float* out; unsigned char* ws; int ph_lo, ph_hi; };

constexpr int BM = 256, BK = 64, HALF = 128, HTB = HALF * BK * 2, NXCD = 8, WGM = 8;
__device__ __forceinline__ int lds_byte(int r, int c) { const int st = (r >> 4) * 2 + (c >> 5), rr = r & 15, cc = c & 31, ob = rr * 64 + cc * 2; return st * 1024 + (ob ^ (((ob >> 9) & 1) << 5)); }
__device__ __forceinline__ void stage_rc(int b, int& R, int& C) { const int st = b / 1024, sb = b % 1024, swz = sb ^ (((sb >> 9) & 1) << 5); R = (st >> 1) * 16 + swz / 64; C = (st & 1) * 32 + (swz % 64) / 2; }
__device__ __forceinline__ int perm32(int rho) { const int n = rho >> 4, i = rho & 15; return 8 * (i >> 2) + 4 * n + (i & 3); }

struct Unit { int pm, pn, e, aux; };
typedef f32x4 Acc[2][2][4][2];

struct OrderStatic {
    int nM, nN, nwg, G, c;
    __device__ __forceinline__ void init(int M, int N, int G_, int c_) { nM = M / BM; nN = N / BM; nwg = nM * nN; G = G_; c = c_; }
    __device__ __forceinline__ bool next(int i, Unit& u) const {
        const long L = (long)i * G + c; if (L >= nwg) return false;
        int wgid = (int)L; { const int q = nwg / NXCD, r = nwg % NXCD, xcd = wgid % NXCD, off = wgid / NXCD; wgid = (xcd < r ? xcd * (q + 1) : r * (q + 1) + (xcd - r) * q) + off; }
        const int nig = WGM * nN, gid = wgid / nig, fm = gid * WGM, gsz = (nM - fm) < WGM ? (nM - fm) : WGM;
        u.pm = fm + ((wgid % nig) % gsz); u.pn = (wgid % nig) / gsz; u.e = 0; u.aux = 0; return true;
    }
};

template <class S_t>
__device__ __forceinline__ void gemm_phase(LAS unsigned char* lds, const S_t& S) {
    const int tid = ltid(), wid = __builtin_amdgcn_readfirstlane(tid >> 6), lane = tid & 63, wr = wid >> 2, wc = wid & 3, fr = lane & 15, fq = lane >> 4;
    const int nt = S.K / BK;
    int Rr[2], Cc[2]; unsigned voffB[2]; unsigned offC[2][2], offN[2][2];
#pragma unroll
    for (int i = 0; i < 2; ++i) { stage_rc(tid * 16 + i * 8192, Rr[i], Cc[i]); const int Rb = S_t::PERM ? ((Rr[i] & ~31) + perm32(Rr[i] & 31)) : Rr[i];
        voffB[i] = (unsigned)(Rb * S.ldb + Cc[i] * 2);
        offC[0][i] = (unsigned)(Rr[i] * S.lda + Cc[i] * 2); offC[1][i] = (unsigned)((Rr[i] + HALF) * S.lda + Cc[i] * 2);
        }
    const size_t kstep = (size_t)(BK * 2);
    const size_t hstepB = (size_t)HALF * S.ldb;
    const unsigned ldsw = (unsigned)wid * 1024u;
    const int aoff = lds_byte(wr * 64 + fr, fq * 8), boff = lds_byte(wc * 32 + fr, fq * 8);
#define G_SA(b, h) (((b) * 2 + (h)) * HTB)
#define G_SB(b, h) ((4 + (b) * 2 + (h)) * HTB)
#define G_STAGE_A(bufoff, kptr, OFF, h) do { _Pragma("unroll") for (int _i = 0; _i < 2; ++_i) \
        __builtin_amdgcn_global_load_lds((const unsigned*)((const char*)(kptr) + (OFF)[h][_i]), (LAS unsigned*)(lds + (bufoff) + ldsw + _i * 8192), 16, 0, 0); } while (0)
#define G_STAGE_B(bufoff, gbase) do { _Pragma("unroll") for (int _i = 0; _i < 2; ++_i) \
        __builtin_amdgcn_global_load_lds((const unsigned*)((const char*)(gbase) + voffB[_i]), (LAS unsigned*)(lds + (bufoff) + ldsw + _i * 8192), 16, 0, 0); } while (0)
#define G_LDA(dst, b, h) do { _Pragma("unroll") for (int m = 0; m < 4; ++m) _Pragma("unroll") for (int k = 0; k < 2; ++k) dst[m][k] = *(const LAS bf16x8*)(lds + G_SA(b, h) + aoff + m * 2048 + k * 1024); } while (0)
#define G_LDB(dst, b, h) do { _Pragma("unroll") for (int n = 0; n < 2; ++n) _Pragma("unroll") for (int k = 0; k < 2; ++k) dst[n][k] = *(const LAS bf16x8*)(lds + G_SB(b, h) + boff + n * 2048 + k * 1024); } while (0)
#define G_MMA(ai, bj, At, Bt) do { __builtin_amdgcn_s_setprio(1); _Pragma("unroll") for (int m = 0; m < 4; ++m) _Pragma("unroll") for (int n = 0; n < 2; ++n) _Pragma("unroll") for (int k = 0; k < 2; ++k) \
        acc[ai][bj][m][n] = __builtin_amdgcn_mfma_f32_16x16x32_bf16(Bt[n][k], At[m][k], acc[ai][bj][m][n], 0, 0, 0); __builtin_amdgcn_s_setprio(0); } while (0)
#define G_WAIT_V(n) asm volatile("s_waitcnt vmcnt(" #n ")" ::: "memory")
#define G_WAIT_L(n) asm volatile("s_waitcnt lgkmcnt(" #n ")" ::: "memory")
#define G_BAR __builtin_amdgcn_s_barrier()
#define G_SCHED __builtin_amdgcn_sched_barrier(0)
    Unit cur, nxt; int ui = 0;
    if (!S.next(0, cur)) return;
    if (S_t::GATHER) S.gather_offs(cur, tid, offC);
    Acc acc;
#pragma unroll
    for (int a = 0; a < 2; ++a)
#pragma unroll
        for (int b = 0; b < 2; ++b)
#pragma unroll
            for (int m = 0; m < 4; ++m)
#pragma unroll
                for (int n = 0; n < 2; ++n) acc[a][b][m][n] = (f32x4){0.f, 0.f, 0.f, 0.f};
    bf16x8 At[4][2], B0[2][2], B1[2][2];
    const char* cA = S.a_ptr(cur); const char* cB = S.b_ptr(cur);
    G_STAGE_B(G_SB(0, 0), cB); G_STAGE_A(G_SA(0, 0), cA, offC, 0); G_STAGE_B(G_SB(0, 1), cB + hstepB); G_STAGE_A(G_SA(0, 1), cA, offC, 1);
    if (wr == 1) G_BAR;
    G_WAIT_V(4); G_BAR;
    G_STAGE_B(G_SB(1, 0), cB + kstep); G_STAGE_A(G_SA(1, 0), cA + kstep, offC, 0); G_STAGE_B(G_SB(1, 1), cB + hstepB + kstep);
    G_WAIT_V(6); G_BAR;
    for (;;) {
        const bool has_next = S.next(ui + 1, nxt);
        const char* nA = has_next ? S.a_ptr(nxt) : cA; const char* nB = has_next ? S.b_ptr(nxt) : cB;
        if (S_t::GATHER) { if (has_next) S.gather_offs(nxt, tid, offN); else { offN[0][0] = offC[0][0]; offN[0][1] = offC[0][1]; offN[1][0] = offC[1][0]; offN[1][1] = offC[1][1]; } }
        for (int t = 0; t < nt; t += 2) {
            const bool last = (t == nt - 2);
            const char* a1 = cA + (size_t)(t + 1) * kstep;
            const char* a2 = last ? nA : cA + (size_t)(t + 2) * kstep; const char* b2 = last ? nB : cB + (size_t)(t + 2) * kstep;
            const char* a3 = a2 + kstep; const char* b3 = b2 + kstep;
            G_LDB(B0, 0, 0); G_SCHED; G_LDA(At, 0, 0); G_STAGE_A(G_SA(1, 1), a1, offC, 1);
            if (S_t::GATHER) { if (last) { offC[0][0] = offN[0][0]; offC[0][1] = offN[0][1]; offC[1][0] = offN[1][0]; offC[1][1] = offN[1][1]; } }
            G_WAIT_L(8); G_BAR; G_WAIT_L(0); G_MMA(0, 0, At, B0); G_BAR; G_SCHED;
            G_LDB(B1, 0, 1); G_STAGE_B(G_SB(0, 0), b2);
            G_BAR; G_WAIT_L(0); G_MMA(0, 1, At, B1); G_BAR;
            G_LDA(At, 0, 1); G_STAGE_A(G_SA(0, 0), a2, offC, 0);
            G_BAR; G_WAIT_L(0); G_MMA(1, 0, At, B0); G_BAR; G_SCHED;
            G_STAGE_B(G_SB(0, 1), b2 + hstepB);
            G_WAIT_V(6); G_BAR; G_MMA(1, 1, At, B1); G_BAR;
            G_LDB(B0, 1, 0); G_SCHED; G_LDA(At, 1, 0); G_STAGE_A(G_SA(0, 1), a2, offC, 1);
            G_WAIT_L(8); G_BAR; G_WAIT_L(0); G_MMA(0, 0, At, B0); G_BAR; G_SCHED;
            G_LDB(B1, 1, 1); G_STAGE_B(G_SB(1, 0), b3);
            G_BAR; G_WAIT_L(0); G_MMA(0, 1, At, B1); G_BAR;
            G_LDA(At, 1, 1); G_STAGE_A(G_SA(1, 0), a3, offC, 0);
            G_BAR; G_WAIT_L(0); G_MMA(1, 0, At, B0); G_BAR; G_SCHED;
            G_STAGE_B(G_SB(1, 1), b3 + hstepB);
            G_WAIT_V(6); G_BAR; G_MMA(1, 1, At, B1); G_BAR;
        }
        if constexpr (!S_t::AFTER) S.epi(acc, cur, wr, wc, fr, fq);
        if (!has_next) break;
#pragma unroll
        for (int a = 0; a < 2; ++a)
#pragma unroll
            for (int b = 0; b < 2; ++b)
#pragma unroll
                for (int m = 0; m < 4; ++m)
#pragma unroll
                    for (int n = 0; n < 2; ++n) acc[a][b][m][n] = (f32x4){0.f, 0.f, 0.f, 0.f};
        cur = nxt; cA = nA; cB = nB; ++ui;
    }
    G_WAIT_V(0);
    if (wr == 0) G_BAR;
    G_BAR;
    if constexpr (S_t::AFTER) S.epi_after(acc, cur, wr, wc, fr, fq, lds);
}

struct ProbBase : OrderStatic {
    static constexpr bool GATHER = false, AFTER = false;
    const char* A; const char* Bt; static constexpr int K = 1024, lda = 2048, ldb = 2048;
    __device__ __forceinline__ const char* a_ptr(const Unit& u) const { return A + (size_t)u.pm * BM * lda; }
    __device__ __forceinline__ const char* b_ptr(const Unit& u) const { return Bt + (size_t)u.pn * BM * ldb; }
    __device__ __forceinline__ void gather_offs(const Unit&, int, unsigned (&)[2][2]) const {}
};

struct ProbInProj : ProbBase {
    static constexpr bool PERM = true;
    bf16_t* out; const float* bias;
    __device__ __forceinline__ void epi(const Acc& acc, const Unit& u, int wr, int wc, int fr, int fq) const {
        const int row0 = u.pm * BM + wr * 64 + fr, colt = u.pn * BM + wc * 32 + 8 * fq;
        f32x4 bv[2][2];
#pragma unroll
        for (int bj = 0; bj < 2; ++bj) { const int c = colt + bj * HALF; int mc = c < COL_UV ? c : (c < COL_GL ? c + 16 : c - COL_GL + COL_UV);
            if (c < NIN) { bv[bj][0] = *(const f32x4*)(bias + mc); bv[bj][1] = *(const f32x4*)(bias + mc + 4); } else { bv[bj][0] = (f32x4){0.f, 0.f, 0.f, 0.f}; bv[bj][1] = bv[bj][0]; } }
#pragma unroll
        for (int ai = 0; ai < 2; ++ai)
#pragma unroll
            for (int m = 0; m < 4; ++m) { bf16_t* rowp = out + (size_t)(row0 + ai * HALF + m * 16) * NP + colt;
#pragma unroll
                for (int bj = 0; bj < 2; ++bj) { const f32x4 v0 = acc[ai][bj][m][0] + bv[bj][0], v1 = acc[ai][bj][m][1] + bv[bj][1];
                    *(u32x4*)(rowp + bj * HALF) = (u32x4){pk2(v0[0], v0[1]), pk2(v0[2], v0[3]), pk2(v1[0], v1[1]), pk2(v1[2], v1[3])}; } }
    }
};
struct ProbBf16 : ProbBase {
    static constexpr bool PERM = true;
    bf16_t* out; int ldc;
    __device__ __forceinline__ void epi(const Acc& acc, const Unit& u, int wr, int wc, int fr, int fq) const {
        const int row0 = u.pm * BM + wr * 64 + fr, colt = u.pn * BM + wc * 32 + 8 * fq;
#pragma unroll
        for (int ai = 0; ai < 2; ++ai)
#pragma unroll
            for (int m = 0; m < 4; ++m) { bf16_t* rowp = out + (size_t)(row0 + ai * HALF + m * 16) * ldc + colt;
#pragma unroll
                for (int bj = 0; bj < 2; ++bj) { const f32x4 v0 = acc[ai][bj][m][0], v1 = acc[ai][bj][m][1];
                    *(u32x4*)(rowp + bj * HALF) = (u32x4){pk2(v0[0], v0[1]), pk2(v0[2], v0[3]), pk2(v1[0], v1[1]), pk2(v1[2], v1[3])}; } }
    }
};
struct ProbQ : ProbBf16 {
    int G2, c2;
    __device__ __forceinline__ bool next(int i, Unit& u) const { const int L = i * G2 + c2; if (L >= 256) return false; const int bh = L >> 4, mt = L & 15; u.pm = (bh >> 2) * 16 + mt; u.pn = bh & 3; u.e = 0; u.aux = 0; return true; }
};
struct ProbRes : ProbBase {
    static constexpr bool PERM = false;
    float* out; const float* xres;
    __device__ __forceinline__ void epi(const Acc& acc, const Unit& u, int wr, int wc, int fr, int fq) const {
        const int row0 = u.pm * BM + wr * 64 + fr, col0 = u.pn * BM + wc * 32 + 4 * fq;
#pragma unroll
        for (int ai = 0; ai < 2; ++ai) {
            f32x4 xr[4][2][2];
#pragma unroll
            for (int m = 0; m < 4; ++m) { const size_t ro = (size_t)(row0 + ai * HALF + m * 16) * DM + col0;
#pragma unroll
                for (int bj = 0; bj < 2; ++bj)
#pragma unroll
                    for (int n = 0; n < 2; ++n) xr[m][bj][n] = *(const f32x4*)(xres + ro + bj * HALF + n * 16); }
#pragma unroll
            for (int m = 0; m < 4; ++m) { const size_t ro = (size_t)(row0 + ai * HALF + m * 16) * DM + col0;
#pragma unroll
                for (int bj = 0; bj < 2; ++bj)
#pragma unroll
                    for (int n = 0; n < 2; ++n) *(f32x4*)(out + ro + bj * HALF + n * 16) = xr[m][bj][n] * ALPHA + acc[ai][bj][m][n]; }
        }
    }
};
struct ProbMT {
    static constexpr bool PERM = true, GATHER = false, AFTER = false;
    static constexpr int K = 256, lda = 2048, ldb = 2048;
    const char* A; const char* Bt; int G, c; bf16_t* out;
    __device__ __forceinline__ bool next(int i, Unit& u) const { const int L = i * G + c; if (L >= 64) return false; u.e = L >> 2; u.pn = L & 3; u.pm = 0; u.aux = 0; return true; }
    __device__ __forceinline__ const char* a_ptr(const Unit& u) const { const int b = u.e >> 2, h = u.e & 3; return A + (size_t)(b * 256) * lda + h * 512; }
    __device__ __forceinline__ const char* b_ptr(const Unit& u) const { const int h = u.e & 3; return Bt + (size_t)u.pn * BM * ldb + h * 512; }
    __device__ __forceinline__ void gather_offs(const Unit&, int, unsigned (&)[2][2]) const {}
    __device__ __forceinline__ void epi(const Acc& acc, const Unit& u, int wr, int wc, int fr, int fq) const {
        const int row0 = wr * 64 + fr, colt = u.pn * BM + wc * 32 + 8 * fq;
#pragma unroll
        for (int ai = 0; ai < 2; ++ai)
#pragma unroll
            for (int m = 0; m < 4; ++m) { bf16_t* rowp = out + (size_t)u.e * 256 * 1024 + (size_t)(row0 + ai * HALF + m * 16) * 1024 + colt;
#pragma unroll
                for (int bj = 0; bj < 2; ++bj) { const f32x4 v0 = acc[ai][bj][m][0], v1 = acc[ai][bj][m][1];
                    *(u32x4*)(rowp + bj * HALF) = (u32x4){pk2(v0[0], v0[1]), pk2(v0[2], v0[3]), pk2(v1[0], v1[1]), pk2(v1[2], v1[3])}; } }
    }
};
struct ProbVW {
    static constexpr bool PERM = true, GATHER = false, AFTER = false;
    static constexpr int K = 256, lda = 2048, ldb = 2048;
    const char* A; const char* Bt; int G, c; bf16_t* out;
    __device__ __forceinline__ bool next(int i, Unit& u) const { const int L = i * G + c; if (L >= 64) return false; u.e = L >> 2; u.pm = L & 3; u.pn = 0; u.aux = 0; return true; }
    __device__ __forceinline__ const char* a_ptr(const Unit& u) const { const int h = u.e & 3; return A + (size_t)u.pm * BM * lda + h * 512; }
    __device__ __forceinline__ const char* b_ptr(const Unit& u) const { const int b = u.e >> 2, h = u.e & 3; return Bt + (size_t)(b * 256) * ldb + h * 512; }
    __device__ __forceinline__ void gather_offs(const Unit&, int, unsigned (&)[2][2]) const {}
    __device__ __forceinline__ void epi(const Acc& acc, const Unit& u, int wr, int wc, int fr, int fq) const {
        const int b = u.e >> 2, h = u.e & 3; const int row0 = u.pm * BM + wr * 64 + fr, colt = h * 256 + wc * 32 + 8 * fq;
#pragma unroll
        for (int ai = 0; ai < 2; ++ai)
#pragma unroll
            for (int m = 0; m < 4; ++m) { bf16_t* rowp = out + (size_t)b * 1024 * 1024 + (size_t)(row0 + ai * HALF + m * 16) * 1024 + colt;
#pragma unroll
                for (int bj = 0; bj < 2; ++bj) { const f32x4 v0 = acc[ai][bj][m][0], v1 = acc[ai][bj][m][1];
                    *(u32x4*)(rowp + bj * HALF) = (u32x4){pk2(v0[0], v0[1]), pk2(v0[2], v0[3]), pk2(v1[0], v1[1]), pk2(v1[2], v1[3])}; } }
    }
};
struct ProbResLN : ProbBase {
    static constexpr bool PERM = false, AFTER = true;
    const float* xres; const float* lng; const float* lnb; float* xf; bf16_t* xb; float* stats; unsigned* cntp; size_t bstride;
    __device__ __forceinline__ const char* b_ptr(const Unit& u) const { return Bt + (size_t)(u.pm >> 4) * bstride + (size_t)u.pn * BM * ldb; }
    __device__ __forceinline__ void epi(const Acc&, const Unit&, int, int, int, int) const {}
    __device__ __forceinline__ void epi_after(Acc& acc, const Unit& u, int wr, int wc, int fr, int fq, LAS unsigned char* lds) const {
        const int tid = ltid();
        const int col0 = u.pn * BM + wc * 32 + 4 * fq;
        LAS float* red = (LAS float*)lds;
        LAS float* tab = (LAS float*)(lds + 8192);
#pragma unroll
        for (int ai = 0; ai < 2; ++ai)
#pragma unroll
            for (int m = 0; m < 4; ++m) { const int rowl = ai * HALF + wr * 64 + m * 16 + fr; const size_t ro = (size_t)(u.pm * BM + rowl) * DM + col0;
                float sv = 0.f, sq = 0.f;
#pragma unroll
                for (int bj = 0; bj < 2; ++bj)
#pragma unroll
                    for (int n = 0; n < 2; ++n) { const f32x4 xr = *(const f32x4*)(xres + ro + bj * HALF + n * 16); const f32x4 y = xr * ALPHA + acc[ai][bj][m][n]; acc[ai][bj][m][n] = y;
                        sv += (y[0] + y[1]) + (y[2] + y[3]); sq += (y[0] * y[0] + y[1] * y[1]) + (y[2] * y[2] + y[3] * y[3]); }
                sv += __shfl_xor(sv, 16); sv += __shfl_xor(sv, 32); sq += __shfl_xor(sq, 16); sq += __shfl_xor(sq, 32);
                if (fq == 0) { red[(rowl * 4 + wc) * 2] = sv; red[(rowl * 4 + wc) * 2 + 1] = sq; } }
        __syncthreads();
        if (tid < 256) { float S = 0.f, SS = 0.f;
#pragma unroll
            for (int w = 0; w < 4; ++w) { S += red[(tid * 4 + w) * 2]; SS += red[(tid * 4 + w) * 2 + 1]; }
            float* st = stats + ((size_t)(u.pm * 4 + u.pn) * 256 + tid) * 2; st[0] = S; st[1] = SS; }
        asm volatile("s_waitcnt vmcnt(0)" ::: "memory");
        __syncthreads();
        if (tid == 0) { unsigned* cw = cntp + u.pm;
            __builtin_amdgcn_fence(__ATOMIC_RELEASE, "agent"); asm volatile("s_waitcnt vmcnt(0)" ::: "memory");
            __hip_atomic_fetch_add(cw, 1u, __ATOMIC_RELAXED, __HIP_MEMORY_SCOPE_AGENT);
            while (__hip_atomic_load(cw, __ATOMIC_RELAXED, __HIP_MEMORY_SCOPE_AGENT) < 4u) __builtin_amdgcn_s_sleep(1);
            __builtin_amdgcn_fence(__ATOMIC_ACQUIRE, "agent"); asm volatile("s_waitcnt vmcnt(0)" ::: "memory"); }
        __syncthreads();
        if (tid < 256) { float S = 0.f, SS = 0.f;
#pragma unroll
            for (int w = 0; w < 4; ++w) { const float* st = stats + ((size_t)(u.pm * 4 + w) * 256 + tid) * 2;
                S += __hip_atomic_load(st, __ATOMIC_RELAXED, __HIP_MEMORY_SCOPE_AGENT); SS += __hip_atomic_load(st + 1, __ATOMIC_RELAXED, __HIP_MEMORY_SCOPE_AGENT); }
            const float mean = S * (1.f / DM), var = fmaxf(SS * (1.f / DM) - mean * mean, 0.f);
            tab[tid * 2] = mean; tab[tid * 2 + 1] = rsqrtf(var + LN_EPS); }
        __syncthreads();
        f32x4 gv[2][2], bv[2][2];
#pragma unroll
        for (int bj = 0; bj < 2; ++bj)
#pragma unroll
            for (int n = 0; n < 2; ++n) { gv[bj][n] = *(const f32x4*)(lng + col0 + bj * HALF + n * 16); bv[bj][n] = *(const f32x4*)(lnb + col0 + bj * HALF + n * 16); }
#pragma unroll
        for (int ai = 0; ai < 2; ++ai)
#pragma unroll
            for (int m = 0; m < 4; ++m) { const int rowl = ai * HALF + wr * 64 + m * 16 + fr; const size_t ro = (size_t)(u.pm * BM + rowl) * DM + col0;
                const float mean = tab[rowl * 2], rstd = tab[rowl * 2 + 1];
#pragma unroll
                for (int bj = 0; bj < 2; ++bj)
#pragma unroll
                    for (int n = 0; n < 2; ++n) { const f32x4 v = (acc[ai][bj][m][n] - mean) * rstd * gv[bj][n] + bv[bj][n];
                        *(f32x4*)(xf + ro + bj * HALF + n * 16) = v; *(u32x2*)(xb + ro + bj * HALF + n * 16) = (u32x2){pk2(v[0], v[1]), pk2(v[2], v[3])}; } }
        __syncthreads();
    }
};
template <int KK> struct ProbMerge {
    static constexpr bool PERM = false, GATHER = false, AFTER = false;
    const char* A; const char* Bt; static constexpr int K = KK, lda = 2048, ldb = 2048; int G, c;
    const bf16_t* p; bf16_t* mb;
    __device__ __forceinline__ bool next(int i, Unit& u) const { const int tile = (KK == 512 ? i : (i >> 1)) * G + c; if (tile >= 256) return false; u.pm = tile >> 2; u.pn = tile & 3; u.e = KK == 512 ? 0 : 1 + (i & 1); u.aux = 0; return true; }
    __device__ __forceinline__ const char* a_ptr(const Unit& u) const { return A + (size_t)u.pm * BM * lda + (KK == 512 ? 0 : 1024 + (u.e - 1) * 512); }
    __device__ __forceinline__ const char* b_ptr(const Unit& u) const { return Bt + (size_t)u.pn * BM * ldb + (KK == 512 ? 0 : 1024 + (u.e - 1) * 512); }
    __device__ __forceinline__ void gather_offs(const Unit&, int, unsigned (&)[2][2]) const {}
    __device__ __forceinline__ void epi(const Acc& acc, const Unit& u, int wr, int wc, int fr, int fq) const {
        const int row0 = u.pm * BM + wr * 64 + fr, col0 = u.pn * BM + wc * 32 + 4 * fq;
        const int gi = u.e;
        const bf16_t* __restrict__ mbr = mb; bf16_t* __restrict__ mbw = mb; const bf16_t* __restrict__ pr = p;
        u32x2 gr[2][2][2]; u32x2 pv[2][2][2];
#define MRG_LOAD(q, buf) do { const int row_ = row0 + ((q) >> 2) * HALF + ((q) & 3) * 16; const size_t ro_ = (size_t)row_ * DM + col0; \
            const bf16_t* gp_ = pr + (size_t)row_ * NP + COL_GATE + gi * 1024 + col0; \
            _Pragma("unroll") for (int bj = 0; bj < 2; ++bj) _Pragma("unroll") for (int n = 0; n < 2; ++n) { gr[buf][bj][n] = *(const u32x2*)(gp_ + bj * HALF + n * 16); \
                pv[buf][bj][n] = (KK != 512) ? *(const u32x2*)(mbr + ro_ + bj * HALF + n * 16) : (u32x2){0u, 0u}; } } while (0)
        MRG_LOAD(0, 0);
#pragma unroll
        for (int q = 0; q < 8; ++q) { const int ai = q >> 2, m = q & 3, buf = q & 1;
            if (q + 1 < 8) MRG_LOAD(q + 1, buf ^ 1);
            const int row = row0 + ai * HALF + m * 16; const size_t ro = (size_t)row * DM + col0;
#pragma unroll
            for (int bj = 0; bj < 2; ++bj)
#pragma unroll
                for (int n = 0; n < 2; ++n) { const u32x2 g2 = gr[buf][bj][n], p2 = pv[buf][bj][n];
                    f32x4 g; g[0] = sigmoid_f(bflo(g2[0])); g[1] = sigmoid_f(bfhi(g2[0])); g[2] = sigmoid_f(bflo(g2[1])); g[3] = sigmoid_f(bfhi(g2[1]));
                    const f32x4 v = g * acc[ai][bj][m][n] + (f32x4){bflo(p2[0]), bfhi(p2[0]), bflo(p2[1]), bfhi(p2[1])};
                    *(u32x2*)(mbw + ro + bj * HALF + n * 16) = (u32x2){pk2(v[0], v[1]), pk2(v[2], v[3])}; } }
#undef MRG_LOAD
    }
};
struct MoeOrder {
    int G, c, nN; const LAS int* tstart; const int* cnt;
    __device__ __forceinline__ bool next(int i, Unit& u) const {
        const int L = i * G + c; const int total = tstart[32] * nN; if (L >= total) return false;
        const int mt = L / nN; u.pn = L % nN; int e = 0;
        for (int k = 1; k < 32; ++k) e += (tstart[k] <= mt) ? 1 : 0;
        u.e = e; u.pm = mt; u.aux = (mt - tstart[e]) * BM; return true;
    }
};
__device__ __forceinline__ float swiglu_f(float g, float l) { g = fminf(g, 7.f); l = fminf(fmaxf(l, -7.f), 7.f); return g * sigmoid_f(1.702f * g) * (l + 1.f); }
struct ProbMoe1 : MoeOrder {
    static constexpr bool PERM = false, GATHER = true, AFTER = false;
    const char* A; const char* Bt; static constexpr int K = 1024, lda = 2048, ldb = 2048; const int* elist; const float* bgu; bf16_t* abuf;
    __device__ __forceinline__ const char* a_ptr(const Unit&) const { return A; }
    __device__ __forceinline__ const char* b_ptr(const Unit& u) const { return Bt + (size_t)u.e * 2048 * ldb + (size_t)u.pn * BM * ldb; }
    __device__ __forceinline__ void gather_offs(const Unit& u, int tid, unsigned (&off)[2][2]) const {
        const int n = cnt[u.e];
#pragma unroll
        for (int i = 0; i < 2; ++i) { int R, C; stage_rc(tid * 16 + i * 8192, R, C);
#pragma unroll
            for (int h = 0; h < 2; ++h) { const int rr = u.aux + h * HALF + R; const int tok = rr < n ? (elist[u.e * ECAP + rr] >> 2) : 0; off[h][i] = (unsigned)(tok * lda + C * 2); } }
    }
    __device__ __forceinline__ void epi(const Acc& acc, const Unit& u, int wr, int wc, int fr, int fq) const {
        const int row0 = u.pm * BM + wr * 64 + fr;
        const float* bb = bgu + (size_t)u.e * 2048;
#pragma unroll
        for (int bj = 0; bj < 2; ++bj) { const int g = u.pn * 8 + bj * 4 + wc; const int ac = 16 * g + 4 * fq;
            const f32x4 bg = *(const f32x4*)(bb + ac), bl = *(const f32x4*)(bb + 1024 + ac);
#pragma unroll
            for (int ai = 0; ai < 2; ++ai)
#pragma unroll
                for (int m = 0; m < 4; ++m) { const f32x4 vg = acc[ai][bj][m][0] + bg, vl = acc[ai][bj][m][1] + bl;
                    *(u32x2*)(abuf + (size_t)(row0 + ai * HALF + m * 16) * 1024 + ac) =
                        (u32x2){pk2(swiglu_f(vg[0], vl[0]), swiglu_f(vg[1], vl[1])), pk2(swiglu_f(vg[2], vl[2]), swiglu_f(vg[3], vl[3]))}; } }
    }
};
struct ProbMoe2 : MoeOrder {
    static constexpr bool PERM = false, GATHER = false, AFTER = false;
    const char* A; const char* Bt; static constexpr int K = 1024, lda = 2048, ldb = 2048; const int* elist; const float* bd; const float* tgate; bf16_t* ys;
    __device__ __forceinline__ const char* a_ptr(const Unit& u) const { return A + (size_t)u.pm * BM * lda; }
    __device__ __forceinline__ const char* b_ptr(const Unit& u) const { return Bt + (size_t)u.e * 1024 * ldb + (size_t)u.pn * BM * ldb; }
    __device__ __forceinline__ void gather_offs(const Unit&, int, unsigned (&)[2][2]) const {}
    __device__ __forceinline__ void epi(const Acc& acc, const Unit& u, int wr, int wc, int fr, int fq) const {
        const int n = cnt[u.e]; const int col0 = u.pn * BM + wc * 32 + 4 * fq;
        const float* bb = bd + (size_t)u.e * 1024 + col0;
        f32x4 bv[2][2];
#pragma unroll
        for (int bj = 0; bj < 2; ++bj)
#pragma unroll
            for (int nn = 0; nn < 2; ++nn) bv[bj][nn] = *(const f32x4*)(bb + bj * HALF + nn * 16);
        int aidx[2][4]; float gts[2][4];
#pragma unroll
        for (int ai = 0; ai < 2; ++ai)
#pragma unroll
            for (int m = 0; m < 4; ++m) { const int rr = u.aux + ai * HALF + wr * 64 + m * 16 + fr; aidx[ai][m] = (rr < n) ? elist[u.e * ECAP + rr] : -1; }
#pragma unroll
        for (int ai = 0; ai < 2; ++ai)
#pragma unroll
            for (int m = 0; m < 4; ++m) gts[ai][m] = (aidx[ai][m] >= 0) ? tgate[aidx[ai][m]] : 0.f;
#pragma unroll
        for (int ai = 0; ai < 2; ++ai)
#pragma unroll
            for (int m = 0; m < 4; ++m) {
                if (aidx[ai][m] >= 0) { const float g = gts[ai][m]; bf16_t* rowp = ys + (size_t)aidx[ai][m] * 1024 + col0;
#pragma unroll
                    for (int bj = 0; bj < 2; ++bj)
#pragma unroll
                        for (int nn = 0; nn < 2; ++nn) { const f32x4 v = (acc[ai][bj][m][nn] + bv[bj][nn]) * g;
                            *(u32x2*)(rowp + bj * HALF + nn * 16) = (u32x2){pk2(v[0], v[1]), pk2(v[2], v[3])}; } } }
    }
};

template <int MODE, int KK = 256> struct ProbAttn {
    static constexpr bool PERM = (MODE == 1), GATHER = false, AFTER = (MODE == 0);
    static constexpr int K = KK, lda = 2048, ldb = 2048;
    const char* A; const char* Bt; int G, c; float* sout; bf16_t* oout;
    __device__ __forceinline__ bool next(int i, Unit& u) const { const int L = i * G + c; if (L >= 256) return false; u.e = L >> 4; u.pm = L & 15; u.pn = 0; u.aux = 0; return true; }
    __device__ __forceinline__ const char* a_ptr(const Unit& u) const { const int b = u.e >> 2, h = u.e & 3; return A + ((size_t)(b * SEQL + u.pm * BM) * DM + (KK == 1024 ? 0 : h * 256)) * 2; }
    __device__ __forceinline__ const char* b_ptr(const Unit& u) const { const int b = u.e >> 2, h = u.e & 3;
        if (KK == 1024) return Bt + (size_t)u.e * 256 * 2048;
        return MODE == 0 ? Bt + ((size_t)(b * 256) * DM + h * 256) * 2 : Bt + ((size_t)b * 1024 * 1024 + (size_t)h * 256 * 1024) * 2; }
    __device__ __forceinline__ void gather_offs(const Unit&, int, unsigned (&)[2][2]) const {}
    __device__ __forceinline__ void epi_after(Acc& acc, const Unit& u, int wr, int wc, int fr, int fq, LAS unsigned char* lds) const {
        const int b = u.e >> 2, h = u.e & 3; const int grow0 = b * SEQL + u.pm * BM;
        LAS float* redm = (LAS float*)lds; LAS float* reds = (LAS float*)(lds + 4096);
#pragma unroll
        for (int ai = 0; ai < 2; ++ai)
#pragma unroll
            for (int m = 0; m < 4; ++m) { float v = -3e38f;
#pragma unroll
                for (int bj = 0; bj < 2; ++bj)
#pragma unroll
                    for (int n = 0; n < 2; ++n) v = fmaxf(v, fmaxf(fmaxf(acc[ai][bj][m][n][0], acc[ai][bj][m][n][1]), fmaxf(acc[ai][bj][m][n][2], acc[ai][bj][m][n][3])));
                v = fmaxf(v, __shfl_xor(v, 16)); v = fmaxf(v, __shfl_xor(v, 32));
                if (fq == 0) redm[(ai * HALF + wr * 64 + m * 16 + fr) * 4 + wc] = v; }
        __syncthreads();
#pragma unroll
        for (int ai = 0; ai < 2; ++ai)
#pragma unroll
            for (int m = 0; m < 4; ++m) { const int row = ai * HALF + wr * 64 + m * 16 + fr; const f32x4 r = *(const LAS f32x4*)(redm + row * 4);
                const float M = fmaxf(fmaxf(r[0], r[1]), fmaxf(r[2], r[3])); float sm = 0.f;
#pragma unroll
                for (int bj = 0; bj < 2; ++bj)
#pragma unroll
                    for (int n = 0; n < 2; ++n)
#pragma unroll
                        for (int j = 0; j < 4; ++j) { const float e = __expf((acc[ai][bj][m][n][j] - M) * 0.0625f); acc[ai][bj][m][n][j] = e; sm += e; }
                sm += __shfl_xor(sm, 16); sm += __shfl_xor(sm, 32);
                if (fq == 0) reds[row * 4 + wc] = sm; }
        __syncthreads();
#pragma unroll
        for (int ai = 0; ai < 2; ++ai)
#pragma unroll
            for (int m = 0; m < 4; ++m) { const int row = ai * HALF + wr * 64 + m * 16 + fr; const f32x4 r = *(const LAS f32x4*)(reds + row * 4);
                const float inv = 1.f / ((r[0] + r[1]) + (r[2] + r[3]));
                bf16_t* rowp = oout + (size_t)(grow0 + row) * DM + h * 256 + wc * 32 + 4 * fq;
#pragma unroll
                for (int bj = 0; bj < 2; ++bj)
#pragma unroll
                    for (int n = 0; n < 2; ++n) { const f32x4 v = acc[ai][bj][m][n] * inv; *(u32x2*)(rowp + bj * HALF + n * 16) = (u32x2){pk2(v[0], v[1]), pk2(v[2], v[3])}; } }
        __syncthreads();
    }
    __device__ __forceinline__ void epi(const Acc& acc, const Unit& u, int wr, int wc, int fr, int fq) const {
        const int b = u.e >> 2, h = u.e & 3; const int row0 = b * SEQL + u.pm * BM + wr * 64 + fr;
        if (MODE == 0) { const int col0 = h * 256 + wc * 32 + 4 * fq;
#pragma unroll
            for (int ai = 0; ai < 2; ++ai)
#pragma unroll
                for (int m = 0; m < 4; ++m) { float* rowp = sout + (size_t)(row0 + ai * HALF + m * 16) * DM + col0;
#pragma unroll
                    for (int bj = 0; bj < 2; ++bj)
#pragma unroll
                        for (int n = 0; n < 2; ++n) *(f32x4*)(rowp + bj * HALF + n * 16) = acc[ai][bj][m][n] * 0.0625f; }
        } else { const int colt = h * 256 + wc * 32 + 8 * fq;
#pragma unroll
            for (int ai = 0; ai < 2; ++ai)
#pragma unroll
                for (int m = 0; m < 4; ++m) { bf16_t* rowp = oout + (size_t)(row0 + ai * HALF + m * 16) * DM + colt;
#pragma unroll
                    for (int bj = 0; bj < 2; ++bj) { const f32x4 v0 = acc[ai][bj][m][0], v1 = acc[ai][bj][m][1];
                        *(u32x4*)(rowp + bj * HALF) = (u32x4){pk2(v0[0], v0[1]), pk2(v0[2], v0[3]), pk2(v1[0], v1[1]), pk2(v1[2], v1[3])}; } }
        }
    }
};
__device__ __forceinline__ void phase_softmax(const Params& P) {
    const int tid = ltid(); const int lane = tid & 63, wid = __builtin_amdgcn_readfirstlane(tid >> 6); const int gw = blockIdx.x * 8 + wid, NGW = gridDim.x * 8;
    const float* S = (const float*)(P.ws + WS_MRGF); bf16_t* Pb = (bf16_t*)(P.ws + WS_QB);
    for (int r = gw; r < NTOK * 4; r += NGW) { const size_t o = (size_t)r * 256 + lane * 4;
        const f32x4 v = *(const f32x4*)(S + o);
        const float mx = wave_max(fmaxf(fmaxf(v[0], v[1]), fmaxf(v[2], v[3])));
        const float e0 = __expf(v[0] - mx), e1 = __expf(v[1] - mx), e2 = __expf(v[2] - mx), e3 = __expf(v[3] - mx);
        const float inv = 1.f / wave_sum((e0 + e1) + (e2 + e3));
        *(u32x2*)(Pb + o) = (u32x2){pk2(e0 * inv, e1 * inv), pk2(e2 * inv, e3 * inv)}; }
}

__device__ __forceinline__ void tr_item(const float* __restrict__ src, int ldn, int scol, int k0, bf16_t* dst0, int ldk, LAS unsigned char* wl, int lane) {
    float v[64];
    const bool valid = scol >= 0;
    const float* s = src + (size_t)k0 * ldn + (valid ? scol : 0);
#pragma unroll
    for (int kk = 0; kk < 64; ++kk) v[kk] = s[(size_t)kk * ldn];
#pragma unroll
    for (int c = 0; c < 8; ++c) { u32x4 w;
#pragma unroll
        for (int q = 0; q < 4; ++q) w[q] = valid ? pk2(v[8 * c + 2 * q], v[8 * c + 2 * q + 1]) : 0u;
        *(LAS u32x4*)(wl + lane * 144 + c * 16) = w; }
    WBAR();
#pragma unroll
    for (int it = 0; it < 8; ++it) { const int row = it * 8 + (lane >> 3), c16 = lane & 7; const u32x4 w = *(const LAS u32x4*)(wl + row * 144 + c16 * 16);
        *(u32x4*)(dst0 + (size_t)row * ldk + c16 * 8) = w; }
    WBAR();
}
__device__ __forceinline__ void row_to_bf16(const float* src, bf16_t* dst, int lane) {
#pragma unroll
    for (int j = 0; j < 4; ++j) { const f32x4 v = *(const f32x4*)(src + j * 256 + lane * 4); *(u32x2*)(dst + j * 256 + lane * 4) = (u32x2){pk2(v[0], v[1]), pk2(v[2], v[3])}; }
}
struct CvItem { const float* src; bf16_t* dst; int ldn, kind, n0; };
constexpr int CB_WIN = 16 * 22, CB_UP = 64, CB_SQ = 64, CB_GU = 32 * 128, CB_D = 32 * 64, CB_L = CB_WIN + CB_UP + 4 * CB_SQ + CB_GU + CB_D;
__device__ __forceinline__ CvItem cv_decode(const Params& P, int it) {
    unsigned char* ws = P.ws; CvItem t; const int l = it / CB_L; int r = it % CB_L;
    if (r < CB_WIN) { const int nt = r % 22, kt = r / 22; t.src = P.in[2] + (size_t)l * 1024 * NIN + (size_t)kt * 64 * NIN; t.ldn = NIN; t.kind = 1; t.n0 = nt * 256;
        t.dst = (bf16_t*)(ws + WS_WIN + l * SZ_WIN) + (size_t)nt * 256 * 1024 + kt * 64; return t; }
    r -= CB_WIN;
    if (r < CB_UP) { const int nt = r & 3, kt = r >> 2; const float* sp; int kk;
        if (kt < 8) { sp = P.in[13] + (size_t)l * 512 * 1024; kk = kt; } else if (kt < 12) { sp = P.in[14] + (size_t)l * 256 * 1024; kk = kt - 8; } else { sp = P.in[15] + (size_t)l * 256 * 1024; kk = kt - 12; }
        t.src = sp + (size_t)kk * 64 * 1024; t.ldn = 1024; t.kind = 0; t.n0 = nt * 256; t.dst = (bf16_t*)(ws + WS_WUP + l * SZ_SQ) + (size_t)nt * 256 * 1024 + kt * 64; return t; }
    r -= CB_UP;
    if (r < 4 * CB_SQ) { const int w = r / CB_SQ; const int rr = r % CB_SQ; const int nt = rr & 3, kt = rr >> 2;
        const int ii = w == 0 ? 16 : (w == 1 ? 20 : (w == 2 ? 21 : 22));
        const size_t wso = w == 0 ? WS_WO : (w == 1 ? WS_WK : (w == 2 ? WS_WV : WS_WXO));
        t.src = P.in[ii] + (size_t)l * 1024 * 1024 + (size_t)kt * 64 * 1024; t.ldn = 1024; t.kind = 0; t.n0 = nt * 256; t.dst = (bf16_t*)(ws + wso + l * SZ_SQ) + (size_t)nt * 256 * 1024 + kt * 64; return t; }
    r -= 4 * CB_SQ;
    if (r < CB_GU) { const int e = r >> 7; const int rr = r & 127; const int nt = rr & 7, kt = rr >> 3;
        t.src = P.in[27] + ((size_t)l * 32 + e) * 1024 * 2048 + (size_t)kt * 64 * 2048; t.ldn = 2048; t.kind = 2; t.n0 = nt * 256;
        t.dst = (bf16_t*)(ws + WS_WGU + l * SZ_WGU) + ((size_t)e * 2048 + nt * 256) * 1024 + kt * 64; return t; }
    r -= CB_GU;
    { const int e = r >> 6; const int rr = r & 63; const int nt = rr & 3, kt = rr >> 2;
        t.src = P.in[29] + ((size_t)l * 32 + e) * 1024 * 1024 + (size_t)kt * 64 * 1024; t.ldn = 1024; t.kind = 0; t.n0 = nt * 256;
        t.dst = (bf16_t*)(ws + WS_WD + l * SZ_WD) + ((size_t)e * 1024 + nt * 256) * 1024 + kt * 64; return t; }
}
__device__ __forceinline__ void cv_load(const CvItem& t, int tid, f32x4 (&v)[8]) {
    const int c4 = (tid & 63) * 4, n = t.n0 + c4; int sc;
    if (t.kind == 0) sc = n;
    else if (t.kind == 1) sc = n < COL_UV ? n : (n < COL_GL ? n + 16 : (n < NIN ? n - COL_GL + COL_UV : -1));
    else { const int g = n >> 5, w = n & 31; sc = w < 16 ? 16 * g + w : 1024 + 16 * g + (w - 16); }
    const float* sp = t.src + (size_t)(tid >> 6) * t.ldn + (sc >= 0 ? sc : 0);
#pragma unroll
    for (int i = 0; i < 8; ++i) { const f32x4 x = *(const f32x4*)(sp + (size_t)(i * 8) * t.ldn); v[i] = sc >= 0 ? x : (f32x4){0.f, 0.f, 0.f, 0.f}; }
}
__device__ __forceinline__ void cv_store(const CvItem& t, int tid, const f32x4 (&v)[8], LAS unsigned char* U) {
    const int c4 = (tid & 63) * 4, kk0 = tid >> 6;
#pragma unroll
    for (int i = 0; i < 8; ++i) { LAS unsigned* w = (LAS unsigned*)(U + (kk0 + i * 8) * 516 + c4 * 2); w[0] = pk2(v[i][0], v[i][1]); w[1] = pk2(v[i][2], v[i][3]); }
    __syncthreads();
#pragma unroll
    for (int i = 0; i < 4; ++i) { const int id = tid + i * 512; const int k8 = id & 7, n = id >> 3;
        const LAS bf16_t* rp = (const LAS bf16_t*)(U + (k8 * 8) * 516 + n * 2);
        unsigned o[4];
#pragma unroll
        for (int q = 0; q < 4; ++q) { const unsigned lo = rp[(2 * q) * 258], hi = rp[(2 * q + 1) * 258]; o[q] = lo | (hi << 16); }
        *(u32x4*)(t.dst + (size_t)n * 1024 + k8 * 8) = (u32x4){o[0], o[1], o[2], o[3]}; }
}
__device__ __forceinline__ void phase_convert(const Params& P, LAS unsigned char* lds) {
    const int tid = ltid(); const int lane = tid & 63, wid = __builtin_amdgcn_readfirstlane(tid >> 6);
    const int gw = blockIdx.x * 8 + wid, NGW = gridDim.x * 8;
    unsigned char* ws = P.ws;
    {
        const int G = gridDim.x; f32x4 va[8], vb[8];
        int it = blockIdx.x;
        if (it < 2 * CB_L) { CvItem ta = cv_decode(P, it); cv_load(ta, tid, va);
            for (;;) {
                const int it2 = it + G; const bool h2 = it2 < 2 * CB_L; CvItem tb = ta; if (h2) { tb = cv_decode(P, it2); cv_load(tb, tid, vb); }
                cv_store(ta, tid, va, lds);
                if (!h2) break;
                const int it3 = it2 + G; const bool h3 = it3 < 2 * CB_L; if (h3) { ta = cv_decode(P, it3); cv_load(ta, tid, va); }
                cv_store(tb, tid, vb, lds + 33024);
                if (!h3) break;
                it = it3;
            } }
        __syncthreads();
    }
    for (int m = gw; m < NTOK + 1024 + 2048; m += NGW) {
        if (m < NTOK) row_to_bf16(P.in[0] + (size_t)m * DM, (bf16_t*)(ws + WS_XB) + (size_t)m * DM, lane);
        else if (m >= NTOK + 1024) row_to_bf16(P.in[19] + (size_t)(m - NTOK - 1024) * DM, (bf16_t*)(ws + WS_WQ) + (size_t)(m - NTOK - 1024) * DM, lane);
        else row_to_bf16(P.in[1] + (size_t)(m - NTOK) * DM, (bf16_t*)(ws + WS_MEMB) + (size_t)(m - NTOK) * DM, lane);
    }
}

__device__ __forceinline__ bf16x8 ldfrag(const LAS bf16_t* base, int row, int stride, int k) { return *(const LAS bf16x8*)(base + row * stride + k); }

__device__ __forceinline__ void sgu_item(const Params& P, int l, int item, LAS unsigned char* lds) {
    const int tid = ltid(), lane = tid & 63, wid = tid >> 6, fr = lane & 15, fq = lane >> 4;
    const bf16_t* p = (const bf16_t*)(P.ws + WS_P); bf16_t* ycat = (bf16_t*)(P.ws + WS_YCAT);
    const int t0 = item * 128;
    LAS bf16_t* vnT = (LAS bf16_t*)lds;
    LAS bf16_t* wsb = (LAS bf16_t*)(lds + 69632);
    LAS float* red = (LAS float*)(lds + 69632 + 34816);
    {
        const int t = tid & 127, qd = tid >> 7;
        const bf16_t* src = p + (size_t)(t0 + t) * NP + COL_UV + 256 + qd * 64;
        float s = 0.f, ss = 0.f;
#pragma unroll
        for (int c = 0; c < 8; ++c) { const u32x4 w = *(const u32x4*)(src + c * 8);
#pragma unroll
            for (int q = 0; q < 4; ++q) { const float a = gelu_f(bflo(w[q])), b = gelu_f(bfhi(w[q])); s += a + b; ss += a * a + b * b; } }
        red[(t * 4 + qd) * 2] = s; red[(t * 4 + qd) * 2 + 1] = ss;
        __syncthreads();
        float S = 0.f, SS = 0.f;
#pragma unroll
        for (int q = 0; q < 4; ++q) { S += red[(t * 4 + q) * 2]; SS += red[(t * 4 + q) * 2 + 1]; }
        const float mean = S * (1.f / 256.f), var = fmaxf(SS * (1.f / 256.f) - mean * mean, 0.f), rstd = rsqrtf(var + LN_EPS);
        const float* lg = P.in[7] + l * 256 + qd * 64; const float* lb = P.in[8] + l * 256 + qd * 64;
#pragma unroll 2
        for (int c = 0; c < 8; ++c) { const u32x4 w = *(const u32x4*)(src + c * 8);
#pragma unroll
            for (int q = 0; q < 4; ++q) { const float a = gelu_f(bflo(w[q])), b = gelu_f(bfhi(w[q])); const int ch = c * 8 + 2 * q;
                vnT[(qd * 64 + ch) * 136 + t] = f2bf((a - mean) * rstd * lg[ch] + lb[ch]);
                vnT[(qd * 64 + ch + 1) * 136 + t] = f2bf((b - mean) * rstd * lg[ch + 1] + lb[ch + 1]); } }
    }
    for (int g = 0; g < 4; ++g) {
        __syncthreads();
        const float* wsg = P.in[9] + ((size_t)l * 4 + g) * 128 * 128;
#pragma unroll
        for (int i = 0; i < 4; ++i) { const int id = tid + i * 512; const int t = id >> 4, s8 = (id & 15) * 8;
            const f32x4 a = *(const f32x4*)(wsg + t * 128 + s8), b = *(const f32x4*)(wsg + t * 128 + s8 + 4);
            float w[8] = {a[0], a[1], a[2], a[3], b[0], b[1], b[2], b[3]};
#pragma unroll
            for (int q = 0; q < 8; ++q) w[q] = (s8 + q <= t) ? w[q] : 0.f;
            *(LAS u32x4*)(wsb + t * 136 + s8) = (u32x4){pk2(w[0], w[1]), pk2(w[2], w[3]), pk2(w[4], w[5]), pk2(w[6], w[7])}; }
        __syncthreads();
#pragma unroll
        for (int q = 0; q < 4; ++q) { const int tile = wid * 4 + q; const int ti = tile >> 2, di = tile & 3;
            f32x4 acc = {0.f, 0.f, 0.f, 0.f};
            const int ksmax = (ti * 16 + 15) >> 5;
            for (int ks = 0; ks <= ksmax; ++ks) {
                const bf16x8 a = ldfrag(wsb, ti * 16 + fr, 136, ks * 32 + 8 * fq), b = ldfrag(vnT, g * 64 + di * 16 + fr, 136, ks * 32 + 8 * fq);
                acc = __builtin_amdgcn_mfma_f32_16x16x32_bf16(a, b, acc, 0, 0, 0); }
            const int ch = g * 64 + di * 16 + fr;
#pragma unroll
            for (int j = 0; j < 4; ++j) { const int t = ti * 16 + 4 * fq + j;
                const float sv = acc[j] + P.in[10][((size_t)l * 4 + g) * 128 + t];
                const float u = gelu_f(bf2f(p[(size_t)(t0 + t) * NP + COL_UV + ch]));
                ycat[(size_t)(t0 + t) * DM + 512 + ch] = f2bf(u * sv); } }
    }
    __syncthreads();
}

__device__ __forceinline__ void gla1_item(const Params& P, int l, int idx, LAS unsigned char* lds) {
    const int tid = ltid();
    const bf16_t* p = (const bf16_t*)(P.ws + WS_P);
    float* bcum = (float*)(P.ws + WS_BCUM); float* kvT = (float*)(P.ws + WS_KVT); float* cdec = (float*)(P.ws + WS_CDEC);
    const int h = idx & 3, bn = idx >> 2; const int t0 = bn * 64;
    LAS float* gl = (LAS float*)lds;
    LAS float* tot = (LAS float*)(lds + 4096);
    LAS float* kt = (LAS float*)(lds + 8192);
    LAS float* vs = (LAS float*)(lds + 8192 + 16384);
#pragma unroll
    for (int i = 0; i < 2; ++i) { const int id = tid + i * 512; gl[id] = bf2f(p[(size_t)(t0 + (id >> 4)) * NP + COL_GL + (id & 15)]); }
#pragma unroll
    for (int i = 0; i < 2; ++i) { const int id = tid + i * 512; const int t = id >> 4, e8 = (id & 15) * 8;
        const u32x4 w = *(const u32x4*)(p + (size_t)(t0 + t) * NP + COL_V + h * 128 + e8);
        *(LAS f32x4*)(vs + t * 128 + e8) = (f32x4){bflo(w[0]), bfhi(w[0]), bflo(w[1]), bfhi(w[1])};
        *(LAS f32x4*)(vs + t * 128 + e8 + 4) = (f32x4){bflo(w[2]), bfhi(w[2]), bflo(w[3]), bfhi(w[3])}; }
    __syncthreads();
    {
        const int tq = tid >> 6, d = tid & 63;
        float wreg[16];
#pragma unroll
        for (int r = 0; r < 16; ++r) wreg[r] = P.in[4][((size_t)l * 16 + r) * 256 + h * 64 + d];
        const float bgv = P.in[5][l * 256 + h * 64 + d];
        float pre[8]; float run = 0.f;
#pragma unroll
        for (int i = 0; i < 8; ++i) { const int t = tq * 8 + i; float z = bgv;
#pragma unroll
            for (int r = 0; r < 16; ++r) z += gl[t * 16 + r] * wreg[r];
            const float ls = fminf(z, 0.f) - log1pf(__expf(-fabsf(z)));
            run += ls * (1.f / 16.f); pre[i] = run; }
        tot[tq * 64 + d] = run;
        __syncthreads();
        float off = 0.f, total = 0.f;
#pragma unroll
        for (int g = 0; g < 8; ++g) { const float x = tot[g * 64 + d]; total += x; off += (g < tq) ? x : 0.f; }
#pragma unroll
        for (int i = 0; i < 8; ++i) { const int t = tq * 8 + i; const float bv = off + pre[i];
            bcum[(size_t)(t0 + t) * 256 + h * 64 + d] = bv;
            kt[t * 64 + d] = bf2f(p[(size_t)(t0 + t) * NP + COL_K + h * 64 + d]) * __expf(total - bv); }
        if (tq == 0) cdec[idx * 64 + d] = __expf(total);
    }
    __syncthreads();
    {
        const int d4 = tid & 15, e4 = tid >> 4;
        f32x4 a0 = {0.f, 0.f, 0.f, 0.f}, a1 = a0, a2 = a0, a3 = a0;
        for (int t = 0; t < 64; ++t) { const f32x4 kv = *(const LAS f32x4*)(kt + t * 64 + 4 * d4), vv = *(const LAS f32x4*)(vs + t * 128 + 4 * e4);
            a0 += kv * vv[0]; a1 += kv * vv[1]; a2 += kv * vv[2]; a3 += kv * vv[3]; }
        float* o = kvT + (size_t)idx * 8192 + (4 * e4) * 64 + 4 * d4;
        *(f32x4*)(o) = a0; *(f32x4*)(o + 64) = a1; *(f32x4*)(o + 128) = a2; *(f32x4*)(o + 192) = a3;
    }
    __syncthreads();
}

__device__ __forceinline__ void pool_item(const Params& P, int l, int item, LAS unsigned char* lds) {
    const int tid = ltid(), lane = tid & 63, wid = tid >> 6, fr = lane & 15, fq = lane >> 4;
    const bf16_t* p = (const bf16_t*)(P.ws + WS_P); bf16_t* ycat = (bf16_t*)(P.ws + WS_YCAT);
    const int T0 = item * 64, pos0 = T0 & (SEQL - 1);
    LAS bf16_t* xs = (LAS bf16_t*)lds;
    LAS bf16_t* ybf = (LAS bf16_t*)(lds + 42240);
    LAS bf16_t* pwT = (LAS bf16_t*)(lds + 42240 + 33792);
#pragma unroll
    for (int i = 0; i < 5; ++i) { const int id = tid + i * 512; const int r = id >> 5, c8 = (id & 31) * 8;
        u32x4 w = {0u, 0u, 0u, 0u};
        if (pos0 - 16 + r >= 0) w = *(const u32x4*)(p + (size_t)(T0 - 16 + r) * NP + COL_XC + c8);
        *(LAS u32x4*)(xs + r * 264 + c8) = w; }
    const float* pw = P.in[11] + (size_t)l * 4 * 64 * 64;
#pragma unroll 4
    for (int i = 0; i < 32; ++i) { const int id = tid + i * 512; const int g = id >> 12, c = (id >> 6) & 63, dd = id & 63; pwT[(g * 64 + dd) * 72 + c] = f2bf(pw[id]); }
    __syncthreads();
    {
        const int ch = tid & 255, th = tid >> 8; const int gi = ch >> 6, w = 2 << gi;
        float sum = 0.f;
        for (int j = 1; j < w; ++j) sum += bf2f(xs[(16 + th * 32 - j) * 264 + ch]);
        for (int tt = 0; tt < 32; ++tt) { const int t = th * 32 + tt; const float x = bf2f(xs[(16 + t) * 264 + ch]);
            sum += x; const int pos = pos0 + t; const float cntf = (float)min(pos + 1, w);
            ybf[t * 264 + ch] = f2bf(sum / cntf - x);
            sum -= bf2f(xs[(16 + t - w + 1) * 264 + ch]); }
    }
    __syncthreads();
#pragma unroll
    for (int q = 0; q < 8; ++q) { const int tile = wid * 8 + q; const int g = tile >> 4, ti = (tile >> 2) & 3, di = tile & 3;
        f32x4 acc = {0.f, 0.f, 0.f, 0.f};
#pragma unroll
        for (int ks = 0; ks < 2; ++ks) { const bf16x8 a = ldfrag(ybf, ti * 16 + fr, 264, g * 64 + ks * 32 + 8 * fq), b = ldfrag(pwT, g * 64 + di * 16 + fr, 72, ks * 32 + 8 * fq);
            acc = __builtin_amdgcn_mfma_f32_16x16x32_bf16(a, b, acc, 0, 0, 0); }
        const int ch = g * 64 + di * 16 + fr; const float sc = P.in[12][l * 256 + ch];
#pragma unroll
        for (int j = 0; j < 4; ++j) ycat[(size_t)(T0 + ti * 16 + 4 * fq + j) * DM + 768 + ch] = f2bf(acc[j] * sc); }
    __syncthreads();
}

__device__ __forceinline__ void phase_mixer_local(const Params& P, int l, LAS unsigned char* lds) {
    constexpr int N_SGU = 128, N_GLA = 1024, N_POOL = 256;
    if (gridDim.x == 256) {
        const int b = blockIdx.x; int first, cntn;
        if (b < N_SGU) { sgu_item(P, l, b, lds); first = b * 3; cntn = 3; } else { first = 384 + (b - N_SGU) * 7; cntn = 7; }
        for (int k = 0; k < cntn; ++k) { const int it = first + k; if (it < N_GLA) gla1_item(P, l, it, lds); else pool_item(P, l, it - N_GLA, lds); }
        return;
    }
    for (int it = blockIdx.x; it < N_SGU + N_GLA + N_POOL; it += gridDim.x) {
        if (it < N_SGU) sgu_item(P, l, it, lds);
        else if (it < N_SGU + N_GLA) gla1_item(P, l, it - N_SGU, lds);
        else pool_item(P, l, it - N_SGU - N_GLA, lds);
    }
}

__device__ __forceinline__ void phase_scan(const Params& P) {
    const float* kvT = (const float*)(P.ws + WS_KVT); const float* cdec = (const float*)(P.ws + WS_CDEC); bf16_t* sT = (bf16_t*)(P.ws + WS_ST);
    for (int g = blockIdx.x * 512 + ltid(); g < 16 * 8192; g += gridDim.x * 512) {
        const int bh = g >> 13, ed = g & 8191, d = ed & 63, b = bh >> 2, h = bh & 3;
        float S = 0.f;
#pragma unroll 8
        for (int n = 0; n < 64; ++n) { const int ci = (b * 64 + n) * 4 + h;
            sT[(size_t)ci * 8192 + ed] = f2bf(S);
            S = cdec[ci * 64 + d] * S + kvT[(size_t)ci * 8192 + ed]; }
    }
}

struct G2R { u32x4 qw, kw, vw0, vw1, sw0, sw1, r0, r1; f32x4 b0, b1; };
__device__ __forceinline__ void gla2_load(const Params& P, int idx, int tid, G2R& r) {
    const bf16_t* p = (const bf16_t*)(P.ws + WS_P); const float* bcum = (const float*)(P.ws + WS_BCUM); const bf16_t* sT = (const bf16_t*)(P.ws + WS_ST);
    const int h = idx & 3, bn = idx >> 2; const int t0 = bn * 64;
    const int t = tid >> 3, c8 = (tid & 7) * 8;
    r.qw = *(const u32x4*)(p + (size_t)(t0 + t) * NP + h * 64 + c8); r.kw = *(const u32x4*)(p + (size_t)(t0 + t) * NP + COL_K + h * 64 + c8);
    r.b0 = *(const f32x4*)(bcum + (size_t)(t0 + t) * 256 + h * 64 + c8); r.b1 = *(const f32x4*)(bcum + (size_t)(t0 + t) * 256 + h * 64 + c8 + 4);
    { const int id = tid; const int tt = id >> 4, e8 = (id & 15) * 8; r.vw0 = *(const u32x4*)(p + (size_t)(t0 + tt) * NP + COL_V + h * 128 + e8); }
    { const int id = tid + 512; const int tt = id >> 4, e8 = (id & 15) * 8; r.vw1 = *(const u32x4*)(p + (size_t)(t0 + tt) * NP + COL_V + h * 128 + e8); }
    { const int id = tid; const int e = id >> 3, d8 = (id & 7) * 8; r.sw0 = *(const u32x4*)(sT + (size_t)idx * 8192 + e * 64 + d8); }
    { const int id = tid + 512; const int e = id >> 3, d8 = (id & 7) * 8; r.sw1 = *(const u32x4*)(sT + (size_t)idx * 8192 + e * 64 + d8); }
    { const int seg = tid & 7; const bf16_t* rp = p + (size_t)(t0 + t) * NP + COL_R + h * 128 + seg * 16; r.r0 = *(const u32x4*)rp; r.r1 = *(const u32x4*)(rp + 8); }
}
__device__ __forceinline__ void gla2_item(const Params& P, int l, int idx, int nidx, const G2R& R, G2R& RN, LAS unsigned char* lds) {
    const int tid = ltid(), lane = tid & 63, wid = tid >> 6, fr = lane & 15, fq = lane >> 4;
    bf16_t* ycat = (bf16_t*)(P.ws + WS_YCAT);
    const int h = idx & 3, bn = idx >> 2; const int t0 = bn * 64;
    LAS bf16_t* qd = (LAS bf16_t*)lds;
    LAS bf16_t* kd = (LAS bf16_t*)(lds + 9216);
    LAS bf16_t* vT = (LAS bf16_t*)(lds + 18432);
    LAS bf16_t* Ps = (LAS bf16_t*)(lds + 36864);
    LAS bf16_t* sTs = (LAS bf16_t*)(lds + 46080);
    LAS float* of = (LAS float*)(lds + 64512);
    {
        const int t = tid >> 3, c8 = (tid & 7) * 8;
        const u32x4 qw = R.qw, kw = R.kw; const f32x4 b0 = R.b0, b1 = R.b1;
        float bb[8] = {b0[0], b0[1], b0[2], b0[3], b1[0], b1[1], b1[2], b1[3]}; float qv[8], kv[8];
#pragma unroll
        for (int q = 0; q < 4; ++q) { qv[2 * q] = bflo(qw[q]); qv[2 * q + 1] = bfhi(qw[q]); kv[2 * q] = bflo(kw[q]); kv[2 * q + 1] = bfhi(kw[q]); }
#pragma unroll
        for (int q = 0; q < 8; ++q) { const float e = __expf(bb[q]); qv[q] = qv[q] * 0.125f * e; kv[q] = kv[q] / e; }
        *(LAS u32x4*)(qd + t * 72 + c8) = (u32x4){pk2(qv[0], qv[1]), pk2(qv[2], qv[3]), pk2(qv[4], qv[5]), pk2(qv[6], qv[7])};
        *(LAS u32x4*)(kd + t * 72 + c8) = (u32x4){pk2(kv[0], kv[1]), pk2(kv[2], kv[3]), pk2(kv[4], kv[5]), pk2(kv[6], kv[7])};
#pragma unroll
        for (int i = 0; i < 2; ++i) { const int id = tid + i * 512; const int tt = id >> 4, e8 = (id & 15) * 8;
            const u32x4 w = i == 0 ? R.vw0 : R.vw1;
#pragma unroll
            for (int q = 0; q < 4; ++q) { vT[(e8 + 2 * q) * 72 + tt] = (bf16_t)(w[q] & 0xffffu); vT[(e8 + 2 * q + 1) * 72 + tt] = (bf16_t)(w[q] >> 16); } }
#pragma unroll
        for (int i = 0; i < 2; ++i) { const int id = tid + i * 512; const int e = id >> 3, d8 = (id & 7) * 8;
            *(LAS u32x4*)(sTs + e * 72 + d8) = i == 0 ? R.sw0 : R.sw1; }
    }
    __syncthreads();
    if (nidx >= 0) gla2_load(P, nidx, tid, RN);
#pragma unroll
    for (int q = 0; q < 2; ++q) { const int tile = wid * 2 + q; const int ti = tile >> 2, si = tile & 3;
        f32x4 acc = {0.f, 0.f, 0.f, 0.f};
        if (si <= ti) {
#pragma unroll
            for (int ks = 0; ks < 2; ++ks) { const bf16x8 a = ldfrag(qd, ti * 16 + fr, 72, ks * 32 + 8 * fq), b = ldfrag(kd, si * 16 + fr, 72, ks * 32 + 8 * fq);
                acc = __builtin_amdgcn_mfma_f32_16x16x32_bf16(a, b, acc, 0, 0, 0); } }
        const int s = si * 16 + fr;
#pragma unroll
        for (int j = 0; j < 4; ++j) { const int t = ti * 16 + 4 * fq + j; Ps[t * 72 + s] = f2bf(s <= t ? acc[j] : 0.f); } }
    __syncthreads();
#pragma unroll
    for (int q = 0; q < 4; ++q) { const int tile = wid * 4 + q; const int ti = tile >> 3, ei = tile & 7;
        f32x4 acc = {0.f, 0.f, 0.f, 0.f};
#pragma unroll
        for (int ks = 0; ks < 2; ++ks) { const bf16x8 a = ldfrag(Ps, ti * 16 + fr, 72, ks * 32 + 8 * fq), b = ldfrag(vT, ei * 16 + fr, 72, ks * 32 + 8 * fq);
            acc = __builtin_amdgcn_mfma_f32_16x16x32_bf16(a, b, acc, 0, 0, 0); }
#pragma unroll
        for (int ks = 0; ks < 2; ++ks) { const bf16x8 a = ldfrag(qd, ti * 16 + fr, 72, ks * 32 + 8 * fq), b = ldfrag(sTs, ei * 16 + fr, 72, ks * 32 + 8 * fq);
            acc = __builtin_amdgcn_mfma_f32_16x16x32_bf16(a, b, acc, 0, 0, 0); }
#pragma unroll
        for (int j = 0; j < 4; ++j) of[(ti * 16 + 4 * fq + j) * 132 + ei * 16 + fr] = acc[j]; }
    __syncthreads();
    {
        const int t = tid >> 3, seg = tid & 7;
        float o[16]; float ss = 0.f;
#pragma unroll
        for (int q = 0; q < 4; ++q) { const f32x4 v = *(const LAS f32x4*)(of + t * 132 + seg * 16 + 4 * q); o[4 * q] = v[0]; o[4 * q + 1] = v[1]; o[4 * q + 2] = v[2]; o[4 * q + 3] = v[3]; ss += v[0] * v[0] + v[1] * v[1] + v[2] * v[2] + v[3] * v[3]; }
        ss += __shfl_xor(ss, 1); ss += __shfl_xor(ss, 2); ss += __shfl_xor(ss, 4);
        const float rstd = rsqrtf(ss * (1.f / 128.f) + LN_EPS);
        const float* gn = P.in[6] + l * 512 + h * 128 + seg * 16;
        const u32x4 r0 = R.r0, r1 = R.r1;
        float rv[16];
#pragma unroll
        for (int q = 0; q < 4; ++q) { rv[2 * q] = bflo(r0[q]); rv[2 * q + 1] = bfhi(r0[q]); rv[8 + 2 * q] = bflo(r1[q]); rv[8 + 2 * q + 1] = bfhi(r1[q]); }
        float y[16];
#pragma unroll
        for (int q = 0; q < 16; ++q) y[q] = o[q] * rstd * gn[q] * (rv[q] * sigmoid_f(rv[q]));
        bf16_t* yo = ycat + (size_t)(t0 + t) * DM + h * 128 + seg * 16;
        *(u32x4*)yo = (u32x4){pk2(y[0], y[1]), pk2(y[2], y[3]), pk2(y[4], y[5]), pk2(y[6], y[7])};
        *(u32x4*)(yo + 8) = (u32x4){pk2(y[8], y[9]), pk2(y[10], y[11]), pk2(y[12], y[13]), pk2(y[14], y[15])};
    }
    __syncthreads();
}

__device__ __forceinline__ void attn_item(const Params& P, int l, int item, LAS unsigned char* lds) {
    const int tid = ltid(), lane = tid & 63, wid = tid >> 6, fr = lane & 15, fq = lane >> 4;
    const int qt = item & 31, h = (item >> 5) & 3, b = item >> 7;
    const bf16_t* qb = (const bf16_t*)(P.ws + WS_QB) + (size_t)(b * SEQL + qt * 128) * DM + h * 256;
    const bf16_t* km = (const bf16_t*)(P.ws + WS_KM + l * SZ_SQ) + (size_t)(b * 256) * DM + h * 256;
    const bf16_t* vt = (const bf16_t*)(P.ws + WS_VT + l * SZ_SQ) + ((size_t)b * 1024 + h * 256) * 256;
    bf16_t* ob = (bf16_t*)(P.ws + WS_OB) + (size_t)(b * SEQL + qt * 128) * DM + h * 256;
    LAS bf16_t* QP = (LAS bf16_t*)lds;
    LAS bf16_t* KV = (LAS bf16_t*)(lds + 67584);
#pragma unroll
    for (int i = 0; i < 8; ++i) { const int id = tid + i * 512; const int r = id >> 5, c8 = (id & 31) * 8; *(LAS u32x4*)(QP + r * 264 + c8) = *(const u32x4*)(qb + (size_t)r * DM + c8); }
    u32x4 pre[4];
#pragma unroll
    for (int i = 0; i < 4; ++i) { const int id = tid + i * 512; const int r = id >> 5, c8 = (id & 31) * 8; pre[i] = *(const u32x4*)(km + (size_t)r * DM + c8); }
#pragma unroll
    for (int i = 0; i < 4; ++i) { const int id = tid + i * 512; const int r = id >> 5, c8 = (id & 31) * 8; *(LAS u32x4*)(KV + r * 264 + c8) = pre[i]; }
    __syncthreads();
#ifdef ATT_DBG0
    {
#if ATT_DBG0 == 1
#pragma unroll
    for (int i = 0; i < 8; ++i) { const int id = tid + i * 512; const int r = id >> 5, c8 = (id & 31) * 8; *(u32x4*)(ob + (size_t)r * DM + c8) = *(const LAS u32x4*)(QP + r * 264 + c8); }
#else
#pragma unroll
    for (int i = 0; i < 4; ++i) { const int id = tid + i * 512; const int r = id >> 5, c8 = (id & 31) * 8; *(u32x4*)(ob + (size_t)r * DM + c8) = *(const LAS u32x4*)(KV + r * 264 + c8); *(u32x4*)(ob + (size_t)(r + 64) * DM + c8) = *(const LAS u32x4*)(KV + r * 264 + c8); }
#endif
    __syncthreads(); return; }
#endif
    bf16x8 aq[8];
#pragma unroll
    for (int ks = 0; ks < 8; ++ks) aq[ks] = ldfrag(QP, wid * 16 + fr, 264, ks * 32 + 8 * fq);
    f32x4 acc[16];
#pragma unroll
    for (int i = 0; i < 16; ++i) acc[i] = (f32x4){0.f, 0.f, 0.f, 0.f};
#pragma unroll
    for (int c = 0; c < 4; ++c) {
#pragma unroll
        for (int kt = 0; kt < 4; ++kt)
#pragma unroll
            for (int ks = 0; ks < 8; ++ks) acc[c * 4 + kt] = __builtin_amdgcn_mfma_f32_16x16x32_bf16(aq[ks], ldfrag(KV, kt * 16 + fr, 264, ks * 32 + 8 * fq), acc[c * 4 + kt], 0, 0, 0);
        __syncthreads();
#pragma unroll
        for (int i = 0; i < 4; ++i) { const int id = tid + i * 512; const int r = id >> 5, c8 = (id & 31) * 8;
            *(LAS u32x4*)(KV + r * 264 + c8) = (c < 3) ? *(const u32x4*)(km + (size_t)((c + 1) * 64 + r) * DM + c8) : *(const u32x4*)(vt + (size_t)r * 256 + c8); }
        __syncthreads();
    }
#ifdef ATT_DBG1
    {
#pragma unroll
    for (int i = 0; i < 16; ++i)
#pragma unroll
        for (int j = 0; j < 4; ++j) ob[(size_t)(wid * 16 + 4 * fq + j) * DM + i * 16 + fr] = f2bf(acc[i][j]);
    return; }
#endif
#pragma unroll
    for (int j = 0; j < 4; ++j) {
        float mx = -1e30f;
#pragma unroll
        for (int i = 0; i < 16; ++i) mx = fmaxf(mx, acc[i][j]);
        mx = fmaxf(mx, __shfl_xor(mx, 1)); mx = fmaxf(mx, __shfl_xor(mx, 2)); mx = fmaxf(mx, __shfl_xor(mx, 4)); mx = fmaxf(mx, __shfl_xor(mx, 8));
        float sm = 0.f;
#pragma unroll
        for (int i = 0; i < 16; ++i) { const float e = __expf((acc[i][j] - mx) * 0.0625f); acc[i][j] = e; sm += e; }
        sm += __shfl_xor(sm, 1); sm += __shfl_xor(sm, 2); sm += __shfl_xor(sm, 4); sm += __shfl_xor(sm, 8);
        const float inv = 1.f / sm;
#pragma unroll
        for (int i = 0; i < 16; ++i) QP[(wid * 16 + 4 * fq + j) * 264 + i * 16 + fr] = f2bf(acc[i][j] * inv);
    }
    WBAR();
#pragma unroll
    for (int ks = 0; ks < 8; ++ks) aq[ks] = ldfrag(QP, wid * 16 + fr, 264, ks * 32 + 8 * fq);
#pragma unroll
    for (int i = 0; i < 16; ++i) acc[i] = (f32x4){0.f, 0.f, 0.f, 0.f};
#pragma unroll
    for (int c = 0; c < 4; ++c) {
#pragma unroll
        for (int dt = 0; dt < 4; ++dt)
#pragma unroll
            for (int ks = 0; ks < 8; ++ks) acc[c * 4 + dt] = __builtin_amdgcn_mfma_f32_16x16x32_bf16(aq[ks], ldfrag(KV, dt * 16 + fr, 264, ks * 32 + 8 * fq), acc[c * 4 + dt], 0, 0, 0);
        __syncthreads();
        if (c < 3) {
#pragma unroll
            for (int i = 0; i < 4; ++i) { const int id = tid + i * 512; const int r = id >> 5, c8 = (id & 31) * 8; *(LAS u32x4*)(KV + r * 264 + c8) = *(const u32x4*)(vt + (size_t)((c + 1) * 64 + r) * 256 + c8); } }
        __syncthreads();
    }
#pragma unroll
    for (int i = 0; i < 16; ++i)
#pragma unroll
        for (int j = 0; j < 4; ++j) ob[(size_t)(wid * 16 + 4 * fq + j) * DM + i * 16 + fr] = f2bf(acc[i][j]);
}

__device__ __forceinline__ void ln_core(f32x4 (&v)[4], const float* g, const float* b, int lane) {
    float s = 0.f;
#pragma unroll
    for (int j = 0; j < 4; ++j) s += (v[j][0] + v[j][1]) + (v[j][2] + v[j][3]);
    const float mean = wave_sum(s) * (1.f / DM);
    float s2 = 0.f;
#pragma unroll
    for (int j = 0; j < 4; ++j) { v[j] = v[j] - mean; s2 += (v[j][0] * v[j][0] + v[j][1] * v[j][1]) + (v[j][2] * v[j][2] + v[j][3] * v[j][3]); }
    const float rstd = rsqrtf(wave_sum(s2) * (1.f / DM) + LN_EPS);
#pragma unroll
    for (int j = 0; j < 4; ++j) { const f32x4 gg = *(const f32x4*)(g + j * 256 + lane * 4), bb = *(const f32x4*)(b + j * 256 + lane * 4); v[j] = v[j] * rstd * gg + bb; }
}
__device__ __forceinline__ void ln_store(const f32x4 (&v)[4], float* of, bf16_t* obf, int lane) {
#pragma unroll
    for (int j = 0; j < 4; ++j) { *(f32x4*)(of + j * 256 + lane * 4) = v[j]; if (obf) *(u32x2*)(obf + j * 256 + lane * 4) = (u32x2){pk2(v[j][0], v[j][1]), pk2(v[j][2], v[j][3])}; }
}
__device__ __forceinline__ void phase_ln1(const Params& P, int l) {
    const int tid = ltid(); const int lane = tid & 63, wid = __builtin_amdgcn_readfirstlane(tid >> 6); const int gw = blockIdx.x * 8 + wid, NGW = gridDim.x * 8;
    const float* y = (const float*)(P.ws + WS_YBUF); float* xf = (float*)(P.ws + WS_XF); bf16_t* xb = (bf16_t*)(P.ws + WS_XB);
    for (int m = gw; m < NTOK; m += NGW) { f32x4 v[4];
#pragma unroll
        for (int j = 0; j < 4; ++j) v[j] = *(const f32x4*)(y + (size_t)m * DM + j * 256 + lane * 4);
        ln_core(v, P.in[17] + l * DM, P.in[18] + l * DM, lane);
        ln_store(v, xf + (size_t)m * DM, xb + (size_t)m * DM, lane); }
}
__device__ __forceinline__ void phase_ln2_router(const Params& P, int l, LAS unsigned char* lds) {
    const int tid = ltid(); const int lane = tid & 63, wid = __builtin_amdgcn_readfirstlane(tid >> 6); const int gw = blockIdx.x * 8 + wid, NGW = gridDim.x * 8;
    const float* y = (const float*)(P.ws + WS_YBUF); float* xf = (float*)(P.ws + WS_XF); bf16_t* xb = (bf16_t*)(P.ws + WS_XB);
    int* cnt = (int*)(P.ws + WS_CTL) + l * 32; int* elist = (int*)(P.ws + WS_ELIST); float* tgate = (float*)(P.ws + WS_TGATE);
    LAS float* xs = (LAS float*)(lds + wid * 16384);
    const float* rw = P.in[25] + (size_t)l * 1024 * 32; const float* rb = P.in[26] + l * 32;
    for (int pr = gw; pr < NTOK / 4; pr += NGW) {
#pragma unroll
        for (int rr = 0; rr < 4; ++rr) { const int m = pr * 4 + rr; f32x4 v[4];
#pragma unroll
            for (int j = 0; j < 4; ++j) v[j] = *(const f32x4*)(y + (size_t)m * DM + j * 256 + lane * 4);
            ln_core(v, P.in[23] + l * DM, P.in[24] + l * DM, lane);
            ln_store(v, xf + (size_t)m * DM, xb + (size_t)m * DM, lane);
#pragma unroll
            for (int j = 0; j < 4; ++j) *(LAS f32x4*)(xs + rr * 1024 + j * 256 + lane * 4) = v[j]; }
        WBAR();
        const int e = lane & 31, hf = lane >> 5;
        float a[4] = {0.f, 0.f, 0.f, 0.f};
        for (int kb = 0; kb < 16; ++kb) { const int k0 = hf * 512 + kb * 32;
            float w[32];
#pragma unroll
            for (int j = 0; j < 32; ++j) w[j] = rw[(k0 + j) * 32 + e];
#pragma unroll
            for (int j4 = 0; j4 < 8; ++j4)
#pragma unroll
                for (int rr = 0; rr < 4; ++rr) { const f32x4 x = *(const LAS f32x4*)(xs + rr * 1024 + k0 + j4 * 4);
                    a[rr] += x[0] * w[4 * j4]; a[rr] += x[1] * w[4 * j4 + 1]; a[rr] += x[2] * w[4 * j4 + 2]; a[rr] += x[3] * w[4 * j4 + 3]; } }
        const float bias = rb[e];
#pragma unroll
        for (int rr = 0; rr < 4; ++rr) { const int m = pr * 4 + rr;
            float lg = a[rr] + __shfl_xor(a[rr], 32) + bias; lg = (lg == lg) ? fminf(fmaxf(lg, -1e30f), 1e30f) : -1e30f; float v = (lane < 32) ? lg : -3e38f;
            float tv[4]; int te[4];
#pragma unroll
            for (int k = 0; k < 4; ++k) { const float mx = wave_max(v); const unsigned long long bal = __ballot(v == mx); const int idx = (__ffsll((long long)bal) - 1) & 31; tv[k] = mx; te[k] = idx; if (lane == idx) v = -3e38f; }
            const float e1 = __expf(tv[1] - tv[0]), e2 = __expf(tv[2] - tv[0]), e3 = __expf(tv[3] - tv[0]); const float inv = 1.f / (1.f + e1 + e2 + e3);
            if (lane < 4) { const int ee = lane == 0 ? te[0] : (lane == 1 ? te[1] : (lane == 2 ? te[2] : te[3])); const float gg = (lane == 0 ? 1.f : (lane == 1 ? e1 : (lane == 2 ? e2 : e3))) * inv;
                const int pos = atomicAdd(cnt + ee, 1); elist[ee * ECAP + pos] = m * 4 + lane; tgate[m * 4 + lane] = gg; } }
        WBAR();
    }
}
__device__ __forceinline__ void phase_router_old(const Params& P, int l, LAS unsigned char* lds) {
    const int tid = ltid(); const int lane = tid & 63, wid = __builtin_amdgcn_readfirstlane(tid >> 6); const int gw = blockIdx.x * 8 + wid, NGW = gridDim.x * 8;
    const float* y = (const float*)(P.ws + WS_YBUF); float* xf = (float*)(P.ws + WS_XF); bf16_t* xb = (bf16_t*)(P.ws + WS_XB);
    int* cnt = (int*)(P.ws + WS_CTL) + l * 32; int* elist = (int*)(P.ws + WS_ELIST); float* tgate = (float*)(P.ws + WS_TGATE);
    LAS float* xs = (LAS float*)(lds + wid * 16384);
    const float* rw = P.in[25] + (size_t)l * 1024 * 32; const float* rb = P.in[26] + l * 32;
    for (int pr = gw; pr < NTOK / 4; pr += NGW) {
#pragma unroll
        for (int rr = 0; rr < 4; ++rr) { const int m = pr * 4 + rr; f32x4 v[4];
#pragma unroll
            for (int j = 0; j < 4; ++j) v[j] = *(const f32x4*)(xf + (size_t)m * DM + j * 256 + lane * 4);
#pragma unroll
            for (int j = 0; j < 4; ++j) *(LAS f32x4*)(xs + rr * 1024 + j * 256 + lane * 4) = v[j]; }
        WBAR();
        const int e = lane & 31, hf = lane >> 5;
        float a[4] = {0.f, 0.f, 0.f, 0.f};
        for (int kb = 0; kb < 16; ++kb) { const int k0 = hf * 512 + kb * 32;
            float w[32];
#pragma unroll
            for (int j = 0; j < 32; ++j) w[j] = rw[(k0 + j) * 32 + e];
#pragma unroll
            for (int j4 = 0; j4 < 8; ++j4)
#pragma unroll
                for (int rr = 0; rr < 4; ++rr) { const f32x4 x = *(const LAS f32x4*)(xs + rr * 1024 + k0 + j4 * 4);
                    a[rr] += x[0] * w[4 * j4]; a[rr] += x[1] * w[4 * j4 + 1]; a[rr] += x[2] * w[4 * j4 + 2]; a[rr] += x[3] * w[4 * j4 + 3]; } }
        const float bias = rb[e];
#pragma unroll
        for (int rr = 0; rr < 4; ++rr) { const int m = pr * 4 + rr;
            float lg = a[rr] + __shfl_xor(a[rr], 32) + bias; lg = (lg == lg) ? fminf(fmaxf(lg, -1e30f), 1e30f) : -1e30f; float v = (lane < 32) ? lg : -3e38f;
            float tv[4]; int te[4];
#pragma unroll
            for (int k = 0; k < 4; ++k) { const float mx = wave_max(v); const unsigned long long bal = __ballot(v == mx); const int idx = (__ffsll((long long)bal) - 1) & 31; tv[k] = mx; te[k] = idx; if (lane == idx) v = -3e38f; }
            const float e1 = __expf(tv[1] - tv[0]), e2 = __expf(tv[2] - tv[0]), e3 = __expf(tv[3] - tv[0]); const float inv = 1.f / (1.f + e1 + e2 + e3);
            if (lane < 4) { const int ee = lane == 0 ? te[0] : (lane == 1 ? te[1] : (lane == 2 ? te[2] : te[3])); const float gg = (lane == 0 ? 1.f : (lane == 1 ? e1 : (lane == 2 ? e2 : e3))) * inv;
                const int pos = atomicAdd(cnt + ee, 1); elist[ee * ECAP + pos] = m * 4 + lane; tgate[m * 4 + lane] = gg; } }
        WBAR();
    }
}
__device__ __forceinline__ void phase_router(const Params& P, int l, LAS unsigned char* lds) {
    if (gridDim.x != 256) { phase_router_old(P, l, lds); return; }
    const int tid = ltid(); const int lane = tid & 63, wid = __builtin_amdgcn_readfirstlane(tid >> 6); const int gw = blockIdx.x * 8 + wid, NGW = gridDim.x * 8;
    const float* xf = (const float*)(P.ws + WS_XF);
    int* cnt = (int*)(P.ws + WS_CTL) + l * 32; int* elist = (int*)(P.ws + WS_ELIST); float* tgate = (float*)(P.ws + WS_TGATE);
    LAS float* xs = (LAS float*)(lds + wid * 16384);
    LAS int* lcnt = (LAS int*)(lds + 131072 + 256); LAS int* lbase = (LAS int*)(lds + 131072 + 384);
    const float* rw = P.in[25] + (size_t)l * 1024 * 32; const float* rb = P.in[26] + l * 32;
    if (tid < 32) lcnt[tid] = 0;
    __syncthreads();
    int rec_e[2][4], rec_p[2][4];
    {
        const int e = lane & 31, hf = lane >> 5;
        float a[8] = {0.f, 0.f, 0.f, 0.f, 0.f, 0.f, 0.f, 0.f};
#pragma unroll 1
        for (int ps = 0; ps < 2; ++ps) {
#pragma unroll
            for (int r8 = 0; r8 < 8; ++r8) { const int m = (gw + (r8 >> 2) * NGW) * 4 + (r8 & 3);
#pragma unroll
                for (int j = 0; j < 2; ++j) *(LAS f32x4*)(xs + r8 * 512 + j * 256 + lane * 4) = *(const f32x4*)(xf + (size_t)m * DM + ps * 512 + j * 256 + lane * 4); }
            WBAR();
            for (int kb = 0; kb < 8; ++kb) { const int kl = hf * 256 + kb * 32;
                float w[32];
#pragma unroll
                for (int j = 0; j < 32; ++j) w[j] = rw[(ps * 512 + kl + j) * 32 + e];
#pragma unroll
                for (int j4 = 0; j4 < 8; ++j4)
#pragma unroll
                    for (int r8 = 0; r8 < 8; ++r8) { const f32x4 x = *(const LAS f32x4*)(xs + r8 * 512 + kl + j4 * 4);
                        a[r8] += x[0] * w[4 * j4]; a[r8] += x[1] * w[4 * j4 + 1]; a[r8] += x[2] * w[4 * j4 + 2]; a[r8] += x[3] * w[4 * j4 + 3]; } }
            WBAR();
        }
        const float bias = rb[e];
#pragma unroll
        for (int r8 = 0; r8 < 8; ++r8) { const int q = r8 >> 2, rr = r8 & 3; const int m = (gw + q * NGW) * 4 + rr;
            float lg = a[r8] + __shfl_xor(a[r8], 32) + bias; lg = (lg == lg) ? fminf(fmaxf(lg, -1e30f), 1e30f) : -1e30f; float v = (lane < 32) ? lg : -3e38f;
            float tv[4]; int te[4];
#pragma unroll
            for (int k = 0; k < 4; ++k) { const float mx = wave_max(v); const unsigned long long bal = __ballot(v == mx); const int idx = (__ffsll((long long)bal) - 1) & 31; tv[k] = mx; te[k] = idx; if (lane == idx) v = -3e38f; }
            const float e1 = __expf(tv[1] - tv[0]), e2 = __expf(tv[2] - tv[0]), e3 = __expf(tv[3] - tv[0]); const float inv = 1.f / (1.f + e1 + e2 + e3);
            rec_e[q][rr] = 0; rec_p[q][rr] = 0;
            if (lane < 4) { const int ee = lane == 0 ? te[0] : (lane == 1 ? te[1] : (lane == 2 ? te[2] : te[3])); const float gg = (lane == 0 ? 1.f : (lane == 1 ? e1 : (lane == 2 ? e2 : e3))) * inv;
                rec_e[q][rr] = ee; rec_p[q][rr] = __hip_atomic_fetch_add(lcnt + ee, 1, __ATOMIC_RELAXED, __HIP_MEMORY_SCOPE_WORKGROUP); tgate[m * 4 + lane] = gg; } }
    }
    __syncthreads();
    if (tid < 32) lbase[tid] = atomicAdd(cnt + tid, lcnt[tid]);
    __syncthreads();
    if (lane < 4) {
#pragma unroll
        for (int q = 0; q < 2; ++q)
#pragma unroll
            for (int rr = 0; rr < 4; ++rr) { const int m = (gw + q * NGW) * 4 + rr; const int ee = rec_e[q][rr]; elist[ee * ECAP + lbase[ee] + rec_p[q][rr]] = m * 4 + lane; } }
    __syncthreads();
}
__device__ __forceinline__ void phase_ln3(const Params& P, int l) {
    const int tid = ltid(); const int lane = tid & 63, wid = __builtin_amdgcn_readfirstlane(tid >> 6); const int gw = blockIdx.x * 8 + wid, NGW = gridDim.x * 8;
    float* xf = (float*)(P.ws + WS_XF); bf16_t* xb = (bf16_t*)(P.ws + WS_XB); const bf16_t* ys = (const bf16_t*)(P.ws + WS_YS);
    for (int m = gw; m < NTOK; m += NGW) { f32x4 v[4];
#pragma unroll
        for (int j = 0; j < 4; ++j) { v[j] = *(const f32x4*)(xf + (size_t)m * DM + j * 256 + lane * 4) * ALPHA;
#pragma unroll
            for (int k = 0; k < 4; ++k) { const u32x2 w = *(const u32x2*)(ys + ((size_t)m * 4 + k) * DM + j * 256 + lane * 4); v[j] += (f32x4){bflo(w[0]), bfhi(w[0]), bflo(w[1]), bfhi(w[1])}; } }
        ln_core(v, P.in[31] + l * DM, P.in[32] + l * DM, lane);
        if (l == 1) ln_store(v, P.out + (size_t)m * DM, nullptr, lane); else ln_store(v, xf + (size_t)m * DM, xb + (size_t)m * DM, lane); }
}

__device__ __forceinline__ void set_base(ProbBase& S, const void* A, int lda, const void* Bt, int ldb, int M, int N, int K, int G, int c) { S.A = (const char*)A; S.Bt = (const char*)Bt; S.init(M, N, G, c); }

typedef const Params __attribute__((address_space(4))) CParams;
__global__ void __launch_bounds__(512, 2) mega(Params Pk) {
    extern __shared__ __attribute__((aligned(16))) unsigned char smem[];
    LAS unsigned char* lds = (LAS unsigned char*)smem;
    cg::grid_group grid = cg::this_grid();
    CParams* kp = (CParams*)__builtin_amdgcn_kernarg_segment_ptr();
    const int lo = Pk.ph_lo, hi = Pk.ph_hi;
    int nbar = 0;
#ifndef PHMASK
#define PHMASK 0xffffffffu
#endif
#define EN(k) (((PHMASK) >> (k)) & 1u)
#ifndef REPMASK
#define REPMASK 0u
#endif
#define NREP(k) ((((REPMASK) >> (k)) & 1u) ? 2 : 1)
#define RB(k) for (int rep_ = 0; rep_ < NREP(k); ++rep_) { if (rep_) GRID_BARRIER();
#define RE }
#define GRID_BARRIER() do { asm volatile("s_waitcnt vmcnt(0) lgkmcnt(0)" ::: "memory"); __syncthreads(); \
        if (nbar == 0) grid.sync(); \
        if (ltid() == 0) { unsigned* bw = (unsigned*)(kp->ws + WS_CTL + 1024) + nbar * 160; const unsigned gx = gridDim.x, sg = blockIdx.x & 7u; const unsigned nsub = (gx + 7u - sg) >> 3; const unsigned ngrp = gx < 8u ? gx : 8u; \
            __builtin_amdgcn_fence(__ATOMIC_RELEASE, "agent"); asm volatile("s_waitcnt vmcnt(0)" ::: "memory"); \
            const unsigned old = __hip_atomic_fetch_add(bw + 16 + sg * 16, 1u, __ATOMIC_RELAXED, __HIP_MEMORY_SCOPE_AGENT); \
            if (old + 1u == nsub) __hip_atomic_fetch_add(bw, 1u, __ATOMIC_RELAXED, __HIP_MEMORY_SCOPE_AGENT); \
            while (__hip_atomic_load(bw, __ATOMIC_RELAXED, __HIP_MEMORY_SCOPE_AGENT) < ngrp) __builtin_amdgcn_s_sleep(1); \
            __builtin_amdgcn_fence(__ATOMIC_ACQUIRE, "agent"); asm volatile("s_waitcnt vmcnt(0)" ::: "memory"); } \
        __syncthreads(); ++nbar; } while (0)
#define LOCAL_SYNC() do { asm volatile("s_waitcnt vmcnt(0) lgkmcnt(0)" ::: "memory"); __syncthreads(); if (ltid() < 64) { asm volatile("buffer_inv sc1\n\ts_waitcnt vmcnt(0)" ::: "memory"); } __syncthreads(); } while (0)
#define PH_BEGIN(id) if ((id) >= lo && (id) < hi) { CParams* kq = kp; asm volatile("" : "+s"(kq)); const Params& P = *(const Params*)kq; unsigned char* ws = P.ws; \
        int G = gridDim.x, bx = blockIdx.x; asm volatile("" : "+s"(G), "+s"(bx)); (void)ws; (void)G; (void)bx;
#define PH_END(id) if ((id) + 1 < hi) GRID_BARRIER(); }
    PH_BEGIN(0) if (EN(0)) RB(0) phase_convert(P, lds);  RE PH_END(0)
#define LAYER(l, B) \
    PH_BEGIN(B + 0) if (EN(1)) RB(1) { \
        { ProbInProj S; set_base(S, ws + WS_XB, 2048, ws + WS_WIN + l * SZ_WIN, 2048, NTOK, NP, 1024, G, bx); S.out = (bf16_t*)(ws + WS_P); S.bias = P.in[3] + (size_t)l * NIN; gemm_phase(lds, S); } \
        { ProbBf16 S; set_base(S, ws + WS_MEMB, 2048, ws + WS_WK + l * SZ_SQ, 2048, 1024, 1024, 1024, G, (bx + G - 128) % G); S.out = (bf16_t*)(ws + WS_KM + l * SZ_SQ); S.ldc = 1024; gemm_phase(lds, S); } \
        { ProbBf16 S; set_base(S, ws + WS_MEMB, 2048, ws + WS_WV + l * SZ_SQ, 2048, 1024, 1024, 1024, G, (bx + G - 144) % G); S.out = (bf16_t*)(ws + WS_VT + l * SZ_SQ); S.ldc = 1024; gemm_phase(lds, S); } }  RE PH_END(B + 0) \
    PH_BEGIN(B + 1) if (EN(2)) RB(2) phase_mixer_local(P, l, lds);  RE PH_END(B + 1) \
    PH_BEGIN(B + 2) if (EN(3)) RB(3) { phase_scan(P); \
        { ProbVW S; S.A = (const char*)(ws + WS_WXO + l * SZ_SQ); S.Bt = (const char*)(ws + WS_VT + l * SZ_SQ); S.G = G; S.c = bx; S.out = (bf16_t*)(ws + WS_VT + 2 * SZ_SQ); gemm_phase(lds, S); } \
        { ProbMT S; S.A = (const char*)(ws + WS_KM + l * SZ_SQ); S.Bt = (const char*)(ws + WS_WQ + l * SZ_SQ); S.G = G; S.c = (bx + G - 64) % G; S.out = (bf16_t*)(ws + WS_QB); gemm_phase(lds, S); } }  RE PH_END(B + 2) \
    PH_BEGIN(B + 3) if (EN(4)) RB(4) { G2R ra, rb; int it = bx; if (it < 1024) { gla2_load(P, it, ltid(), ra); for (;;) { const int i2 = it + G; const bool h2 = i2 < 1024; gla2_item(P, l, it, h2 ? i2 : -1, ra, rb, lds); if (!h2) break; const int i3 = i2 + G; const bool h3 = i3 < 1024; gla2_item(P, l, i2, h3 ? i3 : -1, rb, ra, lds); if (!h3) break; it = i3; } } }  RE PH_END(B + 3) \
    PH_BEGIN(B + 4) if (EN(5)) RB(5) { { ProbMerge<512> S; S.A = (const char*)(ws + WS_YCAT); S.Bt = (const char*)(ws + WS_WUP + l * SZ_SQ); S.G = G; S.c = bx; \
            S.p = (const bf16_t*)(ws + WS_P); S.mb = (bf16_t*)(ws + WS_MRGB); gemm_phase(lds, S); } \
            asm volatile("s_waitcnt vmcnt(0)" ::: "memory"); __syncthreads(); \
            { ProbMerge<256> S; S.A = (const char*)(ws + WS_YCAT); S.Bt = (const char*)(ws + WS_WUP + l * SZ_SQ); S.G = G; S.c = bx; \
            S.p = (const bf16_t*)(ws + WS_P); S.mb = (bf16_t*)(ws + WS_MRGB); gemm_phase(lds, S); } }  RE PH_END(B + 4) \
    PH_BEGIN(B + 5) if (EN(6)) RB(6) { ProbResLN S; set_base(S, ws + WS_MRGB, 2048, ws + WS_WO + l * SZ_SQ, 2048, NTOK, 1024, 1024, G, bx); \
            S.xres = (l == 0) ? P.in[0] : (const float*)(ws + WS_XF); S.lng = P.in[17] + l * DM; S.lnb = P.in[18] + l * DM; S.xf = (float*)(ws + WS_XF); S.xb = (bf16_t*)(ws + WS_XB); \
            S.stats = (float*)(ws + WS_STATS); S.cntp = (unsigned*)(ws + WS_CTL + 24576) + (l * 2 + 0) * 64; S.bstride = 0; gemm_phase(lds, S); }  RE PH_END(B + 5) \
    PH_BEGIN(B + 7) if (EN(8)) RB(8) { ProbAttn<0, 1024> S; S.A = (const char*)(ws + WS_XB); S.Bt = (const char*)(ws + WS_QB); S.G = G; S.c = bx; S.sout = nullptr; S.oout = (bf16_t*)(ws + WS_MRGF); gemm_phase(lds, S); }  RE PH_END(B + 7) \
    PH_BEGIN(B + 10) if (EN(6)) RB(6) { ProbResLN S; set_base(S, ws + WS_MRGF, 2048, ws + WS_VT + 2 * SZ_SQ, 2048, NTOK, 1024, 1024, G, bx); \
            S.xres = (const float*)(ws + WS_XF); S.lng = P.in[23] + l * DM; S.lnb = P.in[24] + l * DM; S.xf = (float*)(ws + WS_XF); S.xb = (bf16_t*)(ws + WS_XB); \
            S.stats = (float*)(ws + WS_STATS); S.cntp = (unsigned*)(ws + WS_CTL + 24576) + (l * 2 + 1) * 64; S.bstride = SZ_SQ; gemm_phase(lds, S); }  RE PH_END(B + 10) \
    PH_BEGIN(B + 11) if (EN(10)) RB(10) phase_router(P, l, lds);  RE PH_END(B + 11) \
    PH_BEGIN(B + 12) if (EN(11)) RB(11) { LAS int* tstart = (LAS int*)(lds + 131072); const int* cnt = (const int*)(ws + WS_CTL) + l * 32; \
            if (ltid() == 0) { int a = 0; for (int e = 0; e < 32; ++e) { tstart[e] = a; a += (cnt[e] + 255) >> 8; } tstart[32] = a; } \
            __syncthreads(); \
            ProbMoe1 S; S.G = G; S.c = (G % 8 == 0) ? (bx % 8) * (G / 8) + bx / 8 : bx; S.nN = 8; S.tstart = tstart; S.cnt = cnt; \
            S.A = (const char*)(ws + WS_XB); S.Bt = (const char*)(ws + WS_WGU + l * SZ_WGU); \
            S.elist = (const int*)(ws + WS_ELIST); S.bgu = P.in[28] + (size_t)l * 32 * 2048; S.abuf = (bf16_t*)(ws + WS_ABUF); gemm_phase(lds, S); }  RE PH_END(B + 12) \
    PH_BEGIN(B + 13) if (EN(12)) RB(12) { LAS int* tstart = (LAS int*)(lds + 131072); const int* cnt = (const int*)(ws + WS_CTL) + l * 32; \
            if (ltid() == 0) { int a = 0; for (int e = 0; e < 32; ++e) { tstart[e] = a; a += (cnt[e] + 255) >> 8; } tstart[32] = a; } \
            __syncthreads(); \
            ProbMoe2 S; S.G = G; S.c = (G % 8 == 0) ? (bx % 8) * (G / 8) + bx / 8 : bx; S.nN = 4; S.tstart = tstart; S.cnt = cnt; \
            S.A = (const char*)(ws + WS_ABUF); S.Bt = (const char*)(ws + WS_WD + l * SZ_WD); \
            S.elist = (const int*)(ws + WS_ELIST); S.bd = P.in[30] + (size_t)l * 32 * 1024; S.tgate = (const float*)(ws + WS_TGATE); S.ys = (bf16_t*)(ws + WS_YS); gemm_phase(lds, S); }  RE PH_END(B + 13) \
    PH_BEGIN(B + 14) if (EN(13)) RB(13) phase_ln3(P, l);  RE PH_END(B + 14)
    LAYER(0, 1)
    LAYER(1, 16)
#ifdef EXTRA_BARS
    for (int xb_ = 0; xb_ < EXTRA_BARS; ++xb_) GRID_BARRIER();
#endif
#ifdef DBG_OFF
    { GRID_BARRIER(); const Params& P = *(const Params*)kp; const int G = gridDim.x, bx = blockIdx.x; const int gt = bx * 512 + ltid();
      for (size_t i = gt; i < (size_t)NTOK * DM; i += (size_t)G * 512) {
#if DBG_BF16
          { float dv = bf2f(((const bf16_t*)(P.ws + DBG_OFF))[i]); P.out[i] = (dv == dv && fabsf(dv) < 1e30f) ? dv : 1000.f; }
#else
          P.out[i] = ((const float*)(P.ws + DBG_OFF))[i];
#endif
      } }
#endif
}

extern "C" void kernel_launch(void* const* d_in, const int* in_sizes, int n_in, void* d_out, int out_size, void* d_ws, size_t ws_size, hipStream_t stream) {
    static int grid = 0;
    if (grid == 0) {
        int dev = 0, cus = 0, per_cu = 0;
        hipGetDevice(&dev);
        hipDeviceGetAttribute(&cus, hipDeviceAttributeMultiprocessorCount, dev);
        hipFuncSetAttribute((const void*)mega, hipFuncAttributeMaxDynamicSharedMemorySize, LDS_BYTES);
        hipOccupancyMaxActiveBlocksPerMultiprocessor(&per_cu, (const void*)mega, 512, LDS_BYTES);
        if (per_cu < 1) per_cu = 1;
        grid = cus < 256 ? cus : 256;
        if (ws_size < WS_END) fprintf(stderr, "kernel_launch: workspace too small: %zu < %zu\n", ws_size, (size_t)WS_END);
        if (n_in != 33) fprintf(stderr, "kernel_launch: expected 33 inputs, got %d\n", n_in);
    }
    hipMemsetAsync((char*)d_ws + WS_CTL, 0, 32768, stream);
    Params p{};
    for (int i = 0; i < 33; ++i) p.in[i] = (const float*)d_in[i];
    p.out = (float*)d_out; p.ws = (unsigned char*)d_ws; p.ph_lo = 0; p.ph_hi = PH_HI;
    void* args[] = {&p};
    hipError_t e = hipLaunchCooperativeKernel((const void*)mega, dim3(grid), dim3(512), args, LDS_BYTES, stream);
    if (e != hipSuccess) fprintf(stderr, "cooperative launch failed: %s (grid %d)\n", hipGetErrorString(e), grid);
}
```

```cpp
#include <hip/hip_runtime.h>
#include <hip/hip_cooperative_groups.h>
#include <cstdio>
namespace cg = cooperative_groups;

#define LAS __attribute__((address_space(3)))
typedef unsigned short bf16_t;
typedef short bf16x8 __attribute__((ext_vector_type(8)));
typedef float f32x4 __attribute__((ext_vector_type(4)));
typedef unsigned u32x4 __attribute__((ext_vector_type(4)));
typedef unsigned u32x2 __attribute__((ext_vector_type(2)));

constexpr int NTOK = 16384, DM = 1024, SEQL = 4096, NP = 5632;
constexpr int COL_K = 256, COL_V = 512, COL_R = 1024, COL_UV = 1536, COL_XC = 2048, COL_GATE = 2304, COL_GL = 5376, NIN = 5392;
constexpr float LN_EPS = 1e-5f;
constexpr float ALPHA = 1.41421356237f;
constexpr int ECAP = 16384;
constexpr int LDS_BYTES = 131072 + 1024;
#ifndef PH_HI
#define PH_HI 31
#endif

constexpr size_t al256(size_t x) { return (x + 255) & ~(size_t)255; }
constexpr size_t WS_CTL = 0;
constexpr size_t WS_WIN = 32768;
constexpr size_t SZ_WIN = (size_t)NP * 1024 * 2;
constexpr size_t WS_WUP = WS_WIN + 2 * SZ_WIN;
constexpr size_t SZ_SQ = (size_t)1024 * 1024 * 2;
constexpr size_t WS_WO = WS_WUP + 2 * SZ_SQ;
constexpr size_t WS_WQ = WS_WO + 2 * SZ_SQ;
constexpr size_t WS_WK = WS_WQ + 2 * SZ_SQ;
constexpr size_t WS_WV = WS_WK + 2 * SZ_SQ;
constexpr size_t WS_WXO = WS_WV + 2 * SZ_SQ;
constexpr size_t WS_WGU = WS_WXO + 2 * SZ_SQ;
constexpr size_t SZ_WGU = (size_t)32 * 2048 * 1024 * 2;
constexpr size_t WS_WD = WS_WGU + 2 * SZ_WGU;
constexpr size_t SZ_WD = (size_t)32 * 1024 * 1024 * 2;
constexpr size_t WS_XB = WS_WD + 2 * SZ_WD;
constexpr size_t SZ_ACTB = (size_t)NTOK * 1024 * 2;
constexpr size_t SZ_ACTF = (size_t)NTOK * 1024 * 4;
constexpr size_t WS_MEMB = WS_XB + SZ_ACTB;
constexpr size_t WS_XF = WS_MEMB + SZ_SQ;
constexpr size_t WS_YBUF = WS_XF + SZ_ACTF;
constexpr size_t WS_P = WS_YBUF + SZ_ACTF;
constexpr size_t WS_YCAT = WS_P + (size_t)NTOK * NP * 2;
constexpr size_t WS_BCUM = WS_YCAT + SZ_ACTB;
constexpr size_t WS_KVT = WS_BCUM + (size_t)NTOK * 256 * 4;
constexpr size_t WS_CDEC = WS_KVT + (size_t)1024 * 8192 * 4;
constexpr size_t WS_ST = WS_CDEC + (size_t)1024 * 64 * 4;
constexpr size_t WS_MRGF = WS_ST + (size_t)1024 * 8192 * 2;
constexpr size_t WS_MRGB = WS_MRGF + SZ_ACTF;
constexpr size_t WS_QB = WS_MRGB + SZ_ACTB;
constexpr size_t WS_OB = WS_QB + SZ_ACTB;
constexpr size_t WS_KM = WS_OB + SZ_ACTB;
constexpr size_t WS_VT = WS_KM + 2 * SZ_SQ;
constexpr size_t WS_ELIST = WS_VT + 8 * SZ_SQ;
constexpr size_t WS_TGATE = WS_ELIST + (size_t)32 * ECAP * 4;
constexpr size_t WS_ABUF = WS_TGATE + (size_t)NTOK * 4 * 4;
constexpr size_t WS_YS = WS_ABUF + (size_t)73728 * 1024 * 2;
constexpr size_t WS_STATS = WS_YS + (size_t)65536 * 1024 * 2;
constexpr size_t WS_END = WS_STATS + (size_t)64 * 4 * 256 * 2 * 4;

__device__ __forceinline__ float bf2f(bf16_t b) { return __uint_as_float(((unsigned)b) << 16); }
__device__ __forceinline__ unsigned pk2(float lo, float hi) { unsigned r; asm("v_cvt_pk_bf16_f32 %0, %1, %2" : "=v"(r) : "v"(lo), "v"(hi)); return r; }
__device__ __forceinline__ bf16_t f2bf(float f) { return (bf16_t)(pk2(f, 0.f) & 0xffffu); }
__device__ __forceinline__ float bflo(unsigned u) { return __uint_as_float(u << 16); }
__device__ __forceinline__ float bfhi(unsigned u) { return __uint_as_float(u & 0xffff0000u); }
__device__ __forceinline__ float wave_sum(float v) {
#pragma unroll
    for (int o = 32; o; o >>= 1) v += __shfl_xor(v, o);
    return v;
}
__device__ __forceinline__ float wave_max(float v) {
#pragma unroll
    for (int o = 32; o; o >>= 1) v = fmaxf(v, __shfl_xor(v, o));
    return v;
}
__device__ __forceinline__ float gelu_f(float v) {
    const float av = fabsf(v), t = __builtin_amdgcn_rcpf(av * 0.2316418882f + 1.0f);
    float q = t * 0.5307027145f + (-0.7265760135f); q = q * t + 0.7107068705f; q = q * t + (-0.142248368f); q = q * t + 0.127414796f; q = q * t;
    const float e = __builtin_amdgcn_exp2f((v * v) * (-0.72134752044f));
    const float m = v * (q * e);
    return v < 0.f ? m : v - m;
}
__device__ __forceinline__ float sigmoid_f(float x) { return 1.f / (1.f + __expf(-x)); }
__device__ __forceinline__ int ltid() { int t = threadIdx.x; asm volatile("" : "+v"(t)); return t; }
#define WBAR() do { asm volatile("" ::: "memory"); __builtin_amdgcn_wave_barrier(); asm volatile("" ::: "memory"); } while (0)

struct Params { const float* in[33]; float* out; unsigned char* ws; int ph_lo, ph_hi; };

constexpr int BM = 256, BK = 64, HALF = 128, HTB = HALF * BK * 2, NXCD = 8, WGM = 8;
__device__ __forceinline__ int lds_byte(int r, int c) { const int st = (r >> 4) * 2 + (c >> 5), rr = r & 15, cc = c & 31, ob = rr * 64 + cc * 2; return st * 1024 + (ob ^ (((ob >> 9) & 1) << 5)); }
__device__ __forceinline__ void stage_rc(int b, int& R, int& C) { const int st = b / 1024, sb = b % 1024, swz = sb ^ (((sb >> 9) & 1) << 5); R = (st >> 1) * 16 + swz / 64; C = (st & 1) * 32 + (swz % 64) / 2; }
__device__ __forceinline__ int perm32(int rho) { const int n = rho >> 4, i = rho & 15; return 8 * (i >> 2) + 4 * n + (i & 3); }

struct Unit { int pm, pn, e, aux; };
typedef f32x4 Acc[2][2][4][2];

struct OrderStatic {
    int nM, nN, nwg, G, c;
    __device__ __forceinline__ void init(int M, int N, int G_, int c_) { nM = M / BM; nN = N / BM; nwg = nM * nN; G = G_; c = c_; }
    __device__ __forceinline__ bool next(int i, Unit& u) const {
        const long L = (long)i * G + c; if (L >= nwg) return false;
        int wgid = (int)L; { const int q = nwg / NXCD, r = nwg % NXCD, xcd = wgid % NXCD, off = wgid / NXCD; wgid = (xcd < r ? xcd * (q + 1) : r * (q + 1) + (xcd - r) * q) + off; }
        const int nig = WGM * nN, gid = wgid / nig, fm = gid * WGM, gsz = (nM - fm) < WGM ? (nM - fm) : WGM;
        u.pm = fm + ((wgid % nig) % gsz); u.pn = (wgid % nig) / gsz; u.e = 0; u.aux = 0; return true;
    }
};

template <class S_t>
__device__ __forceinline__ void gemm_phase(LAS unsigned char* lds, const S_t& S) {
    const int tid = ltid(), wid = __builtin_amdgcn_readfirstlane(tid >> 6), lane = tid & 63, wr = wid >> 2, wc = wid & 3, fr = lane & 15, fq = lane >> 4;
    const int nt = S.K / BK;
    int Rr[2], Cc[2]; unsigned voffB[2]; unsigned offC[2][2], offN[2][2];
#pragma unroll
    for (int i = 0; i < 2; ++i) { stage_rc(tid * 16 + i * 8192, Rr[i], Cc[i]); const int Rb = S_t::PERM ? ((Rr[i] & ~31) + perm32(Rr[i] & 31)) : Rr[i];
        voffB[i] = (unsigned)(Rb * S.ldb + Cc[i] * 2);
        offC[0][i] = (unsigned)(Rr[i] * S.lda + Cc[i] * 2); offC[1][i] = (unsigned)((Rr[i] + HALF) * S.lda + Cc[i] * 2);
        }
    const size_t kstep = (size_t)(BK * 2);
    const size_t hstepB = (size_t)HALF * S.ldb;
    const unsigned ldsw = (unsigned)wid * 1024u;
    const int aoff = lds_byte(wr * 64 + fr, fq * 8), boff = lds_byte(wc * 32 + fr, fq * 8);
#define G_SA(b, h) (((b) * 2 + (h)) * HTB)
#define G_SB(b, h) ((4 + (b) * 2 + (h)) * HTB)
#define G_STAGE_A(bufoff, kptr, OFF, h) do { _Pragma("unroll") for (int _i = 0; _i < 2; ++_i) \
        __builtin_amdgcn_global_load_lds((const unsigned*)((const char*)(kptr) + (OFF)[h][_i]), (LAS unsigned*)(lds + (bufoff) + ldsw + _i * 8192), 16, 0, 0); } while (0)
#define G_STAGE_B(bufoff, gbase) do { _Pragma("unroll") for (int _i = 0; _i < 2; ++_i) \
        __builtin_amdgcn_global_load_lds((const unsigned*)((const char*)(gbase) + voffB[_i]), (LAS unsigned*)(lds + (bufoff) + ldsw + _i * 8192), 16, 0, 0); } while (0)
#define G_LDA(dst, b, h) do { _Pragma("unroll") for (int m = 0; m < 4; ++m) _Pragma("unroll") for (int k = 0; k < 2; ++k) dst[m][k] = *(const LAS bf16x8*)(lds + G_SA(b, h) + aoff + m * 2048 + k * 1024); } while (0)
#define G_LDB(dst, b, h) do { _Pragma("unroll") for (int n = 0; n < 2; ++n) _Pragma("unroll") for (int k = 0; k < 2; ++k) dst[n][k] = *(const LAS bf16x8*)(lds + G_SB(b, h) + boff + n * 2048 + k * 1024); } while (0)
#define G_MMA(ai, bj, At, Bt) do { __builtin_amdgcn_s_setprio(1); _Pragma("unroll") for (int m = 0; m < 4; ++m) _Pragma("unroll") for (int n = 0; n < 2; ++n) _Pragma("unroll") for (int k = 0; k < 2; ++k) \
        acc[ai][bj][m][n] = __builtin_amdgcn_mfma_f32_16x16x32_bf16(Bt[n][k], At[m][k], acc[ai][bj][m][n], 0, 0, 0); __builtin_amdgcn_s_setprio(0); } while (0)
#define G_WAIT_V(n) asm volatile("s_waitcnt vmcnt(" #n ")" ::: "memory")
#define G_WAIT_L(n) asm volatile("s_waitcnt lgkmcnt(" #n ")" ::: "memory")
#define G_BAR __builtin_amdgcn_s_barrier()
#define G_SCHED __builtin_amdgcn_sched_barrier(0)
    Unit cur, nxt; int ui = 0;
    if (!S.next(0, cur)) return;
    if (S_t::GATHER) S.gather_offs(cur, tid, offC);
    Acc acc;
#pragma unroll
    for (int a = 0; a < 2; ++a)
#pragma unroll
        for (int b = 0; b < 2; ++b)
#pragma unroll
            for (int m = 0; m < 4; ++m)
#pragma unroll
                for (int n = 0; n < 2; ++n) acc[a][b][m][n] = (f32x4){0.f, 0.f, 0.f, 0.f};
    bf16x8 At[4][2], B0[2][2], B1[2][2];
    const char* cA = S.a_ptr(cur); const char* cB = S.b_ptr(cur);
    G_STAGE_B(G_SB(0, 0), cB); G_STAGE_A(G_SA(0, 0), cA, offC, 0); G_STAGE_B(G_SB(0, 1), cB + hstepB); G_STAGE_A(G_SA(0, 1), cA, offC, 1);
    if (wr == 1) G_BAR;
    G_WAIT_V(4); G_BAR;
    G_STAGE_B(G_SB(1, 0), cB + kstep); G_STAGE_A(G_SA(1, 0), cA + kstep, offC, 0); G_STAGE_B(G_SB(1, 1), cB + hstepB + kstep);
    G_WAIT_V(6); G_BAR;
    for (;;) {
        const bool has_next = S.next(ui + 1, nxt);
        const char* nA = has_next ? S.a_ptr(nxt) : cA; const char* nB = has_next ? S.b_ptr(nxt) : cB;
        if (S_t::GATHER) { if (has_next) S.gather_offs(nxt, tid, offN); else { offN[0][0] = offC[0][0]; offN[0][1] = offC[0][1]; offN[1][0] = offC[1][0]; offN[1][1] = offC[1][1]; } }
        for (int t = 0; t < nt; t += 2) {
            const bool last = (t == nt - 2);
            const char* a1 = cA + (size_t)(t + 1) * kstep;
            const char* a2 = last ? nA : cA + (size_t)(t + 2) * kstep; const char* b2 = last ? nB : cB + (size_t)(t + 2) * kstep;
            const char* a3 = a2 + kstep; const char* b3 = b2 + kstep;
            G_LDB(B0, 0, 0); G_SCHED; G_LDA(At, 0, 0); G_STAGE_A(G_SA(1, 1), a1, offC, 1);
            if (S_t::GATHER) { if (last) { offC[0][0] = offN[0][0]; offC[0][1] = offN[0][1]; offC[1][0] = offN[1][0]; offC[1][1] = offN[1][1]; } }
            G_WAIT_L(8); G_BAR; G_WAIT_L(0); G_MMA(0, 0, At, B0); G_BAR; G_SCHED;
            G_LDB(B1, 0, 1); G_STAGE_B(G_SB(0, 0), b2);
            G_BAR; G_WAIT_L(0); G_MMA(0, 1, At, B1); G_BAR;
            G_LDA(At, 0, 1); G_STAGE_A(G_SA(0, 0), a2, offC, 0);
            G_BAR; G_WAIT_L(0); G_MMA(1, 0, At, B0); G_BAR; G_SCHED;
            G_STAGE_B(G_SB(0, 1), b2 + hstepB);
            G_WAIT_V(6); G_BAR; G_MMA(1, 1, At, B1); G_BAR;
            G_LDB(B0, 1, 0); G_SCHED; G_LDA(At, 1, 0); G_STAGE_A(G_SA(0, 1), a2, offC, 1);
            G_WAIT_L(8); G_BAR; G_WAIT_L(0); G_MMA(0, 0, At, B0); G_BAR; G_SCHED;
            G_LDB(B1, 1, 1); G_STAGE_B(G_SB(1, 0), b3);
            G_BAR; G_WAIT_L(0); G_MMA(0, 1, At, B1); G_BAR;
            G_LDA(At, 1, 1); G_STAGE_A(G_SA(1, 0), a3, offC, 0);
            G_BAR; G_WAIT_L(0); G_MMA(1, 0, At, B0); G_BAR; G_SCHED;
            G_STAGE_B(G_SB(1, 1), b3 + hstepB);
            G_WAIT_V(6); G_BAR; G_MMA(1, 1, At, B1); G_BAR;
        }
        if constexpr (!S_t::AFTER) S.epi(acc, cur, wr, wc, fr, fq);
        if (!has_next) break;
#pragma unroll
        for (int a = 0; a < 2; ++a)
#pragma unroll
            for (int b = 0; b < 2; ++b)
#pragma unroll
                for (int m = 0; m < 4; ++m)
#pragma unroll
                    for (int n = 0; n < 2; ++n) acc[a][b][m][n] = (f32x4){0.f, 0.f, 0.f, 0.f};
        cur = nxt; cA = nA; cB = nB; ++ui;
    }
    G_WAIT_V(0);
    if (wr == 0) G_BAR;
    G_BAR;
    if constexpr (S_t::AFTER) S.epi_after(acc, cur, wr, wc, fr, fq, lds);
}

struct ProbBase : OrderStatic {
    static constexpr bool GATHER = false, AFTER = false;
    const char* A; const char* Bt; static constexpr int K = 1024, lda = 2048, ldb = 2048;
    __device__ __forceinline__ const char* a_ptr(const Unit& u) const { return A + (size_t)u.pm * BM * lda; }
    __device__ __forceinline__ const char* b_ptr(const Unit& u) const { return Bt + (size_t)u.pn * BM * ldb; }
    __device__ __forceinline__ void gather_offs(const Unit&, int, unsigned (&)[2][2]) const {}
};

struct ProbInProj : ProbBase {
    static constexpr bool PERM = true;
    bf16_t* out; const float* bias;
    __device__ __forceinline__ void epi(const Acc& acc, const Unit& u, int wr, int wc, int fr, int fq) const {
        const int row0 = u.pm * BM + wr * 64 + fr, colt = u.pn * BM + wc * 32 + 8 * fq;
        f32x4 bv[2][2];
#pragma unroll
        for (int bj = 0; bj < 2; ++bj) { const int c = colt + bj * HALF; int mc = c < COL_UV ? c : (c < COL_GL ? c + 16 : c - COL_GL + COL_UV);
            if (c < NIN) { bv[bj][0] = *(const f32x4*)(bias + mc); bv[bj][1] = *(const f32x4*)(bias + mc + 4); } else { bv[bj][0] = (f32x4){0.f, 0.f, 0.f, 0.f}; bv[bj][1] = bv[bj][0]; } }
#pragma unroll
        for (int ai = 0; ai < 2; ++ai)
#pragma unroll
            for (int m = 0; m < 4; ++m) { bf16_t* rowp = out + (size_t)(row0 + ai * HALF + m * 16) * NP + colt;
#pragma unroll
                for (int bj = 0; bj < 2; ++bj) { const f32x4 v0 = acc[ai][bj][m][0] + bv[bj][0], v1 = acc[ai][bj][m][1] + bv[bj][1];
                    *(u32x4*)(rowp + bj * HALF) = (u32x4){pk2(v0[0], v0[1]), pk2(v0[2], v0[3]), pk2(v1[0], v1[1]), pk2(v1[2], v1[3])}; } }
    }
};
struct ProbBf16 : ProbBase {
    static constexpr bool PERM = true;
    bf16_t* out; int ldc;
    __device__ __forceinline__ void epi(const Acc& acc, const Unit& u, int wr, int wc, int fr, int fq) const {
        const int row0 = u.pm * BM + wr * 64 + fr, colt = u.pn * BM + wc * 32 + 8 * fq;
#pragma unroll
        for (int ai = 0; ai < 2; ++ai)
#pragma unroll
            for (int m = 0; m < 4; ++m) { bf16_t* rowp = out + (size_t)(row0 + ai * HALF + m * 16) * ldc + colt;
#pragma unroll
                for (int bj = 0; bj < 2; ++bj) { const f32x4 v0 = acc[ai][bj][m][0], v1 = acc[ai][bj][m][1];
                    *(u32x4*)(rowp + bj * HALF) = (u32x4){pk2(v0[0], v0[1]), pk2(v0[2], v0[3]), pk2(v1[0], v1[1]), pk2(v1[2], v1[3])}; } }
    }
};
struct ProbQ : ProbBf16 {
    int G2, c2;
    __device__ __forceinline__ bool next(int i, Unit& u) const { const int L = i * G2 + c2; if (L >= 256) return false; const int bh = L >> 4, mt = L & 15; u.pm = (bh >> 2) * 16 + mt; u.pn = bh & 3; u.e = 0; u.aux = 0; return true; }
};
struct ProbRes : ProbBase {
    static constexpr bool PERM = false;
    float* out; const float* xres;
    __device__ __forceinline__ void epi(const Acc& acc, const Unit& u, int wr, int wc, int fr, int fq) const {
        const int row0 = u.pm * BM + wr * 64 + fr, col0 = u.pn * BM + wc * 32 + 4 * fq;
#pragma unroll
        for (int ai = 0; ai < 2; ++ai) {
            f32x4 xr[4][2][2];
#pragma unroll
            for (int m = 0; m < 4; ++m) { const size_t ro = (size_t)(row0 + ai * HALF + m * 16) * DM + col0;
#pragma unroll
                for (int bj = 0; bj < 2; ++bj)
#pragma unroll
                    for (int n = 0; n < 2; ++n) xr[m][bj][n] = *(const f32x4*)(xres + ro + bj * HALF + n * 16); }
#pragma unroll
            for (int m = 0; m < 4; ++m) { const size_t ro = (size_t)(row0 + ai * HALF + m * 16) * DM + col0;
#pragma unroll
                for (int bj = 0; bj < 2; ++bj)
#pragma unroll
                    for (int n = 0; n < 2; ++n) *(f32x4*)(out + ro + bj * HALF + n * 16) = xr[m][bj][n] * ALPHA + acc[ai][bj][m][n]; }
        }
    }
};
struct ProbMT {
    static constexpr bool PERM = true, GATHER = false, AFTER = false;
    static constexpr int K = 256, lda = 2048, ldb = 2048;
    const char* A; const char* Bt; int G, c; bf16_t* out;
    __device__ __forceinline__ bool next(int i, Unit& u) const { const int L = i * G + c; if (L >= 64) return false; u.e = L >> 2; u.pn = L & 3; u.pm = 0; u.aux = 0; return true; }
    __device__ __forceinline__ const char* a_ptr(const Unit& u) const { const int b = u.e >> 2, h = u.e & 3; return A + (size_t)(b * 256) * lda + h * 512; }
    __device__ __forceinline__ const char* b_ptr(const Unit& u) const { const int h = u.e & 3; return Bt + (size_t)u.pn * BM * ldb + h * 512; }
    __device__ __forceinline__ void gather_offs(const Unit&, int, unsigned (&)[2][2]) const {}
    __device__ __forceinline__ void epi(const Acc& acc, const Unit& u, int wr, int wc, int fr, int fq) const {
        const int row0 = wr * 64 + fr, colt = u.pn * BM + wc * 32 + 8 * fq;
#pragma unroll
        for (int ai = 0; ai < 2; ++ai)
#pragma unroll
            for (int m = 0; m < 4; ++m) { bf16_t* rowp = out + (size_t)u.e * 256 * 1024 + (size_t)(row0 + ai * HALF + m * 16) * 1024 + colt;
#pragma unroll
                for (int bj = 0; bj < 2; ++bj) { const f32x4 v0 = acc[ai][bj][m][0], v1 = acc[ai][bj][m][1];
                    *(u32x4*)(rowp + bj * HALF) = (u32x4){pk2(v0[0], v0[1]), pk2(v0[2], v0[3]), pk2(v1[0], v1[1]), pk2(v1[2], v1[3])}; } }
    }
};
struct ProbVW {
    static constexpr bool PERM = true, GATHER = false, AFTER = false;
    static constexpr int K = 256, lda = 2048, ldb = 2048;
    const char* A; const char* Bt; int G, c; bf16_t* out;
    __device__ __forceinline__ bool next(int i, Unit& u) const { const int L = i * G + c; if (L >= 64) return false; u.e = L >> 2; u.pm = L & 3; u.pn = 0; u.aux = 0; return true; }
    __device__ __forceinline__ const char* a_ptr(const Unit& u) const { const int h = u.e & 3; return A + (size_t)u.pm * BM * lda + h * 512; }
    __device__ __forceinline__ const char* b_ptr(const Unit& u) const { const int b = u.e >> 2, h = u.e & 3; return Bt + (size_t)(b * 256) * ldb + h * 512; }
    __device__ __forceinline__ void gather_offs(const Unit&, int, unsigned (&)[2][2]) const {}
    __device__ __forceinline__ void epi(const Acc& acc, const Unit& u, int wr, int wc, int fr, int fq) const {
        const int b = u.e >> 2, h = u.e & 3; const int row0 = u.pm * BM + wr * 64 + fr, colt = h * 256 + wc * 32 + 8 * fq;
#pragma unroll
        for (int ai = 0; ai < 2; ++ai)
#pragma unroll
            for (int m = 0; m < 4; ++m) { bf16_t* rowp = out + (size_t)b * 1024 * 1024 + (size_t)(row0 + ai * HALF + m * 16) * 1024 + colt;
#pragma unroll
                for (int bj = 0; bj < 2; ++bj) { const f32x4 v0 = acc[ai][bj][m][0], v1 = acc[ai][bj][m][1];
                    *(u32x4*)(rowp + bj * HALF) = (u32x4){pk2(v0[0], v0[1]), pk2(v0[2], v0[3]), pk2(v1[0], v1[1]), pk2(v1[2], v1[3])}; } }
    }
};
struct ProbResLN : ProbBase {
    static constexpr bool PERM = false, AFTER = true;
    const float* xres; const float* lng; const float* lnb; float* xf; bf16_t* xb; float* stats; unsigned* cntp; size_t bstride;
    __device__ __forceinline__ const char* b_ptr(const Unit& u) const { return Bt + (size_t)(u.pm >> 4) * bstride + (size_t)u.pn * BM * ldb; }
    __device__ __forceinline__ void epi(const Acc&, const Unit&, int, int, int, int) const {}
    __device__ __forceinline__ void epi_after(Acc& acc, const Unit& u, int wr, int wc, int fr, int fq, LAS unsigned char* lds) const {
        const int tid = ltid();
        const int col0 = u.pn * BM + wc * 32 + 4 * fq;
        LAS float* red = (LAS float*)lds;
        LAS float* tab = (LAS float*)(lds + 8192);
#pragma unroll
        for (int ai = 0; ai < 2; ++ai)
#pragma unroll
            for (int m = 0; m < 4; ++m) { const int rowl = ai * HALF + wr * 64 + m * 16 + fr; const size_t ro = (size_t)(u.pm * BM + rowl) * DM + col0;
                float sv = 0.f, sq = 0.f;
#pragma unroll
                for (int bj = 0; bj < 2; ++bj)
#pragma unroll
                    for (int n = 0; n < 2; ++n) { const f32x4 xr = *(const f32x4*)(xres + ro + bj * HALF + n * 16); const f32x4 y = xr * ALPHA + acc[ai][bj][m][n]; acc[ai][bj][m][n] = y;
                        sv += (y[0] + y[1]) + (y[2] + y[3]); sq += (y[0] * y[0] + y[1] * y[1]) + (y[2] * y[2] + y[3] * y[3]); }
                sv += __shfl_xor(sv, 16); sv += __shfl_xor(sv, 32); sq += __shfl_xor(sq, 16); sq += __shfl_xor(sq, 32);
                if (fq == 0) { red[(rowl * 4 + wc) * 2] = sv; red[(rowl * 4 + wc) * 2 + 1] = sq; } }
        __syncthreads();
        if (tid < 256) { float S = 0.f, SS = 0.f;
#pragma unroll
            for (int w = 0; w < 4; ++w) { S += red[(tid * 4 + w) * 2]; SS += red[(tid * 4 + w) * 2 + 1]; }
            float* st = stats + ((size_t)(u.pm * 4 + u.pn) * 256 + tid) * 2; st[0] = S; st[1] = SS; }
        asm volatile("s_waitcnt vmcnt(0)" ::: "memory");
        __syncthreads();
        if (tid == 0) { unsigned* cw = cntp + u.pm;
            __builtin_amdgcn_fence(__ATOMIC_RELEASE, "agent"); asm volatile("s_waitcnt vmcnt(0)" ::: "memory");
            __hip_atomic_fetch_add(cw, 1u, __ATOMIC_RELAXED, __HIP_MEMORY_SCOPE_AGENT);
            while (__hip_atomic_load(cw, __ATOMIC_RELAXED, __HIP_MEMORY_SCOPE_AGENT) < 4u) __builtin_amdgcn_s_sleep(1);
            __builtin_amdgcn_fence(__ATOMIC_ACQUIRE, "agent"); asm volatile("s_waitcnt vmcnt(0)" ::: "memory"); }
        __syncthreads();
        if (tid < 256) { float S = 0.f, SS = 0.f;
#pragma unroll
            for (int w = 0; w < 4; ++w) { const float* st = stats + ((size_t)(u.pm * 4 + w) * 256 + tid) * 2;
                S += __hip_atomic_load(st, __ATOMIC_RELAXED, __HIP_MEMORY_SCOPE_AGENT); SS += __hip_atomic_load(st + 1, __ATOMIC_RELAXED, __HIP_MEMORY_SCOPE_AGENT); }
            const float mean = S * (1.f / DM), var = fmaxf(SS * (1.f / DM) - mean * mean, 0.f);
            tab[tid * 2] = mean; tab[tid * 2 + 1] = rsqrtf(var + LN_EPS); }
        __syncthreads();
        f32x4 gv[2][2], bv[2][2];
#pragma unroll
        for (int bj = 0; bj < 2; ++bj)
#pragma unroll
            for (int n = 0; n < 2; ++n) { gv[bj][n] = *(const f32x4*)(lng + col0 + bj * HALF + n * 16); bv[bj][n] = *(const f32x4*)(lnb + col0 + bj * HALF + n * 16); }
#pragma unroll
        for (int ai = 0; ai < 2; ++ai)
#pragma unroll
            for (int m = 0; m < 4; ++m) { const int rowl = ai * HALF + wr * 64 + m * 16 + fr; const size_t ro = (size_t)(u.pm * BM + rowl) * DM + col0;
                const float mean = tab[rowl * 2], rstd = tab[rowl * 2 + 1];
#pragma unroll
                for (int bj = 0; bj < 2; ++bj)
#pragma unroll
                    for (int n = 0; n < 2; ++n) { const f32x4 v = (acc[ai][bj][m][n] - mean) * rstd * gv[bj][n] + bv[bj][n];
                        *(f32x4*)(xf + ro + bj * HALF + n * 16) = v; *(u32x2*)(xb + ro + bj * HALF + n * 16) = (u32x2){pk2(v[0], v[1]), pk2(v[2], v[3])}; } }
        __syncthreads();
    }
};
template <int KK> struct ProbMerge {
    static constexpr bool PERM = false, GATHER = false, AFTER = false;
    const char* A; const char* Bt; static constexpr int K = KK, lda = 2048, ldb = 2048; int G, c;
    const bf16_t* p; bf16_t* mb;
    __device__ __forceinline__ bool next(int i, Unit& u) const { const int tile = (KK == 512 ? i : (i >> 1)) * G + c; if (tile >= 256) return false; u.pm = tile >> 2; u.pn = tile & 3; u.e = KK == 512 ? 0 : 1 + (i & 1); u.aux = 0; return true; }
    __device__ __forceinline__ const char* a_ptr(const Unit& u) const { return A + (size_t)u.pm * BM * lda + (KK == 512 ? 0 : 1024 + (u.e - 1) * 512); }
    __device__ __forceinline__ const char* b_ptr(const Unit& u) const { return Bt + (size_t)u.pn * BM * ldb + (KK == 512 ? 0 : 1024 + (u.e - 1) * 512); }
    __device__ __forceinline__ void gather_offs(const Unit&, int, unsigned (&)[2][2]) const {}
    __device__ __forceinline__ void epi(const Acc& acc, const Unit& u, int wr, int wc, int fr, int fq) const {
        const int row0 = u.pm * BM + wr * 64 + fr, col0 = u.pn * BM + wc * 32 + 4 * fq;
        const int gi = u.e;
        const bf16_t* __restrict__ mbr = mb; bf16_t* __restrict__ mbw = mb; const bf16_t* __restrict__ pr = p;
        u32x2 gr[2][2][2]; u32x2 pv[2][2][2];
#define MRG_LOAD(q, buf) do { const int row_ = row0 + ((q) >> 2) * HALF + ((q) & 3) * 16; const size_t ro_ = (size_t)row_ * DM + col0; \
            const bf16_t* gp_ = pr + (size_t)row_ * NP + COL_GATE + gi * 1024 + col0; \
            _Pragma("unroll") for (int bj = 0; bj < 2; ++bj) _Pragma("unroll") for (int n = 0; n < 2; ++n) { gr[buf][bj][n] = *(const u32x2*)(gp_ + bj * HALF + n * 16); \
                pv[buf][bj][n] = (KK != 512) ? *(const u32x2*)(mbr + ro_ + bj * HALF + n * 16) : (u32x2){0u, 0u}; } } while (0)
        MRG_LOAD(0, 0);
#pragma unroll
        for (int q = 0; q < 8; ++q) { const int ai = q >> 2, m = q & 3, buf = q & 1;
            if (q + 1 < 8) MRG_LOAD(q + 1, buf ^ 1);
            const int row = row0 + ai * HALF + m * 16; const size_t ro = (size_t)row * DM + col0;
#pragma unroll
            for (int bj = 0; bj < 2; ++bj)
#pragma unroll
                for (int n = 0; n < 2; ++n) { const u32x2 g2 = gr[buf][bj][n], p2 = pv[buf][bj][n];
                    f32x4 g; g[0] = sigmoid_f(bflo(g2[0])); g[1] = sigmoid_f(bfhi(g2[0])); g[2] = sigmoid_f(bflo(g2[1])); g[3] = sigmoid_f(bfhi(g2[1]));
                    const f32x4 v = g * acc[ai][bj][m][n] + (f32x4){bflo(p2[0]), bfhi(p2[0]), bflo(p2[1]), bfhi(p2[1])};
                    *(u32x2*)(mbw + ro + bj * HALF + n * 16) = (u32x2){pk2(v[0], v[1]), pk2(v[2], v[3])}; } }
#undef MRG_LOAD
    }
};
struct MoeOrder {
    int G, c, nN; const LAS int* tstart; const int* cnt;
    __device__ __forceinline__ bool next(int i, Unit& u) const {
        const int L = i * G + c; const int total = tstart[32] * nN; if (L >= total) return false;
        const int mt = L / nN; u.pn = L % nN; int e = 0;
        for (int k = 1; k < 32; ++k) e += (tstart[k] <= mt) ? 1 : 0;
        u.e = e; u.pm = mt; u.aux = (mt - tstart[e]) * BM; return true;
    }
};
__device__ __forceinline__ float swiglu_f(float g, float l) { g = fminf(g, 7.f); l = fminf(fmaxf(l, -7.f), 7.f); return g * sigmoid_f(1.702f * g) * (l + 1.f); }
struct ProbMoe1 : MoeOrder {
    static constexpr bool PERM = false, GATHER = true, AFTER = false;
    const char* A; const char* Bt; static constexpr int K = 1024, lda = 2048, ldb = 2048; const int* elist; const float* bgu; bf16_t* abuf;
    __device__ __forceinline__ const char* a_ptr(const Unit&) const { return A; }
    __device__ __forceinline__ const char* b_ptr(const Unit& u) const { return Bt + (size_t)u.e * 2048 * ldb + (size_t)u.pn * BM * ldb; }
    __device__ __forceinline__ void gather_offs(const Unit& u, int tid, unsigned (&off)[2][2]) const {
        const int n = cnt[u.e];
#pragma unroll
        for (int i = 0; i < 2; ++i) { int R, C; stage_rc(tid * 16 + i * 8192, R, C);
#pragma unroll
            for (int h = 0; h < 2; ++h) { const int rr = u.aux + h * HALF + R; const int tok = rr < n ? (elist[u.e * ECAP + rr] >> 2) : 0; off[h][i] = (unsigned)(tok * lda + C * 2); } }
    }
    __device__ __forceinline__ void epi(const Acc& acc, const Unit& u, int wr, int wc, int fr, int fq) const {
        const int row0 = u.pm * BM + wr * 64 + fr;
        const float* bb = bgu + (size_t)u.e * 2048;
#pragma unroll
        for (int bj = 0; bj < 2; ++bj) { const int g = u.pn * 8 + bj * 4 + wc; const int ac = 16 * g + 4 * fq;
            const f32x4 bg = *(const f32x4*)(bb + ac), bl = *(const f32x4*)(bb + 1024 + ac);
#pragma unroll
            for (int ai = 0; ai < 2; ++ai)
#pragma unroll
                for (int m = 0; m < 4; ++m) { const f32x4 vg = acc[ai][bj][m][0] + bg, vl = acc[ai][bj][m][1] + bl;
                    *(u32x2*)(abuf + (size_t)(row0 + ai * HALF + m * 16) * 1024 + ac) =
                        (u32x2){pk2(swiglu_f(vg[0], vl[0]), swiglu_f(vg[1], vl[1])), pk2(swiglu_f(vg[2], vl[2]), swiglu_f(vg[3], vl[3]))}; } }
    }
};
struct ProbMoe2 : MoeOrder {
    static constexpr bool PERM = false, GATHER = false, AFTER = false;
    const char* A; const char* Bt; static constexpr int K = 1024, lda = 2048, ldb = 2048; const int* elist; const float* bd; const float* tgate; bf16_t* ys;
    __device__ __forceinline__ const char* a_ptr(const Unit& u) const { return A + (size_t)u.pm * BM * lda; }
    __device__ __forceinline__ const char* b_ptr(const Unit& u) const { return Bt + (size_t)u.e * 1024 * ldb + (size_t)u.pn * BM * ldb; }
    __device__ __forceinline__ void gather_offs(const Unit&, int, unsigned (&)[2][2]) const {}
    __device__ __forceinline__ void epi(const Acc& acc, const Unit& u, int wr, int wc, int fr, int fq) const {
        const int n = cnt[u.e]; const int col0 = u.pn * BM + wc * 32 + 4 * fq;
        const float* bb = bd + (size_t)u.e * 1024 + col0;
        f32x4 bv[2][2];
#pragma unroll
        for (int bj = 0; bj < 2; ++bj)
#pragma unroll
            for (int nn = 0; nn < 2; ++nn) bv[bj][nn] = *(const f32x4*)(bb + bj * HALF + nn * 16);
        int aidx[2][4]; float gts[2][4];
#pragma unroll
        for (int ai = 0; ai < 2; ++ai)
#pragma unroll
            for (int m = 0; m < 4; ++m) { const int rr = u.aux + ai * HALF + wr * 64 + m * 16 + fr; aidx[ai][m] = (rr < n) ? elist[u.e * ECAP + rr] : -1; }
#pragma unroll
        for (int ai = 0; ai < 2; ++ai)
#pragma unroll
            for (int m = 0; m < 4; ++m) gts[ai][m] = (aidx[ai][m] >= 0) ? tgate[aidx[ai][m]] : 0.f;
#pragma unroll
        for (int ai = 0; ai < 2; ++ai)
#pragma unroll
            for (int m = 0; m < 4; ++m) {
                if (aidx[ai][m] >= 0) { const float g = gts[ai][m]; bf16_t* rowp = ys + (size_t)aidx[ai][m] * 1024 + col0;
#pragma unroll
                    for (int bj = 0; bj < 2; ++bj)
#pragma unroll
                        for (int nn = 0; nn < 2; ++nn) { const f32x4 v = (acc[ai][bj][m][nn] + bv[bj][nn]) * g;
                            *(u32x2*)(rowp + bj * HALF + nn * 16) = (u32x2){pk2(v[0], v[1]), pk2(v[2], v[3])}; } } }
    }
};

template <int MODE, int KK = 256> struct ProbAttn {
    static constexpr bool PERM = (MODE == 1), GATHER = false, AFTER = (MODE == 0);
    static constexpr int K = KK, lda = 2048, ldb = 2048;
    const char* A; const char* Bt; int G, c; float* sout; bf16_t* oout;
    __device__ __forceinline__ bool next(int i, Unit& u) const { const int L = i * G + c; if (L >= 256) return false; u.e = L >> 4; u.pm = L & 15; u.pn = 0; u.aux = 0; return true; }
    __device__ __forceinline__ const char* a_ptr(const Unit& u) const { const int b = u.e >> 2, h = u.e & 3; return A + ((size_t)(b * SEQL + u.pm * BM) * DM + (KK == 1024 ? 0 : h * 256)) * 2; }
    __device__ __forceinline__ const char* b_ptr(const Unit& u) const { const int b = u.e >> 2, h = u.e & 3;
        if (KK == 1024) return Bt + (size_t)u.e * 256 * 2048;
        return MODE == 0 ? Bt + ((size_t)(b * 256) * DM + h * 256) * 2 : Bt + ((size_t)b * 1024 * 1024 + (size_t)h * 256 * 1024) * 2; }
    __device__ __forceinline__ void gather_offs(const Unit&, int, unsigned (&)[2][2]) const {}
    __device__ __forceinline__ void epi_after(Acc& acc, const Unit& u, int wr, int wc, int fr, int fq, LAS unsigned char* lds) const {
        const int b = u.e >> 2, h = u.e & 3; const int grow0 = b * SEQL + u.pm * BM;
        LAS float* redm = (LAS float*)lds; LAS float* reds = (LAS float*)(lds + 4096);
#pragma unroll
        for (int ai = 0; ai < 2; ++ai)
#pragma unroll
            for (int m = 0; m < 4; ++m) { float v = -3e38f;
#pragma unroll
                for (int bj = 0; bj < 2; ++bj)
#pragma unroll
                    for (int n = 0; n < 2; ++n) v = fmaxf(v, fmaxf(fmaxf(acc[ai][bj][m][n][0], acc[ai][bj][m][n][1]), fmaxf(acc[ai][bj][m][n][2], acc[ai][bj][m][n][3])));
                v = fmaxf(v, __shfl_xor(v, 16)); v = fmaxf(v, __shfl_xor(v, 32));
                if (fq == 0) redm[(ai * HALF + wr * 64 + m * 16 + fr) * 4 + wc] = v; }
        __syncthreads();
#pragma unroll
        for (int ai = 0; ai < 2; ++ai)
#pragma unroll
            for (int m = 0; m < 4; ++m) { const int row = ai * HALF + wr * 64 + m * 16 + fr; const f32x4 r = *(const LAS f32x4*)(redm + row * 4);
                const float M = fmaxf(fmaxf(r[0], r[1]), fmaxf(r[2], r[3])); float sm = 0.f;
#pragma unroll
                for (int bj = 0; bj < 2; ++bj)
#pragma unroll
                    for (int n = 0; n < 2; ++n)
#pragma unroll
                        for (int j = 0; j < 4; ++j) { const float e = __expf((acc[ai][bj][m][n][j] - M) * 0.0625f); acc[ai][bj][m][n][j] = e; sm += e; }
                sm += __shfl_xor(sm, 16); sm += __shfl_xor(sm, 32);
                if (fq == 0) reds[row * 4 + wc] = sm; }
        __syncthreads();
#pragma unroll
        for (int ai = 0; ai < 2; ++ai)
#pragma unroll
            for (int m = 0; m < 4; ++m) { const int row = ai * HALF + wr * 64 + m * 16 + fr; const f32x4 r = *(const LAS f32x4*)(reds + row * 4);
                const float inv = 1.f / ((r[0] + r[1]) + (r[2] + r[3]));
                bf16_t* rowp = oout + (size_t)(grow0 + row) * DM + h * 256 + wc * 32 + 4 * fq;
#pragma unroll
                for (int bj = 0; bj < 2; ++bj)
#pragma unroll
                    for (int n = 0; n < 2; ++n) { const f32x4 v = acc[ai][bj][m][n] * inv; *(u32x2*)(rowp + bj * HALF + n * 16) = (u32x2){pk2(v[0], v[1]), pk2(v[2], v[3])}; } }
        __syncthreads();
    }
    __device__ __forceinline__ void epi(const Acc& acc, const Unit& u, int wr, int wc, int fr, int fq) const {
        const int b = u.e >> 2, h = u.e & 3; const int row0 = b * SEQL + u.pm * BM + wr * 64 + fr;
        if (MODE == 0) { const int col0 = h * 256 + wc * 32 + 4 * fq;
#pragma unroll
            for (int ai = 0; ai < 2; ++ai)
#pragma unroll
                for (int m = 0; m < 4; ++m) { float* rowp = sout + (size_t)(row0 + ai * HALF + m * 16) * DM + col0;
#pragma unroll
                    for (int bj = 0; bj < 2; ++bj)
#pragma unroll
                        for (int n = 0; n < 2; ++n) *(f32x4*)(rowp + bj * HALF + n * 16) = acc[ai][bj][m][n] * 0.0625f; }
        } else { const int colt = h * 256 + wc * 32 + 8 * fq;
#pragma unroll
            for (int ai = 0; ai < 2; ++ai)
#pragma unroll
                for (int m = 0; m < 4; ++m) { bf16_t* rowp = oout + (size_t)(row0 + ai * HALF + m * 16) * DM + colt;
#pragma unroll
                    for (int bj = 0; bj < 2; ++bj) { const f32x4 v0 = acc[ai][bj][m][0], v1 = acc[ai][bj][m][1];
                        *(u32x4*)(rowp + bj * HALF) = (u32x4){pk2(v0[0], v0[1]), pk2(v0[2], v0[3]), pk2(v1[0], v1[1]), pk2(v1[2], v1[3])}; } }
        }
    }
};
__device__ __forceinline__ void phase_softmax(const Params& P) {
    const int tid = ltid(); const int lane = tid & 63, wid = __builtin_amdgcn_readfirstlane(tid >> 6); const int gw = blockIdx.x * 8 + wid, NGW = gridDim.x * 8;
    const float* S = (const float*)(P.ws + WS_MRGF); bf16_t* Pb = (bf16_t*)(P.ws + WS_QB);
    for (int r = gw; r < NTOK * 4; r += NGW) { const size_t o = (size_t)r * 256 + lane * 4;
        const f32x4 v = *(const f32x4*)(S + o);
        const float mx = wave_max(fmaxf(fmaxf(v[0], v[1]), fmaxf(v[2], v[3])));
        const float e0 = __expf(v[0] - mx), e1 = __expf(v[1] - mx), e2 = __expf(v[2] - mx), e3 = __expf(v[3] - mx);
        const float inv = 1.f / wave_sum((e0 + e1) + (e2 + e3));
        *(u32x2*)(Pb + o) = (u32x2){pk2(e0 * inv, e1 * inv), pk2(e2 * inv, e3 * inv)}; }
}

__device__ __forceinline__ void tr_item(const float* __restrict__ src, int ldn, int scol, int k0, bf16_t* dst0, int ldk, LAS unsigned char* wl, int lane) {
    float v[64];
    const bool valid = scol >= 0;
    const float* s = src + (size_t)k0 * ldn + (valid ? scol : 0);
#pragma unroll
    for (int kk = 0; kk < 64; ++kk) v[kk] = s[(size_t)kk * ldn];
#pragma unroll
    for (int c = 0; c < 8; ++c) { u32x4 w;
#pragma unroll
        for (int q = 0; q < 4; ++q) w[q] = valid ? pk2(v[8 * c + 2 * q], v[8 * c + 2 * q + 1]) : 0u;
        *(LAS u32x4*)(wl + lane * 144 + c * 16) = w; }
    WBAR();
#pragma unroll
    for (int it = 0; it < 8; ++it) { const int row = it * 8 + (lane >> 3), c16 = lane & 7; const u32x4 w = *(const LAS u32x4*)(wl + row * 144 + c16 * 16);
        *(u32x4*)(dst0 + (size_t)row * ldk + c16 * 8) = w; }
    WBAR();
}
__device__ __forceinline__ void row_to_bf16(const float* src, bf16_t* dst, int lane) {
#pragma unroll
    for (int j = 0; j < 4; ++j) { const f32x4 v = *(const f32x4*)(src + j * 256 + lane * 4); *(u32x2*)(dst + j * 256 + lane * 4) = (u32x2){pk2(v[0], v[1]), pk2(v[2], v[3])}; }
}
__device__ __forceinline__ void phase_convert(const Params& P, LAS unsigned char* lds) {
    const int tid = ltid(); const int lane = tid & 63, wid = __builtin_amdgcn_readfirstlane(tid >> 6);
    const int gw = blockIdx.x * 8 + wid, NGW = gridDim.x * 8;
    LAS unsigned char* wl = lds + wid * 9216;
    unsigned char* ws = P.ws;
    constexpr int I_WIN = 16 * 88, I_SQ = 256, I_GU = 32 * 512, I_D = 32 * 256, I_L = I_WIN + 6 * I_SQ + I_GU + I_D;
    for (int it = gw; it < 2 * I_L; it += NGW) {
        const int l = it / I_L; int r = it % I_L;
        if (r < I_WIN) { const int ntl = r % 88, kt = r / 88; const int n = ntl * 64 + lane;
            const int sc = n < COL_UV ? n : (n < COL_GL ? n + 16 : (n < NIN ? n - COL_GL + COL_UV : -1));
            tr_item(P.in[2] + (size_t)l * 1024 * NIN, NIN, sc, kt * 64, (bf16_t*)(ws + WS_WIN + l * SZ_WIN) + (size_t)ntl * 64 * 1024 + kt * 64, 1024, wl, lane); continue; }
        r -= I_WIN;
        if (r < I_SQ) {
            const int ntl = r % 16, kt = r / 16; const float* src; int kk;
            if (kt < 8) { src = P.in[13] + (size_t)l * 512 * 1024; kk = kt; } else if (kt < 12) { src = P.in[14] + (size_t)l * 256 * 1024; kk = kt - 8; } else { src = P.in[15] + (size_t)l * 256 * 1024; kk = kt - 12; }
            tr_item(src, 1024, ntl * 64 + lane, kk * 64, (bf16_t*)(ws + WS_WUP + l * SZ_SQ) + (size_t)ntl * 64 * 1024 + kt * 64, 1024, wl, lane); continue; }
        r -= I_SQ;
        if (r < 5 * I_SQ) { const int w = r / I_SQ; const int rr = r % I_SQ; const int ntl = rr % 16, kt = rr / 16;
            const int ii = w == 0 ? 16 : 18 + w;
            const size_t wso = w == 0 ? WS_WO : (w == 1 ? WS_OB : (w == 2 ? WS_WK : (w == 3 ? WS_WV : WS_WXO)));
            tr_item(P.in[ii] + (size_t)l * 1024 * 1024, 1024, ntl * 64 + lane, kt * 64, (bf16_t*)(ws + wso + l * SZ_SQ) + (size_t)ntl * 64 * 1024 + kt * 64, 1024, wl, lane); continue; }
        r -= 5 * I_SQ;
        if (r < I_GU) { const int e = r / 512; const int rr = r % 512; const int ntl = rr % 32, kt = rr / 32; const int n = ntl * 64 + lane; const int g = n >> 5, w = n & 31;
            const int sc = w < 16 ? 16 * g + w : 1024 + 16 * g + (w - 16);
            tr_item(P.in[27] + ((size_t)l * 32 + e) * 1024 * 2048, 2048, sc, kt * 64, (bf16_t*)(ws + WS_WGU + l * SZ_WGU) + ((size_t)e * 2048 + ntl * 64) * 1024 + kt * 64, 1024, wl, lane); continue; }
        r -= I_GU;
        { const int e = r / 256; const int rr = r % 256; const int ntl = rr % 16, kt = rr / 16;
            tr_item(P.in[29] + ((size_t)l * 32 + e) * 1024 * 1024, 1024, ntl * 64 + lane, kt * 64, (bf16_t*)(ws + WS_WD + l * SZ_WD) + ((size_t)e * 1024 + ntl * 64) * 1024 + kt * 64, 1024, wl, lane); }
    }
    for (int m = gw; m < NTOK + 1024 + 2048; m += NGW) {
        if (m < NTOK) row_to_bf16(P.in[0] + (size_t)m * DM, (bf16_t*)(ws + WS_XB) + (size_t)m * DM, lane);
        else if (m >= NTOK + 1024) row_to_bf16(P.in[19] + (size_t)(m - NTOK - 1024) * DM, (bf16_t*)(ws + WS_WQ) + (size_t)(m - NTOK - 1024) * DM, lane);
        else row_to_bf16(P.in[1] + (size_t)(m - NTOK) * DM, (bf16_t*)(ws + WS_MEMB) + (size_t)(m - NTOK) * DM, lane);
    }
}

__device__ __forceinline__ bf16x8 ldfrag(const LAS bf16_t* base, int row, int stride, int k) { return *(const LAS bf16x8*)(base + row * stride + k); }

__device__ __forceinline__ void sgu_item(const Params& P, int l, int item, LAS unsigned char* lds) {
    const int tid = ltid(), lane = tid & 63, wid = tid >> 6, fr = lane & 15, fq = lane >> 4;
    const bf16_t* p = (const bf16_t*)(P.ws + WS_P); bf16_t* ycat = (bf16_t*)(P.ws + WS_YCAT);
    const int t0 = item * 128;
    LAS bf16_t* vnT = (LAS bf16_t*)lds;
    LAS bf16_t* wsb = (LAS bf16_t*)(lds + 69632);
    LAS float* red = (LAS float*)(lds + 69632 + 34816);
    {
        const int t = tid & 127, qd = tid >> 7;
        const bf16_t* src = p + (size_t)(t0 + t) * NP + COL_UV + 256 + qd * 64;
        float s = 0.f, ss = 0.f;
#pragma unroll
        for (int c = 0; c < 8; ++c) { const u32x4 w = *(const u32x4*)(src + c * 8);
#pragma unroll
            for (int q = 0; q < 4; ++q) { const float a = gelu_f(bflo(w[q])), b = gelu_f(bfhi(w[q])); s += a + b; ss += a * a + b * b; } }
        red[(t * 4 + qd) * 2] = s; red[(t * 4 + qd) * 2 + 1] = ss;
        __syncthreads();
        float S = 0.f, SS = 0.f;
#pragma unroll
        for (int q = 0; q < 4; ++q) { S += red[(t * 4 + q) * 2]; SS += red[(t * 4 + q) * 2 + 1]; }
        const float mean = S * (1.f / 256.f), var = fmaxf(SS * (1.f / 256.f) - mean * mean, 0.f), rstd = rsqrtf(var + LN_EPS);
        const float* lg = P.in[7] + l * 256 + qd * 64; const float* lb = P.in[8] + l * 256 + qd * 64;
#pragma unroll 2
        for (int c = 0; c < 8; ++c) { const u32x4 w = *(const u32x4*)(src + c * 8);
#pragma unroll
            for (int q = 0; q < 4; ++q) { const float a = gelu_f(bflo(w[q])), b = gelu_f(bfhi(w[q])); const int ch = c * 8 + 2 * q;
                vnT[(qd * 64 + ch) * 136 + t] = f2bf((a - mean) * rstd * lg[ch] + lb[ch]);
                vnT[(qd * 64 + ch + 1) * 136 + t] = f2bf((b - mean) * rstd * lg[ch + 1] + lb[ch + 1]); } }
    }
    for (int g = 0; g < 4; ++g) {
        __syncthreads();
        const float* wsg = P.in[9] + ((size_t)l * 4 + g) * 128 * 128;
#pragma unroll
        for (int i = 0; i < 4; ++i) { const int id = tid + i * 512; const int t = id >> 4, s8 = (id & 15) * 8;
            const f32x4 a = *(const f32x4*)(wsg + t * 128 + s8), b = *(const f32x4*)(wsg + t * 128 + s8 + 4);
            float w[8] = {a[0], a[1], a[2], a[3], b[0], b[1], b[2], b[3]};
#pragma unroll
            for (int q = 0; q < 8; ++q) w[q] = (s8 + q <= t) ? w[q] : 0.f;
            *(LAS u32x4*)(wsb + t * 136 + s8) = (u32x4){pk2(w[0], w[1]), pk2(w[2], w[3]), pk2(w[4], w[5]), pk2(w[6], w[7])}; }
        __syncthreads();
#pragma unroll
        for (int q = 0; q < 4; ++q) { const int tile = wid * 4 + q; const int ti = tile >> 2, di = tile & 3;
            f32x4 acc = {0.f, 0.f, 0.f, 0.f};
            const int ksmax = (ti * 16 + 15) >> 5;
            for (int ks = 0; ks <= ksmax; ++ks) {
                const bf16x8 a = ldfrag(wsb, ti * 16 + fr, 136, ks * 32 + 8 * fq), b = ldfrag(vnT, g * 64 + di * 16 + fr, 136, ks * 32 + 8 * fq);
                acc = __builtin_amdgcn_mfma_f32_16x16x32_bf16(a, b, acc, 0, 0, 0); }
            const int ch = g * 64 + di * 16 + fr;
#pragma unroll
            for (int j = 0; j < 4; ++j) { const int t = ti * 16 + 4 * fq + j;
                const float sv = acc[j] + P.in[10][((size_t)l * 4 + g) * 128 + t];
                const float u = gelu_f(bf2f(p[(size_t)(t0 + t) * NP + COL_UV + ch]));
                ycat[(size_t)(t0 + t) * DM + 512 + ch] = f2bf(u * sv); } }
    }
    __syncthreads();
}

__device__ __forceinline__ void gla1_item(const Params& P, int l, int idx, LAS unsigned char* lds) {
    const int tid = ltid();
    const bf16_t* p = (const bf16_t*)(P.ws + WS_P);
    float* bcum = (float*)(P.ws + WS_BCUM); float* kvT = (float*)(P.ws + WS_KVT); float* cdec = (float*)(P.ws + WS_CDEC);
    const int h = idx & 3, bn = idx >> 2; const int t0 = bn * 64;
    LAS float* gl = (LAS float*)lds;
    LAS float* tot = (LAS float*)(lds + 4096);
    LAS float* kt = (LAS float*)(lds + 8192);
    LAS float* vs = (LAS float*)(lds + 8192 + 16384);
#pragma unroll
    for (int i = 0; i < 2; ++i) { const int id = tid + i * 512; gl[id] = bf2f(p[(size_t)(t0 + (id >> 4)) * NP + COL_GL + (id & 15)]); }
#pragma unroll
    for (int i = 0; i < 2; ++i) { const int id = tid + i * 512; const int t = id >> 4, e8 = (id & 15) * 8;
        const u32x4 w = *(const u32x4*)(p + (size_t)(t0 + t) * NP + COL_V + h * 128 + e8);
        *(LAS f32x4*)(vs + t * 128 + e8) = (f32x4){bflo(w[0]), bfhi(w[0]), bflo(w[1]), bfhi(w[1])};
        *(LAS f32x4*)(vs + t * 128 + e8 + 4) = (f32x4){bflo(w[2]), bfhi(w[2]), bflo(w[3]), bfhi(w[3])}; }
    __syncthreads();
    {
        const int tq = tid >> 6, d = tid & 63;
        float wreg[16];
#pragma unroll
        for (int r = 0; r < 16; ++r) wreg[r] = P.in[4][((size_t)l * 16 + r) * 256 + h * 64 + d];
        const float bgv = P.in[5][l * 256 + h * 64 + d];
        float pre[8]; float run = 0.f;
#pragma unroll
        for (int i = 0; i < 8; ++i) { const int t = tq * 8 + i; float z = bgv;
#pragma unroll
            for (int r = 0; r < 16; ++r) z += gl[t * 16 + r] * wreg[r];
            const float ls = fminf(z, 0.f) - log1pf(__expf(-fabsf(z)));
            run += ls * (1.f / 16.f); pre[i] = run; }
        tot[tq * 64 + d] = run;
        __syncthreads();
        float off = 0.f, total = 0.f;
#pragma unroll
        for (int g = 0; g < 8; ++g) { const float x = tot[g * 64 + d]; total += x; off += (g < tq) ? x : 0.f; }
#pragma unroll
        for (int i = 0; i < 8; ++i) { const int t = tq * 8 + i; const float bv = off + pre[i];
            bcum[(size_t)(t0 + t) * 256 + h * 64 + d] = bv;
            kt[t * 64 + d] = bf2f(p[(size_t)(t0 + t) * NP + COL_K + h * 64 + d]) * __expf(total - bv); }
        if (tq == 0) cdec[idx * 64 + d] = __expf(total);
    }
    __syncthreads();
    {
        const int d4 = tid & 15, e4 = tid >> 4;
        f32x4 a0 = {0.f, 0.f, 0.f, 0.f}, a1 = a0, a2 = a0, a3 = a0;
        for (int t = 0; t < 64; ++t) { const f32x4 kv = *(const LAS f32x4*)(kt + t * 64 + 4 * d4), vv = *(const LAS f32x4*)(vs + t * 128 + 4 * e4);
            a0 += kv * vv[0]; a1 += kv * vv[1]; a2 += kv * vv[2]; a3 += kv * vv[3]; }
        float* o = kvT + (size_t)idx * 8192 + (4 * e4) * 64 + 4 * d4;
        *(f32x4*)(o) = a0; *(f32x4*)(o + 64) = a1; *(f32x4*)(o + 128) = a2; *(f32x4*)(o + 192) = a3;
    }
    __syncthreads();
}

__device__ __forceinline__ void pool_item(const Params& P, int l, int item, LAS unsigned char* lds) {
    const int tid = ltid(), lane = tid & 63, wid = tid >> 6, fr = lane & 15, fq = lane >> 4;
    const bf16_t* p = (const bf16_t*)(P.ws + WS_P); bf16_t* ycat = (bf16_t*)(P.ws + WS_YCAT);
    const int T0 = item * 64, pos0 = T0 & (SEQL - 1);
    LAS bf16_t* xs = (LAS bf16_t*)lds;
    LAS bf16_t* ybf = (LAS bf16_t*)(lds + 42240);
    LAS bf16_t* pwT = (LAS bf16_t*)(lds + 42240 + 33792);
#pragma unroll
    for (int i = 0; i < 5; ++i) { const int id = tid + i * 512; const int r = id >> 5, c8 = (id & 31) * 8;
        u32x4 w = {0u, 0u, 0u, 0u};
        if (pos0 - 16 + r >= 0) w = *(const u32x4*)(p + (size_t)(T0 - 16 + r) * NP + COL_XC + c8);
        *(LAS u32x4*)(xs + r * 264 + c8) = w; }
    const float* pw = P.in[11] + (size_t)l * 4 * 64 * 64;
#pragma unroll 4
    for (int i = 0; i < 32; ++i) { const int id = tid + i * 512; const int g = id >> 12, c = (id >> 6) & 63, dd = id & 63; pwT[(g * 64 + dd) * 72 + c] = f2bf(pw[id]); }
    __syncthreads();
    {
        const int ch = tid & 255, th = tid >> 8; const int gi = ch >> 6, w = 2 << gi;
        float sum = 0.f;
        for (int j = 1; j < w; ++j) sum += bf2f(xs[(16 + th * 32 - j) * 264 + ch]);
        for (int tt = 0; tt < 32; ++tt) { const int t = th * 32 + tt; const float x = bf2f(xs[(16 + t) * 264 + ch]);
            sum += x; const int pos = pos0 + t; const float cntf = (float)min(pos + 1, w);
            ybf[t * 264 + ch] = f2bf(sum / cntf - x);
            sum -= bf2f(xs[(16 + t - w + 1) * 264 + ch]); }
    }
    __syncthreads();
#pragma unroll
    for (int q = 0; q < 8; ++q) { const int tile = wid * 8 + q; const int g = tile >> 4, ti = (tile >> 2) & 3, di = tile & 3;
        f32x4 acc = {0.f, 0.f, 0.f, 0.f};
#pragma unroll
        for (int ks = 0; ks < 2; ++ks) { const bf16x8 a = ldfrag(ybf, ti * 16 + fr, 264, g * 64 + ks * 32 + 8 * fq), b = ldfrag(pwT, g * 64 + di * 16 + fr, 72, ks * 32 + 8 * fq);
            acc = __builtin_amdgcn_mfma_f32_16x16x32_bf16(a, b, acc, 0, 0, 0); }
        const int ch = g * 64 + di * 16 + fr; const float sc = P.in[12][l * 256 + ch];
#pragma unroll
        for (int j = 0; j < 4; ++j) ycat[(size_t)(T0 + ti * 16 + 4 * fq + j) * DM + 768 + ch] = f2bf(acc[j] * sc); }
    __syncthreads();
}

__device__ __forceinline__ void phase_mixer_local(const Params& P, int l, LAS unsigned char* lds) {
    constexpr int N_SGU = 128, N_GLA = 1024, N_POOL = 256;
    if (gridDim.x == 256) {
        const int b = blockIdx.x; int first, cntn;
        if (b < N_SGU) { sgu_item(P, l, b, lds); first = b * 3; cntn = 3; } else { first = 384 + (b - N_SGU) * 7; cntn = 7; }
        for (int k = 0; k < cntn; ++k) { const int it = first + k; if (it < N_GLA) gla1_item(P, l, it, lds); else pool_item(P, l, it - N_GLA, lds); }
        return;
    }
    for (int it = blockIdx.x; it < N_SGU + N_GLA + N_POOL; it += gridDim.x) {
        if (it < N_SGU) sgu_item(P, l, it, lds);
        else if (it < N_SGU + N_GLA) gla1_item(P, l, it - N_SGU, lds);
        else pool_item(P, l, it - N_SGU - N_GLA, lds);
    }
}

__device__ __forceinline__ void phase_scan(const Params& P) {
    const float* kvT = (const float*)(P.ws + WS_KVT); const float* cdec = (const float*)(P.ws + WS_CDEC); bf16_t* sT = (bf16_t*)(P.ws + WS_ST);
    for (int g = blockIdx.x * 512 + ltid(); g < 16 * 8192; g += gridDim.x * 512) {
        const int bh = g >> 13, ed = g & 8191, d = ed & 63, b = bh >> 2, h = bh & 3;
        float S = 0.f;
#pragma unroll 8
        for (int n = 0; n < 64; ++n) { const int ci = (b * 64 + n) * 4 + h;
            sT[(size_t)ci * 8192 + ed] = f2bf(S);
            S = cdec[ci * 64 + d] * S + kvT[(size_t)ci * 8192 + ed]; }
    }
}

struct G2R { u32x4 qw, kw, vw0, vw1, sw0, sw1, r0, r1; f32x4 b0, b1; };
__device__ __forceinline__ void gla2_load(const Params& P, int idx, int tid, G2R& r) {
    const bf16_t* p = (const bf16_t*)(P.ws + WS_P); const float* bcum = (const float*)(P.ws + WS_BCUM); const bf16_t* sT = (const bf16_t*)(P.ws + WS_ST);
    const int h = idx & 3, bn = idx >> 2; const int t0 = bn * 64;
    const int t = tid >> 3, c8 = (tid & 7) * 8;
    r.qw = *(const u32x4*)(p + (size_t)(t0 + t) * NP + h * 64 + c8); r.kw = *(const u32x4*)(p + (size_t)(t0 + t) * NP + COL_K + h * 64 + c8);
    r.b0 = *(const f32x4*)(bcum + (size_t)(t0 + t) * 256 + h * 64 + c8); r.b1 = *(const f32x4*)(bcum + (size_t)(t0 + t) * 256 + h * 64 + c8 + 4);
    { const int id = tid; const int tt = id >> 4, e8 = (id & 15) * 8; r.vw0 = *(const u32x4*)(p + (size_t)(t0 + tt) * NP + COL_V + h * 128 + e8); }
    { const int id = tid + 512; const int tt = id >> 4, e8 = (id & 15) * 8; r.vw1 = *(const u32x4*)(p + (size_t)(t0 + tt) * NP + COL_V + h * 128 + e8); }
    { const int id = tid; const int e = id >> 3, d8 = (id & 7) * 8; r.sw0 = *(const u32x4*)(sT + (size_t)idx * 8192 + e * 64 + d8); }
    { const int id = tid + 512; const int e = id >> 3, d8 = (id & 7) * 8; r.sw1 = *(const u32x4*)(sT + (size_t)idx * 8192 + e * 64 + d8); }
    { const int seg = tid & 7; const bf16_t* rp = p + (size_t)(t0 + t) * NP + COL_R + h * 128 + seg * 16; r.r0 = *(const u32x4*)rp; r.r1 = *(const u32x4*)(rp + 8); }
}
__device__ __forceinline__ void gla2_item(const Params& P, int l, int idx, int nidx, const G2R& R, G2R& RN, LAS unsigned char* lds) {
    const int tid = ltid(), lane = tid & 63, wid = tid >> 6, fr = lane & 15, fq = lane >> 4;
    bf16_t* ycat = (bf16_t*)(P.ws + WS_YCAT);
    const int h = idx & 3, bn = idx >> 2; const int t0 = bn * 64;
    LAS bf16_t* qd = (LAS bf16_t*)lds;
    LAS bf16_t* kd = (LAS bf16_t*)(lds + 9216);
    LAS bf16_t* vT = (LAS bf16_t*)(lds + 18432);
    LAS bf16_t* Ps = (LAS bf16_t*)(lds + 36864);
    LAS bf16_t* sTs = (LAS bf16_t*)(lds + 46080);
    LAS float* of = (LAS float*)(lds + 64512);
    {
        const int t = tid >> 3, c8 = (tid & 7) * 8;
        const u32x4 qw = R.qw, kw = R.kw; const f32x4 b0 = R.b0, b1 = R.b1;
        float bb[8] = {b0[0], b0[1], b0[2], b0[3], b1[0], b1[1], b1[2], b1[3]}; float qv[8], kv[8];
#pragma unroll
        for (int q = 0; q < 4; ++q) { qv[2 * q] = bflo(qw[q]); qv[2 * q + 1] = bfhi(qw[q]); kv[2 * q] = bflo(kw[q]); kv[2 * q + 1] = bfhi(kw[q]); }
#pragma unroll
        for (int q = 0; q < 8; ++q) { const float e = __expf(bb[q]); qv[q] = qv[q] * 0.125f * e; kv[q] = kv[q] / e; }
        *(LAS u32x4*)(qd + t * 72 + c8) = (u32x4){pk2(qv[0], qv[1]), pk2(qv[2], qv[3]), pk2(qv[4], qv[5]), pk2(qv[6], qv[7])};
        *(LAS u32x4*)(kd + t * 72 + c8) = (u32x4){pk2(kv[0], kv[1]), pk2(kv[2], kv[3]), pk2(kv[4], kv[5]), pk2(kv[6], kv[7])};
#pragma unroll
        for (int i = 0; i < 2; ++i) { const int id = tid + i * 512; const int tt = id >> 4, e8 = (id & 15) * 8;
            const u32x4 w = i == 0 ? R.vw0 : R.vw1;
#pragma unroll
            for (int q = 0; q < 4; ++q) { vT[(e8 + 2 * q) * 72 + tt] = (bf16_t)(w[q] & 0xffffu); vT[(e8 + 2 * q + 1) * 72 + tt] = (bf16_t)(w[q] >> 16); } }
#pragma unroll
        for (int i = 0; i < 2; ++i) { const int id = tid + i * 512; const int e = id >> 3, d8 = (id & 7) * 8;
            *(LAS u32x4*)(sTs + e * 72 + d8) = i == 0 ? R.sw0 : R.sw1; }
    }
    __syncthreads();
    if (nidx >= 0) gla2_load(P, nidx, tid, RN);
#pragma unroll
    for (int q = 0; q < 2; ++q) { const int tile = wid * 2 + q; const int ti = tile >> 2, si = tile & 3;
        f32x4 acc = {0.f, 0.f, 0.f, 0.f};
        if (si <= ti) {
#pragma unroll
            for (int ks = 0; ks < 2; ++ks) { const bf16x8 a = ldfrag(qd, ti * 16 + fr, 72, ks * 32 + 8 * fq), b = ldfrag(kd, si * 16 + fr, 72, ks * 32 + 8 * fq);
                acc = __builtin_amdgcn_mfma_f32_16x16x32_bf16(a, b, acc, 0, 0, 0); } }
        const int s = si * 16 + fr;
#pragma unroll
        for (int j = 0; j < 4; ++j) { const int t = ti * 16 + 4 * fq + j; Ps[t * 72 + s] = f2bf(s <= t ? acc[j] : 0.f); } }
    __syncthreads();
#pragma unroll
    for (int q = 0; q < 4; ++q) { const int tile = wid * 4 + q; const int ti = tile >> 3, ei = tile & 7;
        f32x4 acc = {0.f, 0.f, 0.f, 0.f};
#pragma unroll
        for (int ks = 0; ks < 2; ++ks) { const bf16x8 a = ldfrag(Ps, ti * 16 + fr, 72, ks * 32 + 8 * fq), b = ldfrag(vT, ei * 16 + fr, 72, ks * 32 + 8 * fq);
            acc = __builtin_amdgcn_mfma_f32_16x16x32_bf16(a, b, acc, 0, 0, 0); }
#pragma unroll
        for (int ks = 0; ks < 2; ++ks) { const bf16x8 a = ldfrag(qd, ti * 16 + fr, 72, ks * 32 + 8 * fq), b = ldfrag(sTs, ei * 16 + fr, 72, ks * 32 + 8 * fq);
            acc = __builtin_amdgcn_mfma_f32_16x16x32_bf16(a, b, acc, 0, 0, 0); }
#pragma unroll
        for (int j = 0; j < 4; ++j) of[(ti * 16 + 4 * fq + j) * 132 + ei * 16 + fr] = acc[j]; }
    __syncthreads();
    {
        const int t = tid >> 3, seg = tid & 7;
        float o[16]; float ss = 0.f;
#pragma unroll
        for (int q = 0; q < 4; ++q) { const f32x4 v = *(const LAS f32x4*)(of + t * 132 + seg * 16 + 4 * q); o[4 * q] = v[0]; o[4 * q + 1] = v[1]; o[4 * q + 2] = v[2]; o[4 * q + 3] = v[3]; ss += v[0] * v[0] + v[1] * v[1] + v[2] * v[2] + v[3] * v[3]; }
        ss += __shfl_xor(ss, 1); ss += __shfl_xor(ss, 2); ss += __shfl_xor(ss, 4);
        const float rstd = rsqrtf(ss * (1.f / 128.f) + LN_EPS);
        const float* gn = P.in[6] + l * 512 + h * 128 + seg * 16;
        const u32x4 r0 = R.r0, r1 = R.r1;
        float rv[16];
#pragma unroll
        for (int q = 0; q < 4; ++q) { rv[2 * q] = bflo(r0[q]); rv[2 * q + 1] = bfhi(r0[q]); rv[8 + 2 * q] = bflo(r1[q]); rv[8 + 2 * q + 1] = bfhi(r1[q]); }
        float y[16];
#pragma unroll
        for (int q = 0; q < 16; ++q) y[q] = o[q] * rstd * gn[q] * (rv[q] * sigmoid_f(rv[q]));
        bf16_t* yo = ycat + (size_t)(t0 + t) * DM + h * 128 + seg * 16;
        *(u32x4*)yo = (u32x4){pk2(y[0], y[1]), pk2(y[2], y[3]), pk2(y[4], y[5]), pk2(y[6], y[7])};
        *(u32x4*)(yo + 8) = (u32x4){pk2(y[8], y[9]), pk2(y[10], y[11]), pk2(y[12], y[13]), pk2(y[14], y[15])};
    }
    __syncthreads();
}

__device__ __forceinline__ void attn_item(const Params& P, int l, int item, LAS unsigned char* lds) {
    const int tid = ltid(), lane = tid & 63, wid = tid >> 6, fr = lane & 15, fq = lane >> 4;
    const int qt = item & 31, h = (item >> 5) & 3, b = item >> 7;
    const bf16_t* qb = (const bf16_t*)(P.ws + WS_QB) + (size_t)(b * SEQL + qt * 128) * DM + h * 256;
    const bf16_t* km = (const bf16_t*)(P.ws + WS_KM + l * SZ_SQ) + (size_t)(b * 256) * DM + h * 256;
    const bf16_t* vt = (const bf16_t*)(P.ws + WS_VT + l * SZ_SQ) + ((size_t)b * 1024 + h * 256) * 256;
    bf16_t* ob = (bf16_t*)(P.ws + WS_OB) + (size_t)(b * SEQL + qt * 128) * DM + h * 256;
    LAS bf16_t* QP = (LAS bf16_t*)lds;
    LAS bf16_t* KV = (LAS bf16_t*)(lds + 67584);
#pragma unroll
    for (int i = 0; i < 8; ++i) { const int id = tid + i * 512; const int r = id >> 5, c8 = (id & 31) * 8; *(LAS u32x4*)(QP + r * 264 + c8) = *(const u32x4*)(qb + (size_t)r * DM + c8); }
    u32x4 pre[4];
#pragma unroll
    for (int i = 0; i < 4; ++i) { const int id = tid + i * 512; const int r = id >> 5, c8 = (id & 31) * 8; pre[i] = *(const u32x4*)(km + (size_t)r * DM + c8); }
#pragma unroll
    for (int i = 0; i < 4; ++i) { const int id = tid + i * 512; const int r = id >> 5, c8 = (id & 31) * 8; *(LAS u32x4*)(KV + r * 264 + c8) = pre[i]; }
    __syncthreads();
#ifdef ATT_DBG0
    {
#if ATT_DBG0 == 1
#pragma unroll
    for (int i = 0; i < 8; ++i) { const int id = tid + i * 512; const int r = id >> 5, c8 = (id & 31) * 8; *(u32x4*)(ob + (size_t)r * DM + c8) = *(const LAS u32x4*)(QP + r * 264 + c8); }
#else
#pragma unroll
    for (int i = 0; i < 4; ++i) { const int id = tid + i * 512; const int r = id >> 5, c8 = (id & 31) * 8; *(u32x4*)(ob + (size_t)r * DM + c8) = *(const LAS u32x4*)(KV + r * 264 + c8); *(u32x4*)(ob + (size_t)(r + 64) * DM + c8) = *(const LAS u32x4*)(KV + r * 264 + c8); }
#endif
    __syncthreads(); return; }
#endif
    bf16x8 aq[8];
#pragma unroll
    for (int ks = 0; ks < 8; ++ks) aq[ks] = ldfrag(QP, wid * 16 + fr, 264, ks * 32 + 8 * fq);
    f32x4 acc[16];
#pragma unroll
    for (int i = 0; i < 16; ++i) acc[i] = (f32x4){0.f, 0.f, 0.f, 0.f};
#pragma unroll
    for (int c = 0; c < 4; ++c) {
#pragma unroll
        for (int kt = 0; kt < 4; ++kt)
#pragma unroll
            for (int ks = 0; ks < 8; ++ks) acc[c * 4 + kt] = __builtin_amdgcn_mfma_f32_16x16x32_bf16(aq[ks], ldfrag(KV, kt * 16 + fr, 264, ks * 32 + 8 * fq), acc[c * 4 + kt], 0, 0, 0);
        __syncthreads();
#pragma unroll
        for (int i = 0; i < 4; ++i) { const int id = tid + i * 512; const int r = id >> 5, c8 = (id & 31) * 8;
            *(LAS u32x4*)(KV + r * 264 + c8) = (c < 3) ? *(const u32x4*)(km + (size_t)((c + 1) * 64 + r) * DM + c8) : *(const u32x4*)(vt + (size_t)r * 256 + c8); }
        __syncthreads();
    }
#ifdef ATT_DBG1
    {
#pragma unroll
    for (int i = 0; i < 16; ++i)
#pragma unroll
        for (int j = 0; j < 4; ++j) ob[(size_t)(wid * 16 + 4 * fq + j) * DM + i * 16 + fr] = f2bf(acc[i][j]);
    return; }
#endif
#pragma unroll
    for (int j = 0; j < 4; ++j) {
        float mx = -1e30f;
#pragma unroll
        for (int i = 0; i < 16; ++i) mx = fmaxf(mx, acc[i][j]);
        mx = fmaxf(mx, __shfl_xor(mx, 1)); mx = fmaxf(mx, __shfl_xor(mx, 2)); mx = fmaxf(mx, __shfl_xor(mx, 4)); mx = fmaxf(mx, __shfl_xor(mx, 8));
        float sm = 0.f;
#pragma unroll
        for (int i = 0; i < 16; ++i) { const float e = __expf((acc[i][j] - mx) * 0.0625f); acc[i][j] = e; sm += e; }
        sm += __shfl_xor(sm, 1); sm += __shfl_xor(sm, 2); sm += __shfl_xor(sm, 4); sm += __shfl_xor(sm, 8);
        const float inv = 1.f / sm;
#pragma unroll
        for (int i = 0; i < 16; ++i) QP[(wid * 16 + 4 * fq + j) * 264 + i * 16 + fr] = f2bf(acc[i][j] * inv);
    }
    WBAR();
#pragma unroll
    for (int ks = 0; ks < 8; ++ks) aq[ks] = ldfrag(QP, wid * 16 + fr, 264, ks * 32 + 8 * fq);
#pragma unroll
    for (int i = 0; i < 16; ++i) acc[i] = (f32x4){0.f, 0.f, 0.f, 0.f};
#pragma unroll
    for (int c = 0; c < 4; ++c) {
#pragma unroll
        for (int dt = 0; dt < 4; ++dt)
#pragma unroll
            for (int ks = 0; ks < 8; ++ks) acc[c * 4 + dt] = __builtin_amdgcn_mfma_f32_16x16x32_bf16(aq[ks], ldfrag(KV, dt * 16 + fr, 264, ks * 32 + 8 * fq), acc[c * 4 + dt], 0, 0, 0);
        __syncthreads();
        if (c < 3) {
#pragma unroll
            for (int i = 0; i < 4; ++i) { const int id = tid + i * 512; const int r = id >> 5, c8 = (id & 31) * 8; *(LAS u32x4*)(KV + r * 264 + c8) = *(const u32x4*)(vt + (size_t)((c + 1) * 64 + r) * 256 + c8); } }
        __syncthreads();
    }
#pragma unroll
    for (int i = 0; i < 16; ++i)
#pragma unroll
        for (int j = 0; j < 4; ++j) ob[(size_t)(wid * 16 + 4 * fq + j) * DM + i * 16 + fr] = f2bf(acc[i][j]);
}

__device__ __forceinline__ void ln_core(f32x4 (&v)[4], const float* g, const float* b, int lane) {
    float s = 0.f;
#pragma unroll
    for (int j = 0; j < 4; ++j) s += (v[j][0] + v[j][1]) + (v[j][2] + v[j][3]);
    const float mean = wave_sum(s) * (1.f / DM);
    float s2 = 0.f;
#pragma unroll
    for (int j = 0; j < 4; ++j) { v[j] = v[j] - mean; s2 += (v[j][0] * v[j][0] + v[j][1] * v[j][1]) + (v[j][2] * v[j][2] + v[j][3] * v[j][3]); }
    const float rstd = rsqrtf(wave_sum(s2) * (1.f / DM) + LN_EPS);
#pragma unroll
    for (int j = 0; j < 4; ++j) { const f32x4 gg = *(const f32x4*)(g + j * 256 + lane * 4), bb = *(const f32x4*)(b + j * 256 + lane * 4); v[j] = v[j] * rstd * gg + bb; }
}
__device__ __forceinline__ void ln_store(const f32x4 (&v)[4], float* of, bf16_t* obf, int lane) {
#pragma unroll
    for (int j = 0; j < 4; ++j) { *(f32x4*)(of + j * 256 + lane * 4) = v[j]; if (obf) *(u32x2*)(obf + j * 256 + lane * 4) = (u32x2){pk2(v[j][0], v[j][1]), pk2(v[j][2], v[j][3])}; }
}
__device__ __forceinline__ void phase_ln1(const Params& P, int l) {
    const int tid = ltid(); const int lane = tid & 63, wid = __builtin_amdgcn_readfirstlane(tid >> 6); const int gw = blockIdx.x * 8 + wid, NGW = gridDim.x * 8;
    const float* y = (const float*)(P.ws + WS_YBUF); float* xf = (float*)(P.ws + WS_XF); bf16_t* xb = (bf16_t*)(P.ws + WS_XB);
    for (int m = gw; m < NTOK; m += NGW) { f32x4 v[4];
#pragma unroll
        for (int j = 0; j < 4; ++j) v[j] = *(const f32x4*)(y + (size_t)m * DM + j * 256 + lane * 4);
        ln_core(v, P.in[17] + l * DM, P.in[18] + l * DM, lane);
        ln_store(v, xf + (size_t)m * DM, xb + (size_t)m * DM, lane); }
}
__device__ __forceinline__ void phase_ln2_router(const Params& P, int l, LAS unsigned char* lds) {
    const int tid = ltid(); const int lane = tid & 63, wid = __builtin_amdgcn_readfirstlane(tid >> 6); const int gw = blockIdx.x * 8 + wid, NGW = gridDim.x * 8;
    const float* y = (const float*)(P.ws + WS_YBUF); float* xf = (float*)(P.ws + WS_XF); bf16_t* xb = (bf16_t*)(P.ws + WS_XB);
    int* cnt = (int*)(P.ws + WS_CTL) + l * 32; int* elist = (int*)(P.ws + WS_ELIST); float* tgate = (float*)(P.ws + WS_TGATE);
    LAS float* xs = (LAS float*)(lds + wid * 16384);
    const float* rw = P.in[25] + (size_t)l * 1024 * 32; const float* rb = P.in[26] + l * 32;
    for (int pr = gw; pr < NTOK / 4; pr += NGW) {
#pragma unroll
        for (int rr = 0; rr < 4; ++rr) { const int m = pr * 4 + rr; f32x4 v[4];
#pragma unroll
            for (int j = 0; j < 4; ++j) v[j] = *(const f32x4*)(y + (size_t)m * DM + j * 256 + lane * 4);
            ln_core(v, P.in[23] + l * DM, P.in[24] + l * DM, lane);
            ln_store(v, xf + (size_t)m * DM, xb + (size_t)m * DM, lane);
#pragma unroll
            for (int j = 0; j < 4; ++j) *(LAS f32x4*)(xs + rr * 1024 + j * 256 + lane * 4) = v[j]; }
        WBAR();
        const int e = lane & 31, hf = lane >> 5;
        float a[4] = {0.f, 0.f, 0.f, 0.f};
        for (int kb = 0; kb < 16; ++kb) { const int k0 = hf * 512 + kb * 32;
            float w[32];
#pragma unroll
            for (int j = 0; j < 32; ++j) w[j] = rw[(k0 + j) * 32 + e];
#pragma unroll
            for (int j4 = 0; j4 < 8; ++j4)
#pragma unroll
                for (int rr = 0; rr < 4; ++rr) { const f32x4 x = *(const LAS f32x4*)(xs + rr * 1024 + k0 + j4 * 4);
                    a[rr] += x[0] * w[4 * j4]; a[rr] += x[1] * w[4 * j4 + 1]; a[rr] += x[2] * w[4 * j4 + 2]; a[rr] += x[3] * w[4 * j4 + 3]; } }
        const float bias = rb[e];
#pragma unroll
        for (int rr = 0; rr < 4; ++rr) { const int m = pr * 4 + rr;
            float lg = a[rr] + __shfl_xor(a[rr], 32) + bias; lg = (lg == lg) ? fminf(fmaxf(lg, -1e30f), 1e30f) : -1e30f; float v = (lane < 32) ? lg : -3e38f;
            float tv[4]; int te[4];
#pragma unroll
            for (int k = 0; k < 4; ++k) { const float mx = wave_max(v); const unsigned long long bal = __ballot(v == mx); const int idx = (__ffsll((long long)bal) - 1) & 31; tv[k] = mx; te[k] = idx; if (lane == idx) v = -3e38f; }
            const float e1 = __expf(tv[1] - tv[0]), e2 = __expf(tv[2] - tv[0]), e3 = __expf(tv[3] - tv[0]); const float inv = 1.f / (1.f + e1 + e2 + e3);
            if (lane < 4) { const int ee = lane == 0 ? te[0] : (lane == 1 ? te[1] : (lane == 2 ? te[2] : te[3])); const float gg = (lane == 0 ? 1.f : (lane == 1 ? e1 : (lane == 2 ? e2 : e3))) * inv;
                const int pos = atomicAdd(cnt + ee, 1); elist[ee * ECAP + pos] = m * 4 + lane; tgate[m * 4 + lane] = gg; } }
        WBAR();
    }
}
__device__ __forceinline__ void phase_router_old(const Params& P, int l, LAS unsigned char* lds) {
    const int tid = ltid(); const int lane = tid & 63, wid = __builtin_amdgcn_readfirstlane(tid >> 6); const int gw = blockIdx.x * 8 + wid, NGW = gridDim.x * 8;
    const float* y = (const float*)(P.ws + WS_YBUF); float* xf = (float*)(P.ws + WS_XF); bf16_t* xb = (bf16_t*)(P.ws + WS_XB);
    int* cnt = (int*)(P.ws + WS_CTL) + l * 32; int* elist = (int*)(P.ws + WS_ELIST); float* tgate = (float*)(P.ws + WS_TGATE);
    LAS float* xs = (LAS float*)(lds + wid * 16384);
    const float* rw = P.in[25] + (size_t)l * 1024 * 32; const float* rb = P.in[26] + l * 32;
    for (int pr = gw; pr < NTOK / 4; pr += NGW) {
#pragma unroll
        for (int rr = 0; rr < 4; ++rr) { const int m = pr * 4 + rr; f32x4 v[4];
#pragma unroll
            for (int j = 0; j < 4; ++j) v[j] = *(const f32x4*)(xf + (size_t)m * DM + j * 256 + lane * 4);
#pragma unroll
            for (int j = 0; j < 4; ++j) *(LAS f32x4*)(xs + rr * 1024 + j * 256 + lane * 4) = v[j]; }
        WBAR();
        const int e = lane & 31, hf = lane >> 5;
        float a[4] = {0.f, 0.f, 0.f, 0.f};
        for (int kb = 0; kb < 16; ++kb) { const int k0 = hf * 512 + kb * 32;
            float w[32];
#pragma unroll
            for (int j = 0; j < 32; ++j) w[j] = rw[(k0 + j) * 32 + e];
#pragma unroll
            for (int j4 = 0; j4 < 8; ++j4)
#pragma unroll
                for (int rr = 0; rr < 4; ++rr) { const f32x4 x = *(const LAS f32x4*)(xs + rr * 1024 + k0 + j4 * 4);
                    a[rr] += x[0] * w[4 * j4]; a[rr] += x[1] * w[4 * j4 + 1]; a[rr] += x[2] * w[4 * j4 + 2]; a[rr] += x[3] * w[4 * j4 + 3]; } }
        const float bias = rb[e];
#pragma unroll
        for (int rr = 0; rr < 4; ++rr) { const int m = pr * 4 + rr;
            float lg = a[rr] + __shfl_xor(a[rr], 32) + bias; lg = (lg == lg) ? fminf(fmaxf(lg, -1e30f), 1e30f) : -1e30f; float v = (lane < 32) ? lg : -3e38f;
            float tv[4]; int te[4];
#pragma unroll
            for (int k = 0; k < 4; ++k) { const float mx = wave_max(v); const unsigned long long bal = __ballot(v == mx); const int idx = (__ffsll((long long)bal) - 1) & 31; tv[k] = mx; te[k] = idx; if (lane == idx) v = -3e38f; }
            const float e1 = __expf(tv[1] - tv[0]), e2 = __expf(tv[2] - tv[0]), e3 = __expf(tv[3] - tv[0]); const float inv = 1.f / (1.f + e1 + e2 + e3);
            if (lane < 4) { const int ee = lane == 0 ? te[0] : (lane == 1 ? te[1] : (lane == 2 ? te[2] : te[3])); const float gg = (lane == 0 ? 1.f : (lane == 1 ? e1 : (lane == 2 ? e2 : e3))) * inv;
                const int pos = atomicAdd(cnt + ee, 1); elist[ee * ECAP + pos] = m * 4 + lane; tgate[m * 4 + lane] = gg; } }
        WBAR();
    }
}
__device__ __forceinline__ void phase_router(const Params& P, int l, LAS unsigned char* lds) {
    if (gridDim.x != 256) { phase_router_old(P, l, lds); return; }
    const int tid = ltid(); const int lane = tid & 63, wid = __builtin_amdgcn_readfirstlane(tid >> 6); const int gw = blockIdx.x * 8 + wid, NGW = gridDim.x * 8;
    const float* xf = (const float*)(P.ws + WS_XF);
    int* cnt = (int*)(P.ws + WS_CTL) + l * 32; int* elist = (int*)(P.ws + WS_ELIST); float* tgate = (float*)(P.ws + WS_TGATE);
    LAS float* xs = (LAS float*)(lds + wid * 16384);
    LAS int* lcnt = (LAS int*)(lds + 131072 + 256); LAS int* lbase = (LAS int*)(lds + 131072 + 384);
    const float* rw = P.in[25] + (size_t)l * 1024 * 32; const float* rb = P.in[26] + l * 32;
    if (tid < 32) lcnt[tid] = 0;
    __syncthreads();
    int rec_e[2][4], rec_p[2][4];
    {
        const int e = lane & 31, hf = lane >> 5;
        float a[8] = {0.f, 0.f, 0.f, 0.f, 0.f, 0.f, 0.f, 0.f};
#pragma unroll 1
        for (int ps = 0; ps < 2; ++ps) {
#pragma unroll
            for (int r8 = 0; r8 < 8; ++r8) { const int m = (gw + (r8 >> 2) * NGW) * 4 + (r8 & 3);
#pragma unroll
                for (int j = 0; j < 2; ++j) *(LAS f32x4*)(xs + r8 * 512 + j * 256 + lane * 4) = *(const f32x4*)(xf + (size_t)m * DM + ps * 512 + j * 256 + lane * 4); }
            WBAR();
            for (int kb = 0; kb < 8; ++kb) { const int kl = hf * 256 + kb * 32;
                float w[32];
#pragma unroll
                for (int j = 0; j < 32; ++j) w[j] = rw[(ps * 512 + kl + j) * 32 + e];
#pragma unroll
                for (int j4 = 0; j4 < 8; ++j4)
#pragma unroll
                    for (int r8 = 0; r8 < 8; ++r8) { const f32x4 x = *(const LAS f32x4*)(xs + r8 * 512 + kl + j4 * 4);
                        a[r8] += x[0] * w[4 * j4]; a[r8] += x[1] * w[4 * j4 + 1]; a[r8] += x[2] * w[4 * j4 + 2]; a[r8] += x[3] * w[4 * j4 + 3]; } }
            WBAR();
        }
        const float bias = rb[e];
#pragma unroll
        for (int r8 = 0; r8 < 8; ++r8) { const int q = r8 >> 2, rr = r8 & 3; const int m = (gw + q * NGW) * 4 + rr;
            float lg = a[r8] + __shfl_xor(a[r8], 32) + bias; lg = (lg == lg) ? fminf(fmaxf(lg, -1e30f), 1e30f) : -1e30f; float v = (lane < 32) ? lg : -3e38f;
            float tv[4]; int te[4];
#pragma unroll
            for (int k = 0; k < 4; ++k) { const float mx = wave_max(v); const unsigned long long bal = __ballot(v == mx); const int idx = (__ffsll((long long)bal) - 1) & 31; tv[k] = mx; te[k] = idx; if (lane == idx) v = -3e38f; }
            const float e1 = __expf(tv[1] - tv[0]), e2 = __expf(tv[2] - tv[0]), e3 = __expf(tv[3] - tv[0]); const float inv = 1.f / (1.f + e1 + e2 + e3);
            rec_e[q][rr] = 0; rec_p[q][rr] = 0;
            if (lane < 4) { const int ee = lane == 0 ? te[0] : (lane == 1 ? te[1] : (lane == 2 ? te[2] : te[3])); const float gg = (lane == 0 ? 1.f : (lane == 1 ? e1 : (lane == 2 ? e2 : e3))) * inv;
                rec_e[q][rr] = ee; rec_p[q][rr] = __hip_atomic_fetch_add(lcnt + ee, 1, __ATOMIC_RELAXED, __HIP_MEMORY_SCOPE_WORKGROUP); tgate[m * 4 + lane] = gg; } }
    }
    __syncthreads();
    if (tid < 32) lbase[tid] = atomicAdd(cnt + tid, lcnt[tid]);
    __syncthreads();
    if (lane < 4) {
#pragma unroll
        for (int q = 0; q < 2; ++q)
#pragma unroll
            for (int rr = 0; rr < 4; ++rr) { const int m = (gw + q * NGW) * 4 + rr; const int ee = rec_e[q][rr]; elist[ee * ECAP + lbase[ee] + rec_p[q][rr]] = m * 4 + lane; } }
    __syncthreads();
}
__device__ __forceinline__ void phase_ln3(const Params& P, int l) {
    const int tid = ltid(); const int lane = tid & 63, wid = __builtin_amdgcn_readfirstlane(tid >> 6); const int gw = blockIdx.x * 8 + wid, NGW = gridDim.x * 8;
    float* xf = (float*)(P.ws + WS_XF); bf16_t* xb = (bf16_t*)(P.ws + WS_XB); const bf16_t* ys = (const bf16_t*)(P.ws + WS_YS);
    for (int m = gw; m < NTOK; m += NGW) { f32x4 v[4];
#pragma unroll
        for (int j = 0; j < 4; ++j) { v[j] = *(const f32x4*)(xf + (size_t)m * DM + j * 256 + lane * 4) * ALPHA;
#pragma unroll
            for (int k = 0; k < 4; ++k) { const u32x2 w = *(const u32x2*)(ys + ((size_t)m * 4 + k) * DM + j * 256 + lane * 4); v[j] += (f32x4){bflo(w[0]), bfhi(w[0]), bflo(w[1]), bfhi(w[1])}; } }
        ln_core(v, P.in[31] + l * DM, P.in[32] + l * DM, lane);
        if (l == 1) ln_store(v, P.out + (size_t)m * DM, nullptr, lane); else ln_store(v, xf + (size_t)m * DM, xb + (size_t)m * DM, lane); }
}

__device__ __forceinline__ void set_base(ProbBase& S, const void* A, int lda, const void* Bt, int ldb, int M, int N, int K, int G, int c) { S.A = (const char*)A; S.Bt = (const char*)Bt; S.init(M, N, G, c); }

typedef const Params __attribute__((address_space(4))) CParams;
__global__ void __launch_bounds__(512, 2) mega(Params Pk) {
    extern __shared__ __attribute__((aligned(16))) unsigned char smem[];
    LAS unsigned char* lds = (LAS unsigned char*)smem;
    cg::grid_group grid = cg::this_grid();
    CParams* kp = (CParams*)__builtin_amdgcn_kernarg_segment_ptr();
    const int lo = Pk.ph_lo, hi = Pk.ph_hi;
    int nbar = 0;
#ifndef PHMASK
#define PHMASK 0xffffffffu
#endif
#define EN(k) (((PHMASK) >> (k)) & 1u)
#ifndef REPMASK
#define REPMASK 0u
#endif
#define NREP(k) ((((REPMASK) >> (k)) & 1u) ? 2 : 1)
#define RB(k) for (int rep_ = 0; rep_ < NREP(k); ++rep_) { if (rep_) GRID_BARRIER();
#define RE }
#define GRID_BARRIER() do { asm volatile("s_waitcnt vmcnt(0) lgkmcnt(0)" ::: "memory"); __syncthreads(); \
        if (nbar == 0) grid.sync(); \
        if (ltid() == 0) { unsigned* bw = (unsigned*)(kp->ws + WS_CTL + 1024) + nbar * 160; const unsigned gx = gridDim.x, sg = blockIdx.x & 7u; const unsigned nsub = (gx + 7u - sg) >> 3; const unsigned ngrp = gx < 8u ? gx : 8u; \
            __builtin_amdgcn_fence(__ATOMIC_RELEASE, "agent"); asm volatile("s_waitcnt vmcnt(0)" ::: "memory"); \
            const unsigned old = __hip_atomic_fetch_add(bw + 16 + sg * 16, 1u, __ATOMIC_RELAXED, __HIP_MEMORY_SCOPE_AGENT); \
            if (old + 1u == nsub) __hip_atomic_fetch_add(bw, 1u, __ATOMIC_RELAXED, __HIP_MEMORY_SCOPE_AGENT); \
            while (__hip_atomic_load(bw, __ATOMIC_RELAXED, __HIP_MEMORY_SCOPE_AGENT) < ngrp) __builtin_amdgcn_s_sleep(1); \
            __builtin_amdgcn_fence(__ATOMIC_ACQUIRE, "agent"); asm volatile("s_waitcnt vmcnt(0)" ::: "memory"); } \
        __syncthreads(); ++nbar; } while (0)
#define LOCAL_SYNC() do { asm volatile("s_waitcnt vmcnt(0) lgkmcnt(0)" ::: "memory"); __syncthreads(); if (ltid() < 64) { asm volatile("buffer_inv sc1\n\ts_waitcnt vmcnt(0)" ::: "memory"); } __syncthreads(); } while (0)
#define PH_BEGIN(id) if ((id) >= lo && (id) < hi) { CParams* kq = kp; asm volatile("" : "+s"(kq)); const Params& P = *(const Params*)kq; unsigned char* ws = P.ws; \
        int G = gridDim.x, bx = blockIdx.x; asm volatile("" : "+s"(G), "+s"(bx)); (void)ws; (void)G; (void)bx;
#define PH_END(id) if ((id) + 1 < hi) GRID_BARRIER(); }
    PH_BEGIN(0) if (EN(0)) RB(0) phase_convert(P, lds);  RE PH_END(0)
#define LAYER(l, B) \
    PH_BEGIN(B + 0) if (EN(1)) RB(1) { \
        { ProbInProj S; set_base(S, ws + WS_XB, 2048, ws + WS_WIN + l * SZ_WIN, 2048, NTOK, NP, 1024, G, bx); S.out = (bf16_t*)(ws + WS_P); S.bias = P.in[3] + (size_t)l * NIN; gemm_phase(lds, S); } \
        if (l == 0) { for (int ll = 0; ll < 2; ++ll) { \
          { ProbBf16 S; set_base(S, ws + WS_MEMB, 2048, ws + WS_WK + ll * SZ_SQ, 2048, 1024, 1024, 1024, G, (bx + G - 128 - 32 * ll) % G); S.out = (bf16_t*)(ws + WS_KM + ll * SZ_SQ); S.ldc = 1024; gemm_phase(lds, S); } \
          { ProbBf16 S; set_base(S, ws + WS_MEMB, 2048, ws + WS_WV + ll * SZ_SQ, 2048, 1024, 1024, 1024, G, (bx + G - 144 - 32 * ll) % G); S.out = (bf16_t*)(ws + WS_VT + ll * SZ_SQ); S.ldc = 1024; gemm_phase(lds, S); } } } }  RE PH_END(B + 0) \
    PH_BEGIN(B + 1) if (EN(2)) RB(2) phase_mixer_local(P, l, lds);  RE PH_END(B + 1) \
    PH_BEGIN(B + 2) if (EN(3)) RB(3) { phase_scan(P); \
        if (l == 0) { for (int ll = 0; ll < 2; ++ll) { \
          { ProbVW S; S.A = (const char*)(ws + WS_WXO + ll * SZ_SQ); S.Bt = (const char*)(ws + WS_VT + ll * SZ_SQ); S.G = G; S.c = (bx + G - 128 * ll) % G; S.out = (bf16_t*)(ws + WS_OB + (size_t)ll * 4 * SZ_SQ); gemm_phase(lds, S); } \
          { ProbMT S; S.A = (const char*)(ws + WS_KM + ll * SZ_SQ); S.Bt = (const char*)(ws + WS_WQ + ll * SZ_SQ); S.G = G; S.c = (bx + G - 64 - 128 * ll) % G; S.out = (bf16_t*)(ws + WS_QB + (size_t)ll * 4 * SZ_SQ); gemm_phase(lds, S); } } } }  RE PH_END(B + 2) \
    PH_BEGIN(B + 3) if (EN(4)) RB(4) { G2R ra, rb; int it = bx; if (it < 1024) { gla2_load(P, it, ltid(), ra); for (;;) { const int i2 = it + G; const bool h2 = i2 < 1024; gla2_item(P, l, it, h2 ? i2 : -1, ra, rb, lds); if (!h2) break; const int i3 = i2 + G; const bool h3 = i3 < 1024; gla2_item(P, l, i2, h3 ? i3 : -1, rb, ra, lds); if (!h3) break; it = i3; } } }  RE PH_END(B + 3) \
    PH_BEGIN(B + 4) if (EN(5)) RB(5) { { ProbMerge<512> S; S.A = (const char*)(ws + WS_YCAT); S.Bt = (const char*)(ws + WS_WUP + l * SZ_SQ); S.G = G; S.c = bx; \
            S.p = (const bf16_t*)(ws + WS_P); S.mb = (bf16_t*)(ws + WS_MRGB); gemm_phase(lds, S); } \
            asm volatile("s_waitcnt vmcnt(0)" ::: "memory"); __syncthreads(); \
            { ProbMerge<256> S; S.A = (const char*)(ws + WS_YCAT); S.Bt = (const char*)(ws + WS_WUP + l * SZ_SQ); S.G = G; S.c = bx; \
            S.p = (const bf16_t*)(ws + WS_P); S.mb = (bf16_t*)(ws + WS_MRGB); gemm_phase(lds, S); } }  RE PH_END(B + 4) \
    PH_BEGIN(B + 5) if (EN(6)) RB(6) { ProbResLN S; set_base(S, ws + WS_MRGB, 2048, ws + WS_WO + l * SZ_SQ, 2048, NTOK, 1024, 1024, G, bx); \
            S.xres = (l == 0) ? P.in[0] : (const float*)(ws + WS_XF); S.lng = P.in[17] + l * DM; S.lnb = P.in[18] + l * DM; S.xf = (float*)(ws + WS_XF); S.xb = (bf16_t*)(ws + WS_XB); \
            S.stats = (float*)(ws + WS_STATS); S.cntp = (unsigned*)(ws + WS_CTL + 24576) + (l * 2 + 0) * 64; S.bstride = 0; gemm_phase(lds, S); }  RE PH_END(B + 5) \
    PH_BEGIN(B + 7) if (EN(8)) RB(8) { ProbAttn<0, 1024> S; S.A = (const char*)(ws + WS_XB); S.Bt = (const char*)(ws + WS_QB + (size_t)l * 4 * SZ_SQ); S.G = G; S.c = bx; S.sout = nullptr; S.oout = (bf16_t*)(ws + WS_MRGF); gemm_phase(lds, S); }  RE PH_END(B + 7) \
    PH_BEGIN(B + 10) if (EN(6)) RB(6) { ProbResLN S; set_base(S, ws + WS_MRGF, 2048, ws + WS_OB + (size_t)l * 4 * SZ_SQ, 2048, NTOK, 1024, 1024, G, bx); \
            S.xres = (const float*)(ws + WS_XF); S.lng = P.in[23] + l * DM; S.lnb = P.in[24] + l * DM; S.xf = (float*)(ws + WS_XF); S.xb = (bf16_t*)(ws + WS_XB); \
            S.stats = (float*)(ws + WS_STATS); S.cntp = (unsigned*)(ws + WS_CTL + 24576) + (l * 2 + 1) * 64; S.bstride = SZ_SQ; gemm_phase(lds, S); }  RE PH_END(B + 10) \
    PH_BEGIN(B + 11) if (EN(10)) RB(10) phase_router(P, l, lds);  RE PH_END(B + 11) \
    PH_BEGIN(B + 12) if (EN(11)) RB(11) { LAS int* tstart = (LAS int*)(lds + 131072); const int* cnt = (const int*)(ws + WS_CTL) + l * 32; \
            if (ltid() == 0) { int a = 0; for (int e = 0; e < 32; ++e) { tstart[e] = a; a += (cnt[e] + 255) >> 8; } tstart[32] = a; } \
            __syncthreads(); \
            ProbMoe1 S; S.G = G; S.c = (G % 8 == 0) ? (bx % 8) * (G / 8) + bx / 8 : bx; S.nN = 8; S.tstart = tstart; S.cnt = cnt; \
            S.A = (const char*)(ws + WS_XB); S.Bt = (const char*)(ws + WS_WGU + l * SZ_WGU); \
            S.elist = (const int*)(ws + WS_ELIST); S.bgu = P.in[28] + (size_t)l * 32 * 2048; S.abuf = (bf16_t*)(ws + WS_ABUF); gemm_phase(lds, S); }  RE PH_END(B + 12) \
    PH_BEGIN(B + 13) if (EN(12)) RB(12) { LAS int* tstart = (LAS int*)(lds + 131072); const int* cnt = (const int*)(ws + WS_CTL) + l * 32; \
            if (ltid() == 0) { int a = 0; for (int e = 0; e < 32; ++e) { tstart[e] = a; a += (cnt[e] + 255) >> 8; } tstart[32] = a; } \
            __syncthreads(); \
            ProbMoe2 S; S.G = G; S.c = (G % 8 == 0) ? (bx % 8) * (G / 8) + bx / 8 : bx; S.nN = 4; S.tstart = tstart; S.cnt = cnt; \
            S.A = (const char*)(ws + WS_ABUF); S.Bt = (const char*)(ws + WS_WD + l * SZ_WD); \
            S.elist = (const int*)(ws + WS_ELIST); S.bd = P.in[30] + (size_t)l * 32 * 1024; S.tgate = (const float*)(ws + WS_TGATE); S.ys = (bf16_t*)(ws + WS_YS); gemm_phase(lds, S); }  RE PH_END(B + 13) \
    PH_BEGIN(B + 14) if (EN(13)) RB(13) phase_ln3(P, l);  RE PH_END(B + 14)
    LAYER(0, 1)
    LAYER(1, 16)
#ifdef EXTRA_BARS
    for (int xb_ = 0; xb_ < EXTRA_BARS; ++xb_) GRID_BARRIER();
#endif
#ifdef DBG_OFF
    { GRID_BARRIER(); const Params& P = *(const Params*)kp; const int G = gridDim.x, bx = blockIdx.x; const int gt = bx * 512 + ltid();
      for (size_t i = gt; i < (size_t)NTOK * DM; i += (size_t)G * 512) {
#if DBG_BF16
          { float dv = bf2f(((const bf16_t*)(P.ws + DBG_OFF))[i]); P.out[i] = (dv == dv && fabsf(dv) < 1e30f) ? dv : 1000.f; }
#else
          P.out[i] = ((const float*)(P.ws + DBG_OFF))[i];
#endif
      } }
#endif
}

extern "C" void kernel_launch(void* const* d_in, const int* in_sizes, int n_in, void* d_out, int out_size, void* d_ws, size_t ws_size, hipStream_t stream) {
    static int grid = 0;
    if (grid == 0) {
        int dev = 0, cus = 0, per_cu = 0;
        hipGetDevice(&dev);
        hipDeviceGetAttribute(&cus, hipDeviceAttributeMultiprocessorCount, dev);
        hipFuncSetAttribute((const void*)mega, hipFuncAttributeMaxDynamicSharedMemorySize, LDS_BYTES);
        hipOccupancyMaxActiveBlocksPerMultiprocessor(&per_cu, (const void*)mega, 512, LDS_BYTES);
        if (per_cu < 1) per_cu = 1;
        grid = cus < 256 ? cus : 256;
        if (ws_size < WS_END) fprintf(stderr, "kernel_launch: workspace too small: %zu < %zu\n", ws_size, (size_t)WS_END);
        if (n_in != 33) fprintf(stderr, "kernel_launch: expected 33 inputs, got %d\n", n_in);
    }
    hipMemsetAsync((char*)d_ws + WS_CTL, 0, 32768, stream);
    Params p{};
    for (int i = 0; i < 33; ++i) p.in[i] = (const float*)d_in[i];
    p.out = (float*)d_out; p.ws = (unsigned char*)d_ws; p.ph_lo = 0; p.ph_hi = PH_HI;
    void* args[] = {&p};
    hipError_t e = hipLaunchCooperativeKernel((const void*)mega, dim3(grid), dim3(512), args, LDS_BYTES, stream);
    if (e != hipSuccess) fprintf(stderr, "cooperative launch failed: %s (grid %d)\n", hipGetErrorString(e), grid);
}
```

```cpp
#include <hip/hip_runtime.h>
#include <hip/hip_cooperative_groups.h>
#include <cstdio>
namespace cg = cooperative_groups;

#define LAS __attribute__((address_space(3)))
typedef unsigned short bf16_t;
typedef short bf16x8 __attribute__((ext_vector_type(8)));
typedef float f32x4 __attribute__((ext_vector_type(4)));
typedef unsigned u32x4 __attribute__((ext_vector_type(4)));
typedef unsigned u32x2 __attribute__((ext_vector_type(2)));

constexpr int NTOK = 16384, DM = 1024, SEQL = 4096, NP = 5632;
constexpr int COL_K = 256, COL_V = 512, COL_R = 1024, COL_UV = 1536, COL_XC = 2048, COL_GATE = 2304, COL_GL = 5376, NIN = 5392;
constexpr float LN_EPS = 1e-5f;
constexpr float ALPHA = 1.41421356237f;
constexpr int ECAP = 16384;
constexpr int LDS_BYTES = 131072 + 1024;
#ifndef PH_HI
#define PH_HI 31
#endif

constexpr size_t al256(size_t x) { return (x + 255) & ~(size_t)255; }
constexpr size_t WS_CTL = 0;
constexpr size_t WS_WIN = 32768;
constexpr size_t SZ_WIN = (size_t)NP * 1024 * 2;
constexpr size_t WS_WUP = WS_WIN + 2 * SZ_WIN;
constexpr size_t SZ_SQ = (size_t)1024 * 1024 * 2;
constexpr size_t WS_WO = WS_WUP + 2 * SZ_SQ;
constexpr size_t WS_WQ = WS_WO + 2 * SZ_SQ;
constexpr size_t WS_WK = WS_WQ + 2 * SZ_SQ;
constexpr size_t WS_WV = WS_WK + 2 * SZ_SQ;
constexpr size_t WS_WXO = WS_WV + 2 * SZ_SQ;
constexpr size_t WS_WGU = WS_WXO + 2 * SZ_SQ;
constexpr size_t SZ_WGU = (size_t)32 * 2048 * 1024 * 2;
constexpr size_t WS_WD = WS_WGU + 2 * SZ_WGU;
constexpr size_t SZ_WD = (size_t)32 * 1024 * 1024 * 2;
constexpr size_t WS_XB = WS_WD + 2 * SZ_WD;
constexpr size_t SZ_ACTB = (size_t)NTOK * 1024 * 2;
constexpr size_t SZ_ACTF = (size_t)NTOK * 1024 * 4;
constexpr size_t WS_MEMB = WS_XB + SZ_ACTB;
constexpr size_t WS_XF = WS_MEMB + SZ_SQ;
constexpr size_t WS_YBUF = WS_XF + SZ_ACTF;
constexpr size_t WS_P = WS_YBUF + SZ_ACTF;
constexpr size_t WS_YCAT = WS_P + (size_t)NTOK * NP * 2;
constexpr size_t WS_BCUM = WS_YCAT + SZ_ACTB;
constexpr size_t WS_KVT = WS_BCUM + (size_t)NTOK * 256 * 4;
constexpr size_t WS_CDEC = WS_KVT + (size_t)1024 * 8192 * 4;
constexpr size_t WS_ST = WS_CDEC + (size_t)1024 * 64 * 4;
constexpr size_t WS_MRGF = WS_ST + (size_t)1024 * 8192 * 2;
constexpr size_t WS_MRGB = WS_MRGF + SZ_ACTF;
constexpr size_t WS_QB = WS_MRGB + SZ_ACTB;
constexpr size_t WS_OB = WS_QB + SZ_ACTB;
constexpr size_t WS_KM = WS_OB + SZ_ACTB;
constexpr size_t WS_VT = WS_KM + 2 * SZ_SQ;
constexpr size_t WS_ELIST = WS_VT + 8 * SZ_SQ;
constexpr size_t WS_TGATE = WS_ELIST + (size_t)32 * ECAP * 4;
constexpr size_t WS_ABUF = WS_TGATE + (size_t)NTOK * 4 * 4;
constexpr size_t WS_YS = WS_ABUF + (size_t)73728 * 1024 * 2;
constexpr size_t WS_STATS = WS_YS + (size_t)65536 * 1024 * 2;
constexpr size_t WS_END = WS_STATS + (size_t)64 * 4 * 256 * 2 * 4;

__device__ __forceinline__ float bf2f(bf16_t b) { return __uint_as_float(((unsigned)b) << 16); }
__device__ __forceinline__ unsigned pk2(float lo, float hi) { unsigned r; asm("v_cvt_pk_bf16_f32 %0, %1, %2" : "=v"(r) : "v"(lo), "v"(hi)); return r; }
__device__ __forceinline__ bf16_t f2bf(float f) { return (bf16_t)(pk2(f, 0.f) & 0xffffu); }
__device__ __forceinline__ float bflo(unsigned u) { return __uint_as_float(u << 16); }
__device__ __forceinline__ float bfhi(unsigned u) { return __uint_as_float(u & 0xffff0000u); }
__device__ __forceinline__ float wave_sum(float v) {
#pragma unroll
    for (int o = 32; o; o >>= 1) v += __shfl_xor(v, o);
    return v;
}
__device__ __forceinline__ float wave_max(float v) {
#pragma unroll
    for (int o = 32; o; o >>= 1) v = fmaxf(v, __shfl_xor(v, o));
    return v;
}
__device__ __forceinline__ float gelu_f(float v) {
    const float av = fabsf(v), t = __builtin_amdgcn_rcpf(av * 0.2316418882f + 1.0f);
    float q = t * 0.5307027145f + (-0.7265760135f); q = q * t + 0.7107068705f; q = q * t + (-0.142248368f); q = q * t + 0.127414796f; q = q * t;
    const float e = __builtin_amdgcn_exp2f((v * v) * (-0.72134752044f));
    const float m = v * (q * e);
    return v < 0.f ? m : v - m;
}
__device__ __forceinline__ float sigmoid_f(float x) { return __builtin_amdgcn_rcpf(1.f + __expf(-x)); }
__device__ __forceinline__ int ltid() { int t = threadIdx.x; asm volatile("" : "+v"(t)); return t; }
#define WBAR() do { asm volatile("" ::: "memory"); __builtin_amdgcn_wave_barrier(); asm volatile("" ::: "memory"); } while (0)

struct Params { const float* in[33]; float* out; unsigned char* ws; int ph_lo, ph_hi; };

constexpr int BM = 256, BK = 64, HALF = 128, HTB = HALF * BK * 2, NXCD = 8, WGM = 8;
__device__ __forceinline__ int lds_byte(int r, int c) { const int st = (r >> 4) * 2 + (c >> 5), rr = r & 15, cc = c & 31, ob = rr * 64 + cc * 2; return st * 1024 + (ob ^ (((ob >> 9) & 1) << 5)); }
__device__ __forceinline__ void stage_rc(int b, int& R, int& C) { const int st = b / 1024, sb = b % 1024, swz = sb ^ (((sb >> 9) & 1) << 5); R = (st >> 1) * 16 + swz / 64; C = (st & 1) * 32 + (swz % 64) / 2; }
__device__ __forceinline__ int perm32(int rho) { const int n = rho >> 4, i = rho & 15; return 8 * (i >> 2) + 4 * n + (i & 3); }

struct Unit { int pm, pn, e, aux; };
typedef f32x4 Acc[2][2][4][2];

struct OrderStatic {
    int nM, nN, nwg, G, c;
    __device__ __forceinline__ void init(int M, int N, int G_, int c_) { nM = M / BM; nN = N / BM; nwg = nM * nN; G = G_; c = c_; }
    __device__ __forceinline__ bool next(int i, Unit& u) const {
        const long L = (long)i * G + c; if (L >= nwg) return false;
        int wgid = (int)L; { const int q = nwg / NXCD, r = nwg % NXCD, xcd = wgid % NXCD, off = wgid / NXCD; wgid = (xcd < r ? xcd * (q + 1) : r * (q + 1) + (xcd - r) * q) + off; }
        const int nig = WGM * nN, gid = wgid / nig, fm = gid * WGM, gsz = (nM - fm) < WGM ? (nM - fm) : WGM;
        u.pm = fm + ((wgid % nig) % gsz); u.pn = (wgid % nig) / gsz; u.e = 0; u.aux = 0; return true;
    }
};

template <class S_t>
__device__ __forceinline__ void gemm_phase(LAS unsigned char* lds, const S_t& S) {
    const int tid = ltid(), wid = __builtin_amdgcn_readfirstlane(tid >> 6), lane = tid & 63, wr = wid >> 2, wc = wid & 3, fr = lane & 15, fq = lane >> 4;
    const int nt = S.K / BK;
    int Rr[2], Cc[2]; unsigned voffB[2]; unsigned offC[2][2], offN[2][2];
#pragma unroll
    for (int i = 0; i < 2; ++i) { stage_rc(tid * 16 + i * 8192, Rr[i], Cc[i]); const int Rb = S_t::PERM ? ((Rr[i] & ~31) + perm32(Rr[i] & 31)) : Rr[i];
        voffB[i] = (unsigned)(Rb * S.ldb + Cc[i] * 2);
        offC[0][i] = (unsigned)(Rr[i] * S.lda + Cc[i] * 2); offC[1][i] = (unsigned)((Rr[i] + HALF) * S.lda + Cc[i] * 2);
        }
    const size_t kstep = (size_t)(BK * 2);
    const size_t hstepB = (size_t)HALF * S.ldb;
    const unsigned ldsw = (unsigned)wid * 1024u;
    const int aoff = lds_byte(wr * 64 + fr, fq * 8), boff = lds_byte(wc * 32 + fr, fq * 8);
#define G_SA(b, h) (((b) * 2 + (h)) * HTB)
#define G_SB(b, h) ((4 + (b) * 2 + (h)) * HTB)
#define G_STAGE_A(bufoff, kptr, OFF, h) do { _Pragma("unroll") for (int _i = 0; _i < 2; ++_i) \
        __builtin_amdgcn_global_load_lds((const unsigned*)((const char*)(kptr) + (OFF)[h][_i]), (LAS unsigned*)(lds + (bufoff) + ldsw + _i * 8192), 16, 0, 0); } while (0)
#define G_STAGE_B(bufoff, gbase) do { _Pragma("unroll") for (int _i = 0; _i < 2; ++_i) \
        __builtin_amdgcn_global_load_lds((const unsigned*)((const char*)(gbase) + voffB[_i]), (LAS unsigned*)(lds + (bufoff) + ldsw + _i * 8192), 16, 0, 0); } while (0)
#define G_LDA(dst, b, h) do { _Pragma("unroll") for (int m = 0; m < 4; ++m) _Pragma("unroll") for (int k = 0; k < 2; ++k) dst[m][k] = *(const LAS bf16x8*)(lds + G_SA(b, h) + aoff + m * 2048 + k * 1024); } while (0)
#define G_LDB(dst, b, h) do { _Pragma("unroll") for (int n = 0; n < 2; ++n) _Pragma("unroll") for (int k = 0; k < 2; ++k) dst[n][k] = *(const LAS bf16x8*)(lds + G_SB(b, h) + boff + n * 2048 + k * 1024); } while (0)
#define G_MMA(ai, bj, At, Bt) do { __builtin_amdgcn_s_setprio(1); _Pragma("unroll") for (int m = 0; m < 4; ++m) _Pragma("unroll") for (int n = 0; n < 2; ++n) _Pragma("unroll") for (int k = 0; k < 2; ++k) \
        acc[ai][bj][m][n] = __builtin_amdgcn_mfma_f32_16x16x32_bf16(Bt[n][k], At[m][k], acc[ai][bj][m][n], 0, 0, 0); __builtin_amdgcn_s_setprio(0); } while (0)
#define G_WAIT_V(n) asm volatile("s_waitcnt vmcnt(" #n ")" ::: "memory")
#define G_WAIT_L(n) asm volatile("s_waitcnt lgkmcnt(" #n ")" ::: "memory")
#define G_BAR __builtin_amdgcn_s_barrier()
#define G_SCHED __builtin_amdgcn_sched_barrier(0)
    Unit cur, nxt; int ui = 0;
    if (!S.next(0, cur)) return;
    if (S_t::GATHER) S.gather_offs(cur, tid, offC);
    Acc acc;
#pragma unroll
    for (int a = 0; a < 2; ++a)
#pragma unroll
        for (int b = 0; b < 2; ++b)
#pragma unroll
            for (int m = 0; m < 4; ++m)
#pragma unroll
                for (int n = 0; n < 2; ++n) acc[a][b][m][n] = (f32x4){0.f, 0.f, 0.f, 0.f};
    bf16x8 At[4][2], B0[2][2], B1[2][2];
    const char* cA = S.a_ptr(cur); const char* cB = S.b_ptr(cur);
    G_STAGE_B(G_SB(0, 0), cB); G_STAGE_A(G_SA(0, 0), cA, offC, 0); G_STAGE_B(G_SB(0, 1), cB + hstepB); G_STAGE_A(G_SA(0, 1), cA, offC, 1);
    if (wr == 1) G_BAR;
    G_WAIT_V(4); G_BAR;
    G_STAGE_B(G_SB(1, 0), cB + kstep); G_STAGE_A(G_SA(1, 0), cA + kstep, offC, 0); G_STAGE_B(G_SB(1, 1), cB + hstepB + kstep);
    G_WAIT_V(6); G_BAR;
    for (;;) {
        const bool has_next = S.next(ui + 1, nxt);
        const char* nA = has_next ? S.a_ptr(nxt) : cA; const char* nB = has_next ? S.b_ptr(nxt) : cB;
        if (S_t::GATHER) { if (has_next) S.gather_offs(nxt, tid, offN); else { offN[0][0] = offC[0][0]; offN[0][1] = offC[0][1]; offN[1][0] = offC[1][0]; offN[1][1] = offC[1][1]; } }
        for (int t = 0; t < nt; t += 2) {
            const bool last = (t == nt - 2);
            const char* a1 = cA + (size_t)(t + 1) * kstep;
            const char* a2 = last ? nA : cA + (size_t)(t + 2) * kstep; const char* b2 = last ? nB : cB + (size_t)(t + 2) * kstep;
            const char* a3 = a2 + kstep; const char* b3 = b2 + kstep;
            G_LDB(B0, 0, 0); G_SCHED; G_LDA(At, 0, 0); G_STAGE_A(G_SA(1, 1), a1, offC, 1);
            if (S_t::GATHER) { if (last) { offC[0][0] = offN[0][0]; offC[0][1] = offN[0][1]; offC[1][0] = offN[1][0]; offC[1][1] = offN[1][1]; } }
            G_WAIT_L(8); G_BAR; G_WAIT_L(0); G_MMA(0, 0, At, B0); G_BAR; G_SCHED;
            G_LDB(B1, 0, 1); G_STAGE_B(G_SB(0, 0), b2);
            G_BAR; G_WAIT_L(0); G_MMA(0, 1, At, B1); G_BAR;
            G_LDA(At, 0, 1); G_STAGE_A(G_SA(0, 0), a2, offC, 0);
            G_BAR; G_WAIT_L(0); G_MMA(1, 0, At, B0); G_BAR; G_SCHED;
            G_STAGE_B(G_SB(0, 1), b2 + hstepB);
            G_WAIT_V(6); G_BAR; G_MMA(1, 1, At, B1); G_BAR;
            G_LDB(B0, 1, 0); G_SCHED; G_LDA(At, 1, 0); G_STAGE_A(G_SA(0, 1), a2, offC, 1);
            G_WAIT_L(8); G_BAR; G_WAIT_L(0); G_MMA(0, 0, At, B0); G_BAR; G_SCHED;
            G_LDB(B1, 1, 1); G_STAGE_B(G_SB(1, 0), b3);
            G_BAR; G_WAIT_L(0); G_MMA(0, 1, At, B1); G_BAR;
            G_LDA(At, 1, 1); G_STAGE_A(G_SA(1, 0), a3, offC, 0);
            G_BAR; G_WAIT_L(0); G_MMA(1, 0, At, B0); G_BAR; G_SCHED;
            G_STAGE_B(G_SB(1, 1), b3 + hstepB);
            G_WAIT_V(6); G_BAR; G_MMA(1, 1, At, B1); G_BAR;
        }
        if constexpr (!S_t::AFTER) S.epi(acc, cur, wr, wc, fr, fq);
        if (!has_next) break;
#pragma unroll
        for (int a = 0; a < 2; ++a)
#pragma unroll
            for (int b = 0; b < 2; ++b)
#pragma unroll
                for (int m = 0; m < 4; ++m)
#pragma unroll
                    for (int n = 0; n < 2; ++n) acc[a][b][m][n] = (f32x4){0.f, 0.f, 0.f, 0.f};
        cur = nxt; cA = nA; cB = nB; ++ui;
    }
    G_WAIT_V(0);
    if (wr == 0) G_BAR;
    G_BAR;
    if constexpr (S_t::AFTER) S.epi_after(acc, cur, wr, wc, fr, fq, lds);
}

struct ProbBase : OrderStatic {
    static constexpr bool GATHER = false, AFTER = false;
    const char* A; const char* Bt; static constexpr int K = 1024, lda = 2048, ldb = 2048;
    __device__ __forceinline__ const char* a_ptr(const Unit& u) const { return A + (size_t)u.pm * BM * lda; }
    __device__ __forceinline__ const char* b_ptr(const Unit& u) const { return Bt + (size_t)u.pn * BM * ldb; }
    __device__ __forceinline__ void gather_offs(const Unit&, int, unsigned (&)[2][2]) const {}
};

struct ProbInProj : ProbBase {
    static constexpr bool PERM = true;
    bf16_t* out; const float* bias;
    __device__ __forceinline__ void epi(const Acc& acc, const Unit& u, int wr, int wc, int fr, int fq) const {
        const int row0 = u.pm * BM + wr * 64 + fr, colt = u.pn * BM + wc * 32 + 8 * fq;
        f32x4 bv[2][2];
#pragma unroll
        for (int bj = 0; bj < 2; ++bj) { const int c = colt + bj * HALF; int mc = c < COL_UV ? c : (c < COL_GL ? c + 16 : c - COL_GL + COL_UV);
            if (c < NIN) { bv[bj][0] = *(const f32x4*)(bias + mc); bv[bj][1] = *(const f32x4*)(bias + mc + 4); } else { bv[bj][0] = (f32x4){0.f, 0.f, 0.f, 0.f}; bv[bj][1] = bv[bj][0]; } }
#pragma unroll
        for (int ai = 0; ai < 2; ++ai)
#pragma unroll
            for (int m = 0; m < 4; ++m) { bf16_t* rowp = out + (size_t)(row0 + ai * HALF + m * 16) * NP + colt;
#pragma unroll
                for (int bj = 0; bj < 2; ++bj) { const f32x4 v0 = acc[ai][bj][m][0] + bv[bj][0], v1 = acc[ai][bj][m][1] + bv[bj][1];
                    *(u32x4*)(rowp + bj * HALF) = (u32x4){pk2(v0[0], v0[1]), pk2(v0[2], v0[3]), pk2(v1[0], v1[1]), pk2(v1[2], v1[3])}; } }
    }
};
struct ProbBf16 : ProbBase {
    static constexpr bool PERM = true;
    bf16_t* out; int ldc;
    __device__ __forceinline__ void epi(const Acc& acc, const Unit& u, int wr, int wc, int fr, int fq) const {
        const int row0 = u.pm * BM + wr * 64 + fr, colt = u.pn * BM + wc * 32 + 8 * fq;
#pragma unroll
        for (int ai = 0; ai < 2; ++ai)
#pragma unroll
            for (int m = 0; m < 4; ++m) { bf16_t* rowp = out + (size_t)(row0 + ai * HALF + m * 16) * ldc + colt;
#pragma unroll
                for (int bj = 0; bj < 2; ++bj) { const f32x4 v0 = acc[ai][bj][m][0], v1 = acc[ai][bj][m][1];
                    *(u32x4*)(rowp + bj * HALF) = (u32x4){pk2(v0[0], v0[1]), pk2(v0[2], v0[3]), pk2(v1[0], v1[1]), pk2(v1[2], v1[3])}; } }
    }
};
struct ProbQ : ProbBf16 {
    int G2, c2;
    __device__ __forceinline__ bool next(int i, Unit& u) const { const int L = i * G2 + c2; if (L >= 256) return false; const int bh = L >> 4, mt = L & 15; u.pm = (bh >> 2) * 16 + mt; u.pn = bh & 3; u.e = 0; u.aux = 0; return true; }
};
struct ProbRes : ProbBase {
    static constexpr bool PERM = false;
    float* out; const float* xres;
    __device__ __forceinline__ void epi(const Acc& acc, const Unit& u, int wr, int wc, int fr, int fq) const {
        const int row0 = u.pm * BM + wr * 64 + fr, col0 = u.pn * BM + wc * 32 + 4 * fq;
#pragma unroll
        for (int ai = 0; ai < 2; ++ai) {
            f32x4 xr[4][2][2];
#pragma unroll
            for (int m = 0; m < 4; ++m) { const size_t ro = (size_t)(row0 + ai * HALF + m * 16) * DM + col0;
#pragma unroll
                for (int bj = 0; bj < 2; ++bj)
#pragma unroll
                    for (int n = 0; n < 2; ++n) xr[m][bj][n] = *(const f32x4*)(xres + ro + bj * HALF + n * 16); }
#pragma unroll
            for (int m = 0; m < 4; ++m) { const size_t ro = (size_t)(row0 + ai * HALF + m * 16) * DM + col0;
#pragma unroll
                for (int bj = 0; bj < 2; ++bj)
#pragma unroll
                    for (int n = 0; n < 2; ++n) *(f32x4*)(out + ro + bj * HALF + n * 16) = xr[m][bj][n] * ALPHA + acc[ai][bj][m][n]; }
        }
    }
};
struct ProbMT {
    static constexpr bool PERM = true, GATHER = false, AFTER = false;
    static constexpr int K = 256, lda = 2048, ldb = 2048;
    const char* A; const char* Bt; int G, c; bf16_t* out;
    __device__ __forceinline__ bool next(int i, Unit& u) const { const int L = i * G + c; if (L >= 64) return false; u.e = L >> 2; u.pn = L & 3; u.pm = 0; u.aux = 0; return true; }
    __device__ __forceinline__ const char* a_ptr(const Unit& u) const { const int b = u.e >> 2, h = u.e & 3; return A + (size_t)(b * 256) * lda + h * 512; }
    __device__ __forceinline__ const char* b_ptr(const Unit& u) const { const int h = u.e & 3; return Bt + (size_t)u.pn * BM * ldb + h * 512; }
    __device__ __forceinline__ void gather_offs(const Unit&, int, unsigned (&)[2][2]) const {}
    __device__ __forceinline__ void epi(const Acc& acc, const Unit& u, int wr, int wc, int fr, int fq) const {
        const int row0 = wr * 64 + fr, colt = u.pn * BM + wc * 32 + 8 * fq;
#pragma unroll
        for (int ai = 0; ai < 2; ++ai)
#pragma unroll
            for (int m = 0; m < 4; ++m) { bf16_t* rowp = out + (size_t)u.e * 256 * 1024 + (size_t)(row0 + ai * HALF + m * 16) * 1024 + colt;
#pragma unroll
                for (int bj = 0; bj < 2; ++bj) { const f32x4 v0 = acc[ai][bj][m][0], v1 = acc[ai][bj][m][1];
                    *(u32x4*)(rowp + bj * HALF) = (u32x4){pk2(v0[0], v0[1]), pk2(v0[2], v0[3]), pk2(v1[0], v1[1]), pk2(v1[2], v1[3])}; } }
    }
};
struct ProbVW {
    static constexpr bool PERM = true, GATHER = false, AFTER = false;
    static constexpr int K = 256, lda = 2048, ldb = 2048;
    const char* A; const char* Bt; int G, c; bf16_t* out;
    __device__ __forceinline__ bool next(int i, Unit& u) const { const int L = i * G + c; if (L >= 64) return false; u.e = L >> 2; u.pm = L & 3; u.pn = 0; u.aux = 0; return true; }
    __device__ __forceinline__ const char* a_ptr(const Unit& u) const { const int h = u.e & 3; return A + (size_t)u.pm * BM * lda + h * 512; }
    __device__ __forceinline__ const char* b_ptr(const Unit& u) const { const int b = u.e >> 2, h = u.e & 3; return Bt + (size_t)(b * 256) * ldb + h * 512; }
    __device__ __forceinline__ void gather_offs(const Unit&, int, unsigned (&)[2][2]) const {}
    __device__ __forceinline__ void epi(const Acc& acc, const Unit& u, int wr, int wc, int fr, int fq) const {
        const int b = u.e >> 2, h = u.e & 3; const int row0 = u.pm * BM + wr * 64 + fr, colt = h * 256 + wc * 32 + 8 * fq;
#pragma unroll
        for (int ai = 0; ai < 2; ++ai)
#pragma unroll
            for (int m = 0; m < 4; ++m) { bf16_t* rowp = out + (size_t)b * 1024 * 1024 + (size_t)(row0 + ai * HALF + m * 16) * 1024 + colt;
#pragma unroll
                for (int bj = 0; bj < 2; ++bj) { const f32x4 v0 = acc[ai][bj][m][0], v1 = acc[ai][bj][m][1];
                    *(u32x4*)(rowp + bj * HALF) = (u32x4){pk2(v0[0], v0[1]), pk2(v0[2], v0[3]), pk2(v1[0], v1[1]), pk2(v1[2], v1[3])}; } }
    }
};
struct ProbResLN : ProbBase {
    static constexpr bool PERM = false, AFTER = true;
    const float* xres; const float* lng; const float* lnb; float* xf; bf16_t* xb; float* stats; unsigned* cntp; size_t bstride;
    __device__ __forceinline__ const char* b_ptr(const Unit& u) const { return Bt + (size_t)(u.pm >> 4) * bstride + (size_t)u.pn * BM * ldb; }
    __device__ __forceinline__ void epi(const Acc&, const Unit&, int, int, int, int) const {}
    __device__ __forceinline__ void epi_after(Acc& acc, const Unit& u, int wr, int wc, int fr, int fq, LAS unsigned char* lds) const {
        const int tid = ltid();
        const int col0 = u.pn * BM + wc * 32 + 4 * fq;
        LAS float* red = (LAS float*)lds;
        LAS float* tab = (LAS float*)(lds + 8192);
#pragma unroll
        for (int ai = 0; ai < 2; ++ai)
#pragma unroll
            for (int m = 0; m < 4; ++m) { const int rowl = ai * HALF + wr * 64 + m * 16 + fr; const size_t ro = (size_t)(u.pm * BM + rowl) * DM + col0;
                float sv = 0.f, sq = 0.f;
#pragma unroll
                for (int bj = 0; bj < 2; ++bj)
#pragma unroll
                    for (int n = 0; n < 2; ++n) { const f32x4 xr = *(const f32x4*)(xres + ro + bj * HALF + n * 16); const f32x4 y = xr * ALPHA + acc[ai][bj][m][n]; acc[ai][bj][m][n] = y;
                        sv += (y[0] + y[1]) + (y[2] + y[3]); sq += (y[0] * y[0] + y[1] * y[1]) + (y[2] * y[2] + y[3] * y[3]); }
                sv += __shfl_xor(sv, 16); sv += __shfl_xor(sv, 32); sq += __shfl_xor(sq, 16); sq += __shfl_xor(sq, 32);
                if (fq == 0) { red[(rowl * 4 + wc) * 2] = sv; red[(rowl * 4 + wc) * 2 + 1] = sq; } }
        __syncthreads();
        if (tid < 256) { float S = 0.f, SS = 0.f;
#pragma unroll
            for (int w = 0; w < 4; ++w) { S += red[(tid * 4 + w) * 2]; SS += red[(tid * 4 + w) * 2 + 1]; }
            float* st = stats + ((size_t)(u.pm * 4 + u.pn) * 256 + tid) * 2; st[0] = S; st[1] = SS; }
        asm volatile("s_waitcnt vmcnt(0)" ::: "memory");
        __syncthreads();
        if (tid == 0) { unsigned* cw = cntp + u.pm;
            __builtin_amdgcn_fence(__ATOMIC_RELEASE, "agent"); asm volatile("s_waitcnt vmcnt(0)" ::: "memory");
            __hip_atomic_fetch_add(cw, 1u, __ATOMIC_RELAXED, __HIP_MEMORY_SCOPE_AGENT);
            while (__hip_atomic_load(cw, __ATOMIC_RELAXED, __HIP_MEMORY_SCOPE_AGENT) < 4u) __builtin_amdgcn_s_sleep(1);
            __builtin_amdgcn_fence(__ATOMIC_ACQUIRE, "agent"); asm volatile("s_waitcnt vmcnt(0)" ::: "memory"); }
        __syncthreads();
        if (tid < 256) { float S = 0.f, SS = 0.f;
#pragma unroll
            for (int w = 0; w < 4; ++w) { const float* st = stats + ((size_t)(u.pm * 4 + w) * 256 + tid) * 2;
                S += __hip_atomic_load(st, __ATOMIC_RELAXED, __HIP_MEMORY_SCOPE_AGENT); SS += __hip_atomic_load(st + 1, __ATOMIC_RELAXED, __HIP_MEMORY_SCOPE_AGENT); }
            const float mean = S * (1.f / DM), var = fmaxf(SS * (1.f / DM) - mean * mean, 0.f);
            tab[tid * 2] = mean; tab[tid * 2 + 1] = rsqrtf(var + LN_EPS); }
        __syncthreads();
        f32x4 gv[2][2], bv[2][2];
#pragma unroll
        for (int bj = 0; bj < 2; ++bj)
#pragma unroll
            for (int n = 0; n < 2; ++n) { gv[bj][n] = *(const f32x4*)(lng + col0 + bj * HALF + n * 16); bv[bj][n] = *(const f32x4*)(lnb + col0 + bj * HALF + n * 16); }
#pragma unroll
        for (int ai = 0; ai < 2; ++ai)
#pragma unroll
            for (int m = 0; m < 4; ++m) { const int rowl = ai * HALF + wr * 64 + m * 16 + fr; const size_t ro = (size_t)(u.pm * BM + rowl) * DM + col0;
                const float mean = tab[rowl * 2], rstd = tab[rowl * 2 + 1];
#pragma unroll
                for (int bj = 0; bj < 2; ++bj)
#pragma unroll
                    for (int n = 0; n < 2; ++n) { const f32x4 v = (acc[ai][bj][m][n] - mean) * rstd * gv[bj][n] + bv[bj][n];
                        *(f32x4*)(xf + ro + bj * HALF + n * 16) = v; *(u32x2*)(xb + ro + bj * HALF + n * 16) = (u32x2){pk2(v[0], v[1]), pk2(v[2], v[3])}; } }
        __syncthreads();
    }
};
template <int KK> struct ProbMerge {
    static constexpr bool PERM = false, GATHER = false, AFTER = false;
    const char* A; const char* Bt; static constexpr int K = KK, lda = 2048, ldb = 2048; int G, c;
    const bf16_t* p; bf16_t* mb;
    __device__ __forceinline__ bool next(int i, Unit& u) const { const int tile = (KK == 512 ? i : (i >> 1)) * G + c; if (tile >= 256) return false; u.pm = tile >> 2; u.pn = tile & 3; u.e = KK == 512 ? 0 : 1 + (i & 1); u.aux = 0; return true; }
    __device__ __forceinline__ const char* a_ptr(const Unit& u) const { return A + (size_t)u.pm * BM * lda + (KK == 512 ? 0 : 1024 + (u.e - 1) * 512); }
    __device__ __forceinline__ const char* b_ptr(const Unit& u) const { return Bt + (size_t)u.pn * BM * ldb + (KK == 512 ? 0 : 1024 + (u.e - 1) * 512); }
    __device__ __forceinline__ void gather_offs(const Unit&, int, unsigned (&)[2][2]) const {}
    __device__ __forceinline__ void epi(const Acc& acc, const Unit& u, int wr, int wc, int fr, int fq) const {
        const int row0 = u.pm * BM + wr * 64 + fr, col0 = u.pn * BM + wc * 32 + 4 * fq;
        const int gi = u.e;
        const bf16_t* __restrict__ mbr = mb; bf16_t* __restrict__ mbw = mb; const bf16_t* __restrict__ pr = p;
        u32x2 gr[2][2][2]; u32x2 pv[2][2][2];
#define MRG_LOAD(q, buf) do { const int row_ = row0 + ((q) >> 2) * HALF + ((q) & 3) * 16; const size_t ro_ = (size_t)row_ * DM + col0; \
            const bf16_t* gp_ = pr + (size_t)row_ * NP + COL_GATE + gi * 1024 + col0; \
            _Pragma("unroll") for (int bj = 0; bj < 2; ++bj) _Pragma("unroll") for (int n = 0; n < 2; ++n) { gr[buf][bj][n] = *(const u32x2*)(gp_ + bj * HALF + n * 16); \
                pv[buf][bj][n] = (KK != 512) ? *(const u32x2*)(mbr + ro_ + bj * HALF + n * 16) : (u32x2){0u, 0u}; } } while (0)
        MRG_LOAD(0, 0);
#pragma unroll
        for (int q = 0; q < 8; ++q) { const int ai = q >> 2, m = q & 3, buf = q & 1;
            if (q + 1 < 8) MRG_LOAD(q + 1, buf ^ 1);
            const int row = row0 + ai * HALF + m * 16; const size_t ro = (size_t)row * DM + col0;
#pragma unroll
            for (int bj = 0; bj < 2; ++bj)
#pragma unroll
                for (int n = 0; n < 2; ++n) { const u32x2 g2 = gr[buf][bj][n], p2 = pv[buf][bj][n];
                    f32x4 g; g[0] = sigmoid_f(bflo(g2[0])); g[1] = sigmoid_f(bfhi(g2[0])); g[2] = sigmoid_f(bflo(g2[1])); g[3] = sigmoid_f(bfhi(g2[1]));
                    const f32x4 v = g * acc[ai][bj][m][n] + (f32x4){bflo(p2[0]), bfhi(p2[0]), bflo(p2[1]), bfhi(p2[1])};
                    *(u32x2*)(mbw + ro + bj * HALF + n * 16) = (u32x2){pk2(v[0], v[1]), pk2(v[2], v[3])}; } }
#undef MRG_LOAD
    }
};
struct MoeOrder {
    int G, c, nN; const LAS int* tstart; const int* cnt;
    __device__ __forceinline__ bool next(int i, Unit& u) const {
        const int L = i * G + c; const int total = tstart[32] * nN; if (L >= total) return false;
        const int mt = L / nN; u.pn = L % nN; int e = 0;
        for (int k = 1; k < 32; ++k) e += (tstart[k] <= mt) ? 1 : 0;
        u.e = e; u.pm = mt; u.aux = (mt - tstart[e]) * BM; return true;
    }
};
__device__ __forceinline__ float swiglu_f(float g, float l) { g = fminf(g, 7.f); l = fminf(fmaxf(l, -7.f), 7.f); return g * sigmoid_f(1.702f * g) * (l + 1.f); }
struct ProbMoe1 : MoeOrder {
    static constexpr bool PERM = false, GATHER = true, AFTER = false;
    const char* A; const char* Bt; static constexpr int K = 1024, lda = 2048, ldb = 2048; const int* elist; const float* bgu; bf16_t* abuf;
    __device__ __forceinline__ const char* a_ptr(const Unit&) const { return A; }
    __device__ __forceinline__ const char* b_ptr(const Unit& u) const { return Bt + (size_t)u.e * 2048 * ldb + (size_t)u.pn * BM * ldb; }
    __device__ __forceinline__ void gather_offs(const Unit& u, int tid, unsigned (&off)[2][2]) const {
        const int n = cnt[u.e];
#pragma unroll
        for (int i = 0; i < 2; ++i) { int R, C; stage_rc(tid * 16 + i * 8192, R, C);
#pragma unroll
            for (int h = 0; h < 2; ++h) { const int rr = u.aux + h * HALF + R; const int tok = rr < n ? (elist[u.e * ECAP + rr] >> 2) : 0; off[h][i] = (unsigned)(tok * lda + C * 2); } }
    }
    __device__ __forceinline__ void epi(const Acc& acc, const Unit& u, int wr, int wc, int fr, int fq) const {
        const int row0 = u.pm * BM + wr * 64 + fr;
        const float* bb = bgu + (size_t)u.e * 2048;
#pragma unroll
        for (int bj = 0; bj < 2; ++bj) { const int g = u.pn * 8 + bj * 4 + wc; const int ac = 16 * g + 4 * fq;
            const f32x4 bg = *(const f32x4*)(bb + ac), bl = *(const f32x4*)(bb + 1024 + ac);
#pragma unroll
            for (int ai = 0; ai < 2; ++ai)
#pragma unroll
                for (int m = 0; m < 4; ++m) { const f32x4 vg = acc[ai][bj][m][0] + bg, vl = acc[ai][bj][m][1] + bl;
                    *(u32x2*)(abuf + (size_t)(row0 + ai * HALF + m * 16) * 1024 + ac) =
                        (u32x2){pk2(swiglu_f(vg[0], vl[0]), swiglu_f(vg[1], vl[1])), pk2(swiglu_f(vg[2], vl[2]), swiglu_f(vg[3], vl[3]))}; } }
    }
};
struct ProbMoe2 : MoeOrder {
    static constexpr bool PERM = false, GATHER = false, AFTER = false;
    const char* A; const char* Bt; static constexpr int K = 1024, lda = 2048, ldb = 2048; const int* elist; const float* bd; const float* tgate; bf16_t* ys;
    __device__ __forceinline__ const char* a_ptr(const Unit& u) const { return A + (size_t)u.pm * BM * lda; }
    __device__ __forceinline__ const char* b_ptr(const Unit& u) const { return Bt + (size_t)u.e * 1024 * ldb + (size_t)u.pn * BM * ldb; }
    __device__ __forceinline__ void gather_offs(const Unit&, int, unsigned (&)[2][2]) const {}
    __device__ __forceinline__ void epi(const Acc& acc, const Unit& u, int wr, int wc, int fr, int fq) const {
        const int n = cnt[u.e]; const int col0 = u.pn * BM + wc * 32 + 4 * fq;
        const float* bb = bd + (size_t)u.e * 1024 + col0;
        f32x4 bv[2][2];
#pragma unroll
        for (int bj = 0; bj < 2; ++bj)
#pragma unroll
            for (int nn = 0; nn < 2; ++nn) bv[bj][nn] = *(const f32x4*)(bb + bj * HALF + nn * 16);
        int aidx[2][4]; float gts[2][4];
#pragma unroll
        for (int ai = 0; ai < 2; ++ai)
#pragma unroll
            for (int m = 0; m < 4; ++m) { const int rr = u.aux + ai * HALF + wr * 64 + m * 16 + fr; aidx[ai][m] = (rr < n) ? elist[u.e * ECAP + rr] : -1; }
#pragma unroll
        for (int ai = 0; ai < 2; ++ai)
#pragma unroll
            for (int m = 0; m < 4; ++m) gts[ai][m] = (aidx[ai][m] >= 0) ? tgate[aidx[ai][m]] : 0.f;
#pragma unroll
        for (int ai = 0; ai < 2; ++ai)
#pragma unroll
            for (int m = 0; m < 4; ++m) {
                if (aidx[ai][m] >= 0) { const float g = gts[ai][m]; bf16_t* rowp = ys + (size_t)aidx[ai][m] * 1024 + col0;
#pragma unroll
                    for (int bj = 0; bj < 2; ++bj)
#pragma unroll
                        for (int nn = 0; nn < 2; ++nn) { const f32x4 v = (acc[ai][bj][m][nn] + bv[bj][nn]) * g;
                            *(u32x2*)(rowp + bj * HALF + nn * 16) = (u32x2){pk2(v[0], v[1]), pk2(v[2], v[3])}; } } }
    }
};

template <int MODE, int KK = 256> struct ProbAttn {
    static constexpr bool PERM = (MODE == 1), GATHER = false, AFTER = (MODE == 0);
    static constexpr int K = KK, lda = 2048, ldb = 2048;
    const char* A; const char* Bt; int G, c; float* sout; bf16_t* oout;
    __device__ __forceinline__ bool next(int i, Unit& u) const { const int L = i * G + c; if (L >= 256) return false; u.e = L >> 4; u.pm = L & 15; u.pn = 0; u.aux = 0; return true; }
    __device__ __forceinline__ const char* a_ptr(const Unit& u) const { const int b = u.e >> 2, h = u.e & 3; return A + ((size_t)(b * SEQL + u.pm * BM) * DM + (KK == 1024 ? 0 : h * 256)) * 2; }
    __device__ __forceinline__ const char* b_ptr(const Unit& u) const { const int b = u.e >> 2, h = u.e & 3;
        if (KK == 1024) return Bt + (size_t)u.e * 256 * 2048;
        return MODE == 0 ? Bt + ((size_t)(b * 256) * DM + h * 256) * 2 : Bt + ((size_t)b * 1024 * 1024 + (size_t)h * 256 * 1024) * 2; }
    __device__ __forceinline__ void gather_offs(const Unit&, int, unsigned (&)[2][2]) const {}
    __device__ __forceinline__ void epi_after(Acc& acc, const Unit& u, int wr, int wc, int fr, int fq, LAS unsigned char* lds) const {
        const int b = u.e >> 2, h = u.e & 3; const int grow0 = b * SEQL + u.pm * BM;
        LAS float* redm = (LAS float*)lds; LAS float* reds = (LAS float*)(lds + 4096);
#pragma unroll
        for (int ai = 0; ai < 2; ++ai)
#pragma unroll
            for (int m = 0; m < 4; ++m) { float v = -3e38f;
#pragma unroll
                for (int bj = 0; bj < 2; ++bj)
#pragma unroll
                    for (int n = 0; n < 2; ++n) v = fmaxf(v, fmaxf(fmaxf(acc[ai][bj][m][n][0], acc[ai][bj][m][n][1]), fmaxf(acc[ai][bj][m][n][2], acc[ai][bj][m][n][3])));
                v = fmaxf(v, __shfl_xor(v, 16)); v = fmaxf(v, __shfl_xor(v, 32));
                if (fq == 0) redm[(ai * HALF + wr * 64 + m * 16 + fr) * 4 + wc] = v; }
        __syncthreads();
#pragma unroll
        for (int ai = 0; ai < 2; ++ai)
#pragma unroll
            for (int m = 0; m < 4; ++m) { const int row = ai * HALF + wr * 64 + m * 16 + fr; const f32x4 r = *(const LAS f32x4*)(redm + row * 4);
                const float M = fmaxf(fmaxf(r[0], r[1]), fmaxf(r[2], r[3])); float sm = 0.f;
#pragma unroll
                for (int bj = 0; bj < 2; ++bj)
#pragma unroll
                    for (int n = 0; n < 2; ++n)
#pragma unroll
                        for (int j = 0; j < 4; ++j) { const float e = __expf((acc[ai][bj][m][n][j] - M) * 0.0625f); acc[ai][bj][m][n][j] = e; sm += e; }
                sm += __shfl_xor(sm, 16); sm += __shfl_xor(sm, 32);
                if (fq == 0) reds[row * 4 + wc] = sm; }
        __syncthreads();
#pragma unroll
        for (int ai = 0; ai < 2; ++ai)
#pragma unroll
            for (int m = 0; m < 4; ++m) { const int row = ai * HALF + wr * 64 + m * 16 + fr; const f32x4 r = *(const LAS f32x4*)(reds + row * 4);
                const float inv = __builtin_amdgcn_rcpf((r[0] + r[1]) + (r[2] + r[3]));
                bf16_t* rowp = oout + (size_t)(grow0 + row) * DM + h * 256 + wc * 32 + 4 * fq;
#pragma unroll
                for (int bj = 0; bj < 2; ++bj)
#pragma unroll
                    for (int n = 0; n < 2; ++n) { const f32x4 v = acc[ai][bj][m][n] * inv; *(u32x2*)(rowp + bj * HALF + n * 16) = (u32x2){pk2(v[0], v[1]), pk2(v[2], v[3])}; } }
        __syncthreads();
    }
    __device__ __forceinline__ void epi(const Acc& acc, const Unit& u, int wr, int wc, int fr, int fq) const {
        const int b = u.e >> 2, h = u.e & 3; const int row0 = b * SEQL + u.pm * BM + wr * 64 + fr;
        if (MODE == 0) { const int col0 = h * 256 + wc * 32 + 4 * fq;
#pragma unroll
            for (int ai = 0; ai < 2; ++ai)
#pragma unroll
                for (int m = 0; m < 4; ++m) { float* rowp = sout + (size_t)(row0 + ai * HALF + m * 16) * DM + col0;
#pragma unroll
                    for (int bj = 0; bj < 2; ++bj)
#pragma unroll
                        for (int n = 0; n < 2; ++n) *(f32x4*)(rowp + bj * HALF + n * 16) = acc[ai][bj][m][n] * 0.0625f; }
        } else { const int colt = h * 256 + wc * 32 + 8 * fq;
#pragma unroll
            for (int ai = 0; ai < 2; ++ai)
#pragma unroll
                for (int m = 0; m < 4; ++m) { bf16_t* rowp = oout + (size_t)(row0 + ai * HALF + m * 16) * DM + colt;
#pragma unroll
                    for (int bj = 0; bj < 2; ++bj) { const f32x4 v0 = acc[ai][bj][m][0], v1 = acc[ai][bj][m][1];
                        *(u32x4*)(rowp + bj * HALF) = (u32x4){pk2(v0[0], v0[1]), pk2(v0[2], v0[3]), pk2(v1[0], v1[1]), pk2(v1[2], v1[3])}; } }
        }
    }
};
__device__ __forceinline__ void phase_softmax(const Params& P) {
    const int tid = ltid(); const int lane = tid & 63, wid = __builtin_amdgcn_readfirstlane(tid >> 6); const int gw = blockIdx.x * 8 + wid, NGW = gridDim.x * 8;
    const float* S = (const float*)(P.ws + WS_MRGF); bf16_t* Pb = (bf16_t*)(P.ws + WS_QB);
    for (int r = gw; r < NTOK * 4; r += NGW) { const size_t o = (size_t)r * 256 + lane * 4;
        const f32x4 v = *(const f32x4*)(S + o);
        const float mx = wave_max(fmaxf(fmaxf(v[0], v[1]), fmaxf(v[2], v[3])));
        const float e0 = __expf(v[0] - mx), e1 = __expf(v[1] - mx), e2 = __expf(v[2] - mx), e3 = __expf(v[3] - mx);
        const float inv = 1.f / wave_sum((e0 + e1) + (e2 + e3));
        *(u32x2*)(Pb + o) = (u32x2){pk2(e0 * inv, e1 * inv), pk2(e2 * inv, e3 * inv)}; }
}

__device__ __forceinline__ void tr_item(const float* __restrict__ src, int ldn, int scol, int k0, bf16_t* dst0, int ldk, LAS unsigned char* wl, int lane) {
    float v[64];
    const bool valid = scol >= 0;
    const float* s = src + (size_t)k0 * ldn + (valid ? scol : 0);
#pragma unroll
    for (int kk = 0; kk < 64; ++kk) v[kk] = s[(size_t)kk * ldn];
#pragma unroll
    for (int c = 0; c < 8; ++c) { u32x4 w;
#pragma unroll
        for (int q = 0; q < 4; ++q) w[q] = valid ? pk2(v[8 * c + 2 * q], v[8 * c + 2 * q + 1]) : 0u;
        *(LAS u32x4*)(wl + lane * 144 + c * 16) = w; }
    WBAR();
#pragma unroll
    for (int it = 0; it < 8; ++it) { const int row = it * 8 + (lane >> 3), c16 = lane & 7; const u32x4 w = *(const LAS u32x4*)(wl + row * 144 + c16 * 16);
        *(u32x4*)(dst0 + (size_t)row * ldk + c16 * 8) = w; }
    WBAR();
}
__device__ __forceinline__ void row_to_bf16(const float* src, bf16_t* dst, int lane) {
#pragma unroll
    for (int j = 0; j < 4; ++j) { const f32x4 v = *(const f32x4*)(src + j * 256 + lane * 4); *(u32x2*)(dst + j * 256 + lane * 4) = (u32x2){pk2(v[0], v[1]), pk2(v[2], v[3])}; }
}
__device__ __forceinline__ void phase_convert(const Params& P, LAS unsigned char* lds) {
    const int tid = ltid(); const int lane = tid & 63, wid = __builtin_amdgcn_readfirstlane(tid >> 6);
    const int gw = blockIdx.x * 8 + wid, NGW = gridDim.x * 8;
    LAS unsigned char* wl = lds + wid * 9216;
    unsigned char* ws = P.ws;
    constexpr int I_WIN = 16 * 88, I_SQ = 256, I_GU = 32 * 512, I_D = 32 * 256, I_L = I_WIN + 6 * I_SQ + I_GU + I_D;
    for (int it = gw; it < 2 * I_L; it += NGW) {
        const int l = it / I_L; int r = it % I_L;
        if (r < I_WIN) { const int ntl = r % 88, kt = r / 88; const int n = ntl * 64 + lane;
            const int sc = n < COL_UV ? n : (n < COL_GL ? n + 16 : (n < NIN ? n - COL_GL + COL_UV : -1));
            tr_item(P.in[2] + (size_t)l * 1024 * NIN, NIN, sc, kt * 64, (bf16_t*)(ws + WS_WIN + l * SZ_WIN) + (size_t)ntl * 64 * 1024 + kt * 64, 1024, wl, lane); continue; }
        r -= I_WIN;
        if (r < I_SQ) {
            const int ntl = r % 16, kt = r / 16; const float* src; int kk;
            if (kt < 8) { src = P.in[13] + (size_t)l * 512 * 1024; kk = kt; } else if (kt < 12) { src = P.in[14] + (size_t)l * 256 * 1024; kk = kt - 8; } else { src = P.in[15] + (size_t)l * 256 * 1024; kk = kt - 12; }
            tr_item(src, 1024, ntl * 64 + lane, kk * 64, (bf16_t*)(ws + WS_WUP + l * SZ_SQ) + (size_t)ntl * 64 * 1024 + kt * 64, 1024, wl, lane); continue; }
        r -= I_SQ;
        if (r < 5 * I_SQ) { const int w = r / I_SQ; const int rr = r % I_SQ; const int ntl = rr % 16, kt = rr / 16;
            const int ii = w == 0 ? 16 : 18 + w;
            const size_t wso = w == 0 ? WS_WO : (w == 1 ? WS_OB : (w == 2 ? WS_WK : (w == 3 ? WS_WV : WS_WXO)));
            tr_item(P.in[ii] + (size_t)l * 1024 * 1024, 1024, ntl * 64 + lane, kt * 64, (bf16_t*)(ws + wso + l * SZ_SQ) + (size_t)ntl * 64 * 1024 + kt * 64, 1024, wl, lane); continue; }
        r -= 5 * I_SQ;
        if (r < I_GU) { const int e = r / 512; const int rr = r % 512; const int ntl = rr % 32, kt = rr / 32; const int n = ntl * 64 + lane; const int g = n >> 5, w = n & 31;
            const int sc = w < 16 ? 16 * g + w : 1024 + 16 * g + (w - 16);
            tr_item(P.in[27] + ((size_t)l * 32 + e) * 1024 * 2048, 2048, sc, kt * 64, (bf16_t*)(ws + WS_WGU + l * SZ_WGU) + ((size_t)e * 2048 + ntl * 64) * 1024 + kt * 64, 1024, wl, lane); continue; }
        r -= I_GU;
        { const int e = r / 256; const int rr = r % 256; const int ntl = rr % 16, kt = rr / 16;
            tr_item(P.in[29] + ((size_t)l * 32 + e) * 1024 * 1024, 1024, ntl * 64 + lane, kt * 64, (bf16_t*)(ws + WS_WD + l * SZ_WD) + ((size_t)e * 1024 + ntl * 64) * 1024 + kt * 64, 1024, wl, lane); }
    }
    for (int m = gw; m < NTOK + 1024 + 2048; m += NGW) {
        if (m < NTOK) row_to_bf16(P.in[0] + (size_t)m * DM, (bf16_t*)(ws + WS_XB) + (size_t)m * DM, lane);
        else if (m >= NTOK + 1024) row_to_bf16(P.in[19] + (size_t)(m - NTOK - 1024) * DM, (bf16_t*)(ws + WS_WQ) + (size_t)(m - NTOK - 1024) * DM, lane);
        else row_to_bf16(P.in[1] + (size_t)(m - NTOK) * DM, (bf16_t*)(ws + WS_MEMB) + (size_t)(m - NTOK) * DM, lane);
    }
}

__device__ __forceinline__ bf16x8 ldfrag(const LAS bf16_t* base, int row, int stride, int k) { return *(const LAS bf16x8*)(base + row * stride + k); }

__device__ __forceinline__ void sgu_item(const Params& P, int l, int item, LAS unsigned char* lds) {
    const int tid = ltid(), lane = tid & 63, wid = tid >> 6, fr = lane & 15, fq = lane >> 4;
    const bf16_t* p = (const bf16_t*)(P.ws + WS_P); bf16_t* ycat = (bf16_t*)(P.ws + WS_YCAT);
    const int t0 = item * 128;
    LAS bf16_t* vnT = (LAS bf16_t*)lds;
    LAS bf16_t* wsb = (LAS bf16_t*)(lds + 69632);
    LAS float* red = (LAS float*)(lds + 69632 + 34816);
    {
        const int t = tid & 127, qd = tid >> 7;
        const bf16_t* src = p + (size_t)(t0 + t) * NP + COL_UV + 256 + qd * 64;
        float s = 0.f, ss = 0.f;
#pragma unroll
        for (int c = 0; c < 8; ++c) { const u32x4 w = *(const u32x4*)(src + c * 8);
#pragma unroll
            for (int q = 0; q < 4; ++q) { const float a = gelu_f(bflo(w[q])), b = gelu_f(bfhi(w[q])); s += a + b; ss += a * a + b * b; } }
        red[(t * 4 + qd) * 2] = s; red[(t * 4 + qd) * 2 + 1] = ss;
        __syncthreads();
        float S = 0.f, SS = 0.f;
#pragma unroll
        for (int q = 0; q < 4; ++q) { S += red[(t * 4 + q) * 2]; SS += red[(t * 4 + q) * 2 + 1]; }
        const float mean = S * (1.f / 256.f), var = fmaxf(SS * (1.f / 256.f) - mean * mean, 0.f), rstd = rsqrtf(var + LN_EPS);
        const float* lg = P.in[7] + l * 256 + qd * 64; const float* lb = P.in[8] + l * 256 + qd * 64;
#pragma unroll 2
        for (int c = 0; c < 8; ++c) { const u32x4 w = *(const u32x4*)(src + c * 8);
#pragma unroll
            for (int q = 0; q < 4; ++q) { const float a = gelu_f(bflo(w[q])), b = gelu_f(bfhi(w[q])); const int ch = c * 8 + 2 * q;
                vnT[(qd * 64 + ch) * 136 + t] = f2bf((a - mean) * rstd * lg[ch] + lb[ch]);
                vnT[(qd * 64 + ch + 1) * 136 + t] = f2bf((b - mean) * rstd * lg[ch + 1] + lb[ch + 1]); } }
    }
    for (int g = 0; g < 4; ++g) {
        __syncthreads();
        const float* wsg = P.in[9] + ((size_t)l * 4 + g) * 128 * 128;
#pragma unroll
        for (int i = 0; i < 4; ++i) { const int id = tid + i * 512; const int t = id >> 4, s8 = (id & 15) * 8;
            const f32x4 a = *(const f32x4*)(wsg + t * 128 + s8), b = *(const f32x4*)(wsg + t * 128 + s8 + 4);
            float w[8] = {a[0], a[1], a[2], a[3], b[0], b[1], b[2], b[3]};
#pragma unroll
            for (int q = 0; q < 8; ++q) w[q] = (s8 + q <= t) ? w[q] : 0.f;
            *(LAS u32x4*)(wsb + t * 136 + s8) = (u32x4){pk2(w[0], w[1]), pk2(w[2], w[3]), pk2(w[4], w[5]), pk2(w[6], w[7])}; }
        __syncthreads();
#pragma unroll
        for (int q = 0; q < 4; ++q) { const int tile = wid * 4 + q; const int ti = tile >> 2, di = tile & 3;
            f32x4 acc = {0.f, 0.f, 0.f, 0.f};
            const int ksmax = (ti * 16 + 15) >> 5;
            for (int ks = 0; ks <= ksmax; ++ks) {
                const bf16x8 a = ldfrag(wsb, ti * 16 + fr, 136, ks * 32 + 8 * fq), b = ldfrag(vnT, g * 64 + di * 16 + fr, 136, ks * 32 + 8 * fq);
                acc = __builtin_amdgcn_mfma_f32_16x16x32_bf16(a, b, acc, 0, 0, 0); }
            const int ch = g * 64 + di * 16 + fr;
#pragma unroll
            for (int j = 0; j < 4; ++j) { const int t = ti * 16 + 4 * fq + j;
                const float sv = acc[j] + P.in[10][((size_t)l * 4 + g) * 128 + t];
                const float u = gelu_f(bf2f(p[(size_t)(t0 + t) * NP + COL_UV + ch]));
                ycat[(size_t)(t0 + t) * DM + 512 + ch] = f2bf(u * sv); } }
    }
    __syncthreads();
}

__device__ __forceinline__ void gla1_item(const Params& P, int l, int idx, LAS unsigned char* lds) {
    const int tid = ltid();
    const bf16_t* p = (const bf16_t*)(P.ws + WS_P);
    float* bcum = (float*)(P.ws + WS_BCUM); float* kvT = (float*)(P.ws + WS_KVT); float* cdec = (float*)(P.ws + WS_CDEC);
    const int h = idx & 3, bn = idx >> 2; const int t0 = bn * 64;
    LAS float* gl = (LAS float*)lds;
    LAS float* tot = (LAS float*)(lds + 4096);
    LAS float* kt = (LAS float*)(lds + 8192);
    LAS float* vs = (LAS float*)(lds + 8192 + 16384);
#pragma unroll
    for (int i = 0; i < 2; ++i) { const int id = tid + i * 512; gl[id] = bf2f(p[(size_t)(t0 + (id >> 4)) * NP + COL_GL + (id & 15)]); }
#pragma unroll
    for (int i = 0; i < 2; ++i) { const int id = tid + i * 512; const int t = id >> 4, e8 = (id & 15) * 8;
        const u32x4 w = *(const u32x4*)(p + (size_t)(t0 + t) * NP + COL_V + h * 128 + e8);
        *(LAS f32x4*)(vs + t * 128 + e8) = (f32x4){bflo(w[0]), bfhi(w[0]), bflo(w[1]), bfhi(w[1])};
        *(LAS f32x4*)(vs + t * 128 + e8 + 4) = (f32x4){bflo(w[2]), bfhi(w[2]), bflo(w[3]), bfhi(w[3])}; }
    __syncthreads();
    {
        const int tq = tid >> 6, d = tid & 63;
        float wreg[16];
#pragma unroll
        for (int r = 0; r < 16; ++r) wreg[r] = P.in[4][((size_t)l * 16 + r) * 256 + h * 64 + d];
        const float bgv = P.in[5][l * 256 + h * 64 + d];
        float pre[8]; float run = 0.f;
#pragma unroll
        for (int i = 0; i < 8; ++i) { const int t = tq * 8 + i; float z = bgv;
#pragma unroll
            for (int r = 0; r < 16; ++r) z += gl[t * 16 + r] * wreg[r];
            const float ls = fminf(z, 0.f) - log1pf(__expf(-fabsf(z)));
            run += ls * (1.f / 16.f); pre[i] = run; }
        tot[tq * 64 + d] = run;
        __syncthreads();
        float off = 0.f, total = 0.f;
#pragma unroll
        for (int g = 0; g < 8; ++g) { const float x = tot[g * 64 + d]; total += x; off += (g < tq) ? x : 0.f; }
#pragma unroll
        for (int i = 0; i < 8; ++i) { const int t = tq * 8 + i; const float bv = off + pre[i];
            bcum[(size_t)(t0 + t) * 256 + h * 64 + d] = bv;
            kt[t * 64 + d] = bf2f(p[(size_t)(t0 + t) * NP + COL_K + h * 64 + d]) * __expf(total - bv); }
        if (tq == 0) cdec[idx * 64 + d] = __expf(total);
    }
    __syncthreads();
    {
        const int d4 = tid & 15, e4 = tid >> 4;
        f32x4 a0 = {0.f, 0.f, 0.f, 0.f}, a1 = a0, a2 = a0, a3 = a0;
        for (int t = 0; t < 64; ++t) { const f32x4 kv = *(const LAS f32x4*)(kt + t * 64 + 4 * d4), vv = *(const LAS f32x4*)(vs + t * 128 + 4 * e4);
            a0 += kv * vv[0]; a1 += kv * vv[1]; a2 += kv * vv[2]; a3 += kv * vv[3]; }
        float* o = kvT + (size_t)idx * 8192 + (4 * e4) * 64 + 4 * d4;
        *(f32x4*)(o) = a0; *(f32x4*)(o + 64) = a1; *(f32x4*)(o + 128) = a2; *(f32x4*)(o + 192) = a3;
    }
    __syncthreads();
}

__device__ __forceinline__ void pool_item(const Params& P, int l, int item, LAS unsigned char* lds) {
    const int tid = ltid(), lane = tid & 63, wid = tid >> 6, fr = lane & 15, fq = lane >> 4;
    const bf16_t* p = (const bf16_t*)(P.ws + WS_P); bf16_t* ycat = (bf16_t*)(P.ws + WS_YCAT);
    const int T0 = item * 64, pos0 = T0 & (SEQL - 1);
    LAS bf16_t* xs = (LAS bf16_t*)lds;
    LAS bf16_t* ybf = (LAS bf16_t*)(lds + 42240);
    LAS bf16_t* pwT = (LAS bf16_t*)(lds + 42240 + 33792);
#pragma unroll
    for (int i = 0; i < 5; ++i) { const int id = tid + i * 512; const int r = id >> 5, c8 = (id & 31) * 8;
        u32x4 w = {0u, 0u, 0u, 0u};
        if (pos0 - 16 + r >= 0) w = *(const u32x4*)(p + (size_t)(T0 - 16 + r) * NP + COL_XC + c8);
        *(LAS u32x4*)(xs + r * 264 + c8) = w; }
    const float* pw = P.in[11] + (size_t)l * 4 * 64 * 64;
#pragma unroll 4
    for (int i = 0; i < 32; ++i) { const int id = tid + i * 512; const int g = id >> 12, c = (id >> 6) & 63, dd = id & 63; pwT[(g * 64 + dd) * 72 + c] = f2bf(pw[id]); }
    __syncthreads();
    {
        const int ch = tid & 255, th = tid >> 8; const int gi = ch >> 6, w = 2 << gi;
        float sum = 0.f;
        for (int j = 1; j < w; ++j) sum += bf2f(xs[(16 + th * 32 - j) * 264 + ch]);
        for (int tt = 0; tt < 32; ++tt) { const int t = th * 32 + tt; const float x = bf2f(xs[(16 + t) * 264 + ch]);
            sum += x; const int pos = pos0 + t; const float cntf = (float)min(pos + 1, w);
            ybf[t * 264 + ch] = f2bf(sum / cntf - x);
            sum -= bf2f(xs[(16 + t - w + 1) * 264 + ch]); }
    }
    __syncthreads();
#pragma unroll
    for (int q = 0; q < 8; ++q) { const int tile = wid * 8 + q; const int g = tile >> 4, ti = (tile >> 2) & 3, di = tile & 3;
        f32x4 acc = {0.f, 0.f, 0.f, 0.f};
#pragma unroll
        for (int ks = 0; ks < 2; ++ks) { const bf16x8 a = ldfrag(ybf, ti * 16 + fr, 264, g * 64 + ks * 32 + 8 * fq), b = ldfrag(pwT, g * 64 + di * 16 + fr, 72, ks * 32 + 8 * fq);
            acc = __builtin_amdgcn_mfma_f32_16x16x32_bf16(a, b, acc, 0, 0, 0); }
        const int ch = g * 64 + di * 16 + fr; const float sc = P.in[12][l * 256 + ch];
#pragma unroll
        for (int j = 0; j < 4; ++j) ycat[(size_t)(T0 + ti * 16 + 4 * fq + j) * DM + 768 + ch] = f2bf(acc[j] * sc); }
    __syncthreads();
}

__device__ __forceinline__ void phase_mixer_local(const Params& P, int l, LAS unsigned char* lds) {
    constexpr int N_SGU = 128, N_GLA = 1024, N_POOL = 256;
    if (gridDim.x == 256) {
        const int b = blockIdx.x; int first, cntn;
        if (b < N_SGU) { sgu_item(P, l, b, lds); first = b * 3; cntn = 3; } else { first = 384 + (b - N_SGU) * 7; cntn = 7; }
        for (int k = 0; k < cntn; ++k) { const int it = first + k; if (it < N_GLA) gla1_item(P, l, it, lds); else pool_item(P, l, it - N_GLA, lds); }
        return;
    }
    for (int it = blockIdx.x; it < N_SGU + N_GLA + N_POOL; it += gridDim.x) {
        if (it < N_SGU) sgu_item(P, l, it, lds);
        else if (it < N_SGU + N_GLA) gla1_item(P, l, it - N_SGU, lds);
        else pool_item(P, l, it - N_SGU - N_GLA, lds);
    }
}

__device__ __forceinline__ void phase_scan(const Params& P) {
    const float* kvT = (const float*)(P.ws + WS_KVT); const float* cdec = (const float*)(P.ws + WS_CDEC); bf16_t* sT = (bf16_t*)(P.ws + WS_ST);
    for (int g = blockIdx.x * 512 + ltid(); g < 16 * 8192; g += gridDim.x * 512) {
        const int bh = g >> 13, ed = g & 8191, d = ed & 63, b = bh >> 2, h = bh & 3;
        float S = 0.f;
#pragma unroll 8
        for (int n = 0; n < 64; ++n) { const int ci = (b * 64 + n) * 4 + h;
            sT[(size_t)ci * 8192 + ed] = f2bf(S);
            S = cdec[ci * 64 + d] * S + kvT[(size_t)ci * 8192 + ed]; }
    }
}

struct G2R { u32x4 qw, kw, vw0, vw1, sw0, sw1, r0, r1; f32x4 b0, b1; };
__device__ __forceinline__ void gla2_load(const Params& P, int idx, int tid, G2R& r) {
    const bf16_t* p = (const bf16_t*)(P.ws + WS_P); const float* bcum = (const float*)(P.ws + WS_BCUM); const bf16_t* sT = (const bf16_t*)(P.ws + WS_ST);
    const int h = idx & 3, bn = idx >> 2; const int t0 = bn * 64;
    const int t = tid >> 3, c8 = (tid & 7) * 8;
    r.qw = *(const u32x4*)(p + (size_t)(t0 + t) * NP + h * 64 + c8); r.kw = *(const u32x4*)(p + (size_t)(t0 + t) * NP + COL_K + h * 64 + c8);
    r.b0 = *(const f32x4*)(bcum + (size_t)(t0 + t) * 256 + h * 64 + c8); r.b1 = *(const f32x4*)(bcum + (size_t)(t0 + t) * 256 + h * 64 + c8 + 4);
    { const int id = tid; const int tt = id >> 4, e8 = (id & 15) * 8; r.vw0 = *(const u32x4*)(p + (size_t)(t0 + tt) * NP + COL_V + h * 128 + e8); }
    { const int id = tid + 512; const int tt = id >> 4, e8 = (id & 15) * 8; r.vw1 = *(const u32x4*)(p + (size_t)(t0 + tt) * NP + COL_V + h * 128 + e8); }
    { const int id = tid; const int e = id >> 3, d8 = (id & 7) * 8; r.sw0 = *(const u32x4*)(sT + (size_t)idx * 8192 + e * 64 + d8); }
    { const int id = tid + 512; const int e = id >> 3, d8 = (id & 7) * 8; r.sw1 = *(const u32x4*)(sT + (size_t)idx * 8192 + e * 64 + d8); }
    { const int seg = tid & 7; const bf16_t* rp = p + (size_t)(t0 + t) * NP + COL_R + h * 128 + seg * 16; r.r0 = *(const u32x4*)rp; r.r1 = *(const u32x4*)(rp + 8); }
}
__device__ __forceinline__ void gla2_item(const Params& P, int l, int idx, int nidx, const G2R& R, G2R& RN, LAS unsigned char* lds) {
    const int tid = ltid(), lane = tid & 63, wid = tid >> 6, fr = lane & 15, fq = lane >> 4;
    bf16_t* ycat = (bf16_t*)(P.ws + WS_YCAT);
    const int h = idx & 3, bn = idx >> 2; const int t0 = bn * 64;
    LAS bf16_t* qd = (LAS bf16_t*)lds;
    LAS bf16_t* kd = (LAS bf16_t*)(lds + 9216);
    LAS bf16_t* vT = (LAS bf16_t*)(lds + 18432);
    LAS bf16_t* Ps = (LAS bf16_t*)(lds + 36864);
    LAS bf16_t* sTs = (LAS bf16_t*)(lds + 46080);
    LAS float* of = (LAS float*)(lds + 64512);
    {
        const int t = tid >> 3, c8 = (tid & 7) * 8;
        const u32x4 qw = R.qw, kw = R.kw; const f32x4 b0 = R.b0, b1 = R.b1;
        float bb[8] = {b0[0], b0[1], b0[2], b0[3], b1[0], b1[1], b1[2], b1[3]}; float qv[8], kv[8];
#pragma unroll
        for (int q = 0; q < 4; ++q) { qv[2 * q] = bflo(qw[q]); qv[2 * q + 1] = bfhi(qw[q]); kv[2 * q] = bflo(kw[q]); kv[2 * q + 1] = bfhi(kw[q]); }
#pragma unroll
        for (int q = 0; q < 8; ++q) { const float e = __expf(bb[q]); qv[q] = qv[q] * 0.125f * e; kv[q] = kv[q] * __expf(-bb[q]); }
        *(LAS u32x4*)(qd + t * 72 + c8) = (u32x4){pk2(qv[0], qv[1]), pk2(qv[2], qv[3]), pk2(qv[4], qv[5]), pk2(qv[6], qv[7])};
        *(LAS u32x4*)(kd + t * 72 + c8) = (u32x4){pk2(kv[0], kv[1]), pk2(kv[2], kv[3]), pk2(kv[4], kv[5]), pk2(kv[6], kv[7])};
#pragma unroll
        for (int i = 0; i < 2; ++i) { const int id = tid + i * 512; const int tt = id >> 4, e8 = (id & 15) * 8;
            const u32x4 w = i == 0 ? R.vw0 : R.vw1;
#pragma unroll
            for (int q = 0; q < 4; ++q) { vT[(e8 + 2 * q) * 72 + tt] = (bf16_t)(w[q] & 0xffffu); vT[(e8 + 2 * q + 1) * 72 + tt] = (bf16_t)(w[q] >> 16); } }
#pragma unroll
        for (int i = 0; i < 2; ++i) { const int id = tid + i * 512; const int e = id >> 3, d8 = (id & 7) * 8;
            *(LAS u32x4*)(sTs + e * 72 + d8) = i == 0 ? R.sw0 : R.sw1; }
    }
    __syncthreads();
    if (nidx >= 0) gla2_load(P, nidx, tid, RN);
#pragma unroll
    for (int q = 0; q < 2; ++q) { const int tile = wid * 2 + q; const int ti = tile >> 2, si = tile & 3;
        f32x4 acc = {0.f, 0.f, 0.f, 0.f};
        if (si <= ti) {
#pragma unroll
            for (int ks = 0; ks < 2; ++ks) { const bf16x8 a = ldfrag(qd, ti * 16 + fr, 72, ks * 32 + 8 * fq), b = ldfrag(kd, si * 16 + fr, 72, ks * 32 + 8 * fq);
                acc = __builtin_amdgcn_mfma_f32_16x16x32_bf16(a, b, acc, 0, 0, 0); } }
        const int s = si * 16 + fr;
#pragma unroll
        for (int j = 0; j < 4; ++j) { const int t = ti * 16 + 4 * fq + j; Ps[t * 72 + s] = f2bf(s <= t ? acc[j] : 0.f); } }
    __syncthreads();
#pragma unroll
    for (int q = 0; q < 4; ++q) { const int tile = wid * 4 + q; const int ti = tile >> 3, ei = tile & 7;
        f32x4 acc = {0.f, 0.f, 0.f, 0.f};
#pragma unroll
        for (int ks = 0; ks < 2; ++ks) { const bf16x8 a = ldfrag(Ps, ti * 16 + fr, 72, ks * 32 + 8 * fq), b = ldfrag(vT, ei * 16 + fr, 72, ks * 32 + 8 * fq);
            acc = __builtin_amdgcn_mfma_f32_16x16x32_bf16(a, b, acc, 0, 0, 0); }
#pragma unroll
        for (int ks = 0; ks < 2; ++ks) { const bf16x8 a = ldfrag(qd, ti * 16 + fr, 72, ks * 32 + 8 * fq), b = ldfrag(sTs, ei * 16 + fr, 72, ks * 32 + 8 * fq);
            acc = __builtin_amdgcn_mfma_f32_16x16x32_bf16(a, b, acc, 0, 0, 0); }
#pragma unroll
        for (int j = 0; j < 4; ++j) of[(ti * 16 + 4 * fq + j) * 132 + ei * 16 + fr] = acc[j]; }
    __syncthreads();
    {
        const int t = tid >> 3, seg = tid & 7;
        float o[16]; float ss = 0.f;
#pragma unroll
        for (int q = 0; q < 4; ++q) { const f32x4 v = *(const LAS f32x4*)(of + t * 132 + seg * 16 + 4 * q); o[4 * q] = v[0]; o[4 * q + 1] = v[1]; o[4 * q + 2] = v[2]; o[4 * q + 3] = v[3]; ss += v[0] * v[0] + v[1] * v[1] + v[2] * v[2] + v[3] * v[3]; }
        ss += __shfl_xor(ss, 1); ss += __shfl_xor(ss, 2); ss += __shfl_xor(ss, 4);
        const float rstd = rsqrtf(ss * (1.f / 128.f) + LN_EPS);
        const float* gn = P.in[6] + l * 512 + h * 128 + seg * 16;
        const u32x4 r0 = R.r0, r1 = R.r1;
        float rv[16];
#pragma unroll
        for (int q = 0; q < 4; ++q) { rv[2 * q] = bflo(r0[q]); rv[2 * q + 1] = bfhi(r0[q]); rv[8 + 2 * q] = bflo(r1[q]); rv[8 + 2 * q + 1] = bfhi(r1[q]); }
        float y[16];
#pragma unroll
        for (int q = 0; q < 16; ++q) y[q] = o[q] * rstd * gn[q] * (rv[q] * sigmoid_f(rv[q]));
        bf16_t* yo = ycat + (size_t)(t0 + t) * DM + h * 128 + seg * 16;
        *(u32x4*)yo = (u32x4){pk2(y[0], y[1]), pk2(y[2], y[3]), pk2(y[4], y[5]), pk2(y[6], y[7])};
        *(u32x4*)(yo + 8) = (u32x4){pk2(y[8], y[9]), pk2(y[10], y[11]), pk2(y[12], y[13]), pk2(y[14], y[15])};
    }
    __syncthreads();
}

__device__ __forceinline__ void attn_item(const Params& P, int l, int item, LAS unsigned char* lds) {
    const int tid = ltid(), lane = tid & 63, wid = tid >> 6, fr = lane & 15, fq = lane >> 4;
    const int qt = item & 31, h = (item >> 5) & 3, b = item >> 7;
    const bf16_t* qb = (const bf16_t*)(P.ws + WS_QB) + (size_t)(b * SEQL + qt * 128) * DM + h * 256;
    const bf16_t* km = (const bf16_t*)(P.ws + WS_KM + l * SZ_SQ) + (size_t)(b * 256) * DM + h * 256;
    const bf16_t* vt = (const bf16_t*)(P.ws + WS_VT + l * SZ_SQ) + ((size_t)b * 1024 + h * 256) * 256;
    bf16_t* ob = (bf16_t*)(P.ws + WS_OB) + (size_t)(b * SEQL + qt * 128) * DM + h * 256;
    LAS bf16_t* QP = (LAS bf16_t*)lds;
    LAS bf16_t* KV = (LAS bf16_t*)(lds + 67584);
#pragma unroll
    for (int i = 0; i < 8; ++i) { const int id = tid + i * 512; const int r = id >> 5, c8 = (id & 31) * 8; *(LAS u32x4*)(QP + r * 264 + c8) = *(const u32x4*)(qb + (size_t)r * DM + c8); }
    u32x4 pre[4];
#pragma unroll
    for (int i = 0; i < 4; ++i) { const int id = tid + i * 512; const int r = id >> 5, c8 = (id & 31) * 8; pre[i] = *(const u32x4*)(km + (size_t)r * DM + c8); }
#pragma unroll
    for (int i = 0; i < 4; ++i) { const int id = tid + i * 512; const int r = id >> 5, c8 = (id & 31) * 8; *(LAS u32x4*)(KV + r * 264 + c8) = pre[i]; }
    __syncthreads();
#ifdef ATT_DBG0
    {
#if ATT_DBG0 == 1
#pragma unroll
    for (int i = 0; i < 8; ++i) { const int id = tid + i * 512; const int r = id >> 5, c8 = (id & 31) * 8; *(u32x4*)(ob + (size_t)r * DM + c8) = *(const LAS u32x4*)(QP + r * 264 + c8); }
#else
#pragma unroll
    for (int i = 0; i < 4; ++i) { const int id = tid + i * 512; const int r = id >> 5, c8 = (id & 31) * 8; *(u32x4*)(ob + (size_t)r * DM + c8) = *(const LAS u32x4*)(KV + r * 264 + c8); *(u32x4*)(ob + (size_t)(r + 64) * DM + c8) = *(const LAS u32x4*)(KV + r * 264 + c8); }
#endif
    __syncthreads(); return; }
#endif
    bf16x8 aq[8];
#pragma unroll
    for (int ks = 0; ks < 8; ++ks) aq[ks] = ldfrag(QP, wid * 16 + fr, 264, ks * 32 + 8 * fq);
    f32x4 acc[16];
#pragma unroll
    for (int i = 0; i < 16; ++i) acc[i] = (f32x4){0.f, 0.f, 0.f, 0.f};
#pragma unroll
    for (int c = 0; c < 4; ++c) {
#pragma unroll
        for (int kt = 0; kt < 4; ++kt)
#pragma unroll
            for (int ks = 0; ks < 8; ++ks) acc[c * 4 + kt] = __builtin_amdgcn_mfma_f32_16x16x32_bf16(aq[ks], ldfrag(KV, kt * 16 + fr, 264, ks * 32 + 8 * fq), acc[c * 4 + kt], 0, 0, 0);
        __syncthreads();
#pragma unroll
        for (int i = 0; i < 4; ++i) { const int id = tid + i * 512; const int r = id >> 5, c8 = (id & 31) * 8;
            *(LAS u32x4*)(KV + r * 264 + c8) = (c < 3) ? *(const u32x4*)(km + (size_t)((c + 1) * 64 + r) * DM + c8) : *(const u32x4*)(vt + (size_t)r * 256 + c8); }
        __syncthreads();
    }
#ifdef ATT_DBG1
    {
#pragma unroll
    for (int i = 0; i < 16; ++i)
#pragma unroll
        for (int j = 0; j < 4; ++j) ob[(size_t)(wid * 16 + 4 * fq + j) * DM + i * 16 + fr] = f2bf(acc[i][j]);
    return; }
#endif
#pragma unroll
    for (int j = 0; j < 4; ++j) {
        float mx = -1e30f;
#pragma unroll
        for (int i = 0; i < 16; ++i) mx = fmaxf(mx, acc[i][j]);
        mx = fmaxf(mx, __shfl_xor(mx, 1)); mx = fmaxf(mx, __shfl_xor(mx, 2)); mx = fmaxf(mx, __shfl_xor(mx, 4)); mx = fmaxf(mx, __shfl_xor(mx, 8));
        float sm = 0.f;
#pragma unroll
        for (int i = 0; i < 16; ++i) { const float e = __expf((acc[i][j] - mx) * 0.0625f); acc[i][j] = e; sm += e; }
        sm += __shfl_xor(sm, 1); sm += __shfl_xor(sm, 2); sm += __shfl_xor(sm, 4); sm += __shfl_xor(sm, 8);
        const float inv = 1.f / sm;
#pragma unroll
        for (int i = 0; i < 16; ++i) QP[(wid * 16 + 4 * fq + j) * 264 + i * 16 + fr] = f2bf(acc[i][j] * inv);
    }
    WBAR();
#pragma unroll
    for (int ks = 0; ks < 8; ++ks) aq[ks] = ldfrag(QP, wid * 16 + fr, 264, ks * 32 + 8 * fq);
#pragma unroll
    for (int i = 0; i < 16; ++i) acc[i] = (f32x4){0.f, 0.f, 0.f, 0.f};
#pragma unroll
    for (int c = 0; c < 4; ++c) {
#pragma unroll
        for (int dt = 0; dt < 4; ++dt)
#pragma unroll
            for (int ks = 0; ks < 8; ++ks) acc[c * 4 + dt] = __builtin_amdgcn_mfma_f32_16x16x32_bf16(aq[ks], ldfrag(KV, dt * 16 + fr, 264, ks * 32 + 8 * fq), acc[c * 4 + dt], 0, 0, 0);
        __syncthreads();
        if (c < 3) {
#pragma unroll
            for (int i = 0; i < 4; ++i) { const int id = tid + i * 512; const int r = id >> 5, c8 = (id & 31) * 8; *(LAS u32x4*)(KV + r * 264 + c8) = *(const u32x4*)(vt + (size_t)((c + 1) * 64 + r) * 256 + c8); } }
        __syncthreads();
    }
#pragma unroll
    for (int i = 0; i < 16; ++i)
#pragma unroll
        for (int j = 0; j < 4; ++j) ob[(size_t)(wid * 16 + 4 * fq + j) * DM + i * 16 + fr] = f2bf(acc[i][j]);
}

__device__ __forceinline__ void ln_core(f32x4 (&v)[4], const float* g, const float* b, int lane) {
    float s = 0.f;
#pragma unroll
    for (int j = 0; j < 4; ++j) s += (v[j][0] + v[j][1]) + (v[j][2] + v[j][3]);
    const float mean = wave_sum(s) * (1.f / DM);
    float s2 = 0.f;
#pragma unroll
    for (int j = 0; j < 4; ++j) { v[j] = v[j] - mean; s2 += (v[j][0] * v[j][0] + v[j][1] * v[j][1]) + (v[j][2] * v[j][2] + v[j][3] * v[j][3]); }
    const float rstd = rsqrtf(wave_sum(s2) * (1.f / DM) + LN_EPS);
#pragma unroll
    for (int j = 0; j < 4; ++j) { const f32x4 gg = *(const f32x4*)(g + j * 256 + lane * 4), bb = *(const f32x4*)(b + j * 256 + lane * 4); v[j] = v[j] * rstd * gg + bb; }
}
__device__ __forceinline__ void ln_store(const f32x4 (&v)[4], float* of, bf16_t* obf, int lane) {
#pragma unroll
    for (int j = 0; j < 4; ++j) { *(f32x4*)(of + j * 256 + lane * 4) = v[j]; if (obf) *(u32x2*)(obf + j * 256 + lane * 4) = (u32x2){pk2(v[j][0], v[j][1]), pk2(v[j][2], v[j][3])}; }
}
__device__ __forceinline__ void phase_ln1(const Params& P, int l) {
    const int tid = ltid(); const int lane = tid & 63, wid = __builtin_amdgcn_readfirstlane(tid >> 6); const int gw = blockIdx.x * 8 + wid, NGW = gridDim.x * 8;
    const float* y = (const float*)(P.ws + WS_YBUF); float* xf = (float*)(P.ws + WS_XF); bf16_t* xb = (bf16_t*)(P.ws + WS_XB);
    for (int m = gw; m < NTOK; m += NGW) { f32x4 v[4];
#pragma unroll
        for (int j = 0; j < 4; ++j) v[j] = *(const f32x4*)(y + (size_t)m * DM + j * 256 + lane * 4);
        ln_core(v, P.in[17] + l * DM, P.in[18] + l * DM, lane);
        ln_store(v, xf + (size_t)m * DM, xb + (size_t)m * DM, lane); }
}
__device__ __forceinline__ void phase_ln2_router(const Params& P, int l, LAS unsigned char* lds) {
    const int tid = ltid(); const int lane = tid & 63, wid = __builtin_amdgcn_readfirstlane(tid >> 6); const int gw = blockIdx.x * 8 + wid, NGW = gridDim.x * 8;
    const float* y = (const float*)(P.ws + WS_YBUF); float* xf = (float*)(P.ws + WS_XF); bf16_t* xb = (bf16_t*)(P.ws + WS_XB);
    int* cnt = (int*)(P.ws + WS_CTL) + l * 32; int* elist = (int*)(P.ws + WS_ELIST); float* tgate = (float*)(P.ws + WS_TGATE);
    LAS float* xs = (LAS float*)(lds + wid * 16384);
    const float* rw = P.in[25] + (size_t)l * 1024 * 32; const float* rb = P.in[26] + l * 32;
    for (int pr = gw; pr < NTOK / 4; pr += NGW) {
#pragma unroll
        for (int rr = 0; rr < 4; ++rr) { const int m = pr * 4 + rr; f32x4 v[4];
#pragma unroll
            for (int j = 0; j < 4; ++j) v[j] = *(const f32x4*)(y + (size_t)m * DM + j * 256 + lane * 4);
            ln_core(v, P.in[23] + l * DM, P.in[24] + l * DM, lane);
            ln_store(v, xf + (size_t)m * DM, xb + (size_t)m * DM, lane);
#pragma unroll
            for (int j = 0; j < 4; ++j) *(LAS f32x4*)(xs + rr * 1024 + j * 256 + lane * 4) = v[j]; }
        WBAR();
        const int e = lane & 31, hf = lane >> 5;
        float a[4] = {0.f, 0.f, 0.f, 0.f};
        for (int kb = 0; kb < 16; ++kb) { const int k0 = hf * 512 + kb * 32;
            float w[32];
#pragma unroll
            for (int j = 0; j < 32; ++j) w[j] = rw[(k0 + j) * 32 + e];
#pragma unroll
            for (int j4 = 0; j4 < 8; ++j4)
#pragma unroll
                for (int rr = 0; rr < 4; ++rr) { const f32x4 x = *(const LAS f32x4*)(xs + rr * 1024 + k0 + j4 * 4);
                    a[rr] += x[0] * w[4 * j4]; a[rr] += x[1] * w[4 * j4 + 1]; a[rr] += x[2] * w[4 * j4 + 2]; a[rr] += x[3] * w[4 * j4 + 3]; } }
        const float bias = rb[e];
#pragma unroll
        for (int rr = 0; rr < 4; ++rr) { const int m = pr * 4 + rr;
            float lg = a[rr] + __shfl_xor(a[rr], 32) + bias; lg = (lg == lg) ? fminf(fmaxf(lg, -1e30f), 1e30f) : -1e30f; float v = (lane < 32) ? lg : -3e38f;
            float tv[4]; int te[4];
#pragma unroll
            for (int k = 0; k < 4; ++k) { const float mx = wave_max(v); const unsigned long long bal = __ballot(v == mx); const int idx = (__ffsll((long long)bal) - 1) & 31; tv[k] = mx; te[k] = idx; if (lane == idx) v = -3e38f; }
            const float e1 = __expf(tv[1] - tv[0]), e2 = __expf(tv[2] - tv[0]), e3 = __expf(tv[3] - tv[0]); const float inv = 1.f / (1.f + e1 + e2 + e3);
            if (lane < 4) { const int ee = lane == 0 ? te[0] : (lane == 1 ? te[1] : (lane == 2 ? te[2] : te[3])); const float gg = (lane == 0 ? 1.f : (lane == 1 ? e1 : (lane == 2 ? e2 : e3))) * inv;
                const int pos = atomicAdd(cnt + ee, 1); elist[ee * ECAP + pos] = m * 4 + lane; tgate[m * 4 + lane] = gg; } }
        WBAR();
    }
}
__device__ __forceinline__ void phase_router_old(const Params& P, int l, LAS unsigned char* lds) {
    const int tid = ltid(); const int lane = tid & 63, wid = __builtin_amdgcn_readfirstlane(tid >> 6); const int gw = blockIdx.x * 8 + wid, NGW = gridDim.x * 8;
    const float* y = (const float*)(P.ws + WS_YBUF); float* xf = (float*)(P.ws + WS_XF); bf16_t* xb = (bf16_t*)(P.ws + WS_XB);
    int* cnt = (int*)(P.ws + WS_CTL) + l * 32; int* elist = (int*)(P.ws + WS_ELIST); float* tgate = (float*)(P.ws + WS_TGATE);
    LAS float* xs = (LAS float*)(lds + wid * 16384);
    const float* rw = P.in[25] + (size_t)l * 1024 * 32; const float* rb = P.in[26] + l * 32;
    for (int pr = gw; pr < NTOK / 4; pr += NGW) {
#pragma unroll
        for (int rr = 0; rr < 4; ++rr) { const int m = pr * 4 + rr; f32x4 v[4];
#pragma unroll
            for (int j = 0; j < 4; ++j) v[j] = *(const f32x4*)(xf + (size_t)m * DM + j * 256 + lane * 4);
#pragma unroll
            for (int j = 0; j < 4; ++j) *(LAS f32x4*)(xs + rr * 1024 + j * 256 + lane * 4) = v[j]; }
        WBAR();
        const int e = lane & 31, hf = lane >> 5;
        float a[4] = {0.f, 0.f, 0.f, 0.f};
        for (int kb = 0; kb < 16; ++kb) { const int k0 = hf * 512 + kb * 32;
            float w[32];
#pragma unroll
            for (int j = 0; j < 32; ++j) w[j] = rw[(k0 + j) * 32 + e];
#pragma unroll
            for (int j4 = 0; j4 < 8; ++j4)
#pragma unroll
                for (int rr = 0; rr < 4; ++rr) { const f32x4 x = *(const LAS f32x4*)(xs + rr * 1024 + k0 + j4 * 4);
                    a[rr] += x[0] * w[4 * j4]; a[rr] += x[1] * w[4 * j4 + 1]; a[rr] += x[2] * w[4 * j4 + 2]; a[rr] += x[3] * w[4 * j4 + 3]; } }
        const float bias = rb[e];
#pragma unroll
        for (int rr = 0; rr < 4; ++rr) { const int m = pr * 4 + rr;
            float lg = a[rr] + __shfl_xor(a[rr], 32) + bias; lg = (lg == lg) ? fminf(fmaxf(lg, -1e30f), 1e30f) : -1e30f; float v = (lane < 32) ? lg : -3e38f;
            float tv[4]; int te[4];
#pragma unroll
            for (int k = 0; k < 4; ++k) { const float mx = wave_max(v); const unsigned long long bal = __ballot(v == mx); const int idx = (__ffsll((long long)bal) - 1) & 31; tv[k] = mx; te[k] = idx; if (lane == idx) v = -3e38f; }
            const float e1 = __expf(tv[1] - tv[0]), e2 = __expf(tv[2] - tv[0]), e3 = __expf(tv[3] - tv[0]); const float inv = 1.f / (1.f + e1 + e2 + e3);
            if (lane < 4) { const int ee = lane == 0 ? te[0] : (lane == 1 ? te[1] : (lane == 2 ? te[2] : te[3])); const float gg = (lane == 0 ? 1.f : (lane == 1 ? e1 : (lane == 2 ? e2 : e3))) * inv;
                const int pos = atomicAdd(cnt + ee, 1); elist[ee * ECAP + pos] = m * 4 + lane; tgate[m * 4 + lane] = gg; } }
        WBAR();
    }
}
__device__ __forceinline__ void phase_router(const Params& P, int l, LAS unsigned char* lds) {
    if (gridDim.x != 256) { phase_router_old(P, l, lds); return; }
    const int tid = ltid(); const int lane = tid & 63, wid = __builtin_amdgcn_readfirstlane(tid >> 6); const int gw = blockIdx.x * 8 + wid, NGW = gridDim.x * 8;
    const float* xf = (const float*)(P.ws + WS_XF);
    int* cnt = (int*)(P.ws + WS_CTL) + l * 32; int* elist = (int*)(P.ws + WS_ELIST); float* tgate = (float*)(P.ws + WS_TGATE);
    LAS float* xs = (LAS float*)(lds + wid * 16384);
    LAS int* lcnt = (LAS int*)(lds + 131072 + 256); LAS int* lbase = (LAS int*)(lds + 131072 + 384);
    const float* rw = P.in[25] + (size_t)l * 1024 * 32; const float* rb = P.in[26] + l * 32;
    if (tid < 32) lcnt[tid] = 0;
    __syncthreads();
    int rec_e[2][4], rec_p[2][4];
    {
        const int e = lane & 31, hf = lane >> 5;
        float a[8] = {0.f, 0.f, 0.f, 0.f, 0.f, 0.f, 0.f, 0.f};
#pragma unroll 1
        for (int ps = 0; ps < 2; ++ps) {
#pragma unroll
            for (int r8 = 0; r8 < 8; ++r8) { const int m = (gw + (r8 >> 2) * NGW) * 4 + (r8 & 3);
#pragma unroll
                for (int j = 0; j < 2; ++j) *(LAS f32x4*)(xs + r8 * 512 + j * 256 + lane * 4) = *(const f32x4*)(xf + (size_t)m * DM + ps * 512 + j * 256 + lane * 4); }
            WBAR();
            for (int kb = 0; kb < 8; ++kb) { const int kl = hf * 256 + kb * 32;
                float w[32];
#pragma unroll
                for (int j = 0; j < 32; ++j) w[j] = rw[(ps * 512 + kl + j) * 32 + e];
#pragma unroll
                for (int j4 = 0; j4 < 8; ++j4)
#pragma unroll
                    for (int r8 = 0; r8 < 8; ++r8) { const f32x4 x = *(const LAS f32x4*)(xs + r8 * 512 + kl + j4 * 4);
                        a[r8] += x[0] * w[4 * j4]; a[r8] += x[1] * w[4 * j4 + 1]; a[r8] += x[2] * w[4 * j4 + 2]; a[r8] += x[3] * w[4 * j4 + 3]; } }
            WBAR();
        }
        const float bias = rb[e];
#pragma unroll
        for (int r8 = 0; r8 < 8; ++r8) { const int q = r8 >> 2, rr = r8 & 3; const int m = (gw + q * NGW) * 4 + rr;
            float lg = a[r8] + __shfl_xor(a[r8], 32) + bias; lg = (lg == lg) ? fminf(fmaxf(lg, -1e30f), 1e30f) : -1e30f; float v = (lane < 32) ? lg : -3e38f;
            float tv[4]; int te[4];
#pragma unroll
            for (int k = 0; k < 4; ++k) { const float mx = wave_max(v); const unsigned long long bal = __ballot(v == mx); const int idx = (__ffsll((long long)bal) - 1) & 31; tv[k] = mx; te[k] = idx; if (lane == idx) v = -3e38f; }
            const float e1 = __expf(tv[1] - tv[0]), e2 = __expf(tv[2] - tv[0]), e3 = __expf(tv[3] - tv[0]); const float inv = 1.f / (1.f + e1 + e2 + e3);
            rec_e[q][rr] = 0; rec_p[q][rr] = 0;
            if (lane < 4) { const int ee = lane == 0 ? te[0] : (lane == 1 ? te[1] : (lane == 2 ? te[2] : te[3])); const float gg = (lane == 0 ? 1.f : (lane == 1 ? e1 : (lane == 2 ? e2 : e3))) * inv;
                rec_e[q][rr] = ee; rec_p[q][rr] = __hip_atomic_fetch_add(lcnt + ee, 1, __ATOMIC_RELAXED, __HIP_MEMORY_SCOPE_WORKGROUP); tgate[m * 4 + lane] = gg; } }
    }
    __syncthreads();
    if (tid < 32) lbase[tid] = atomicAdd(cnt + tid, lcnt[tid]);
    __syncthreads();
    if (lane < 4) {
#pragma unroll
        for (int q = 0; q < 2; ++q)
#pragma unroll
            for (int rr = 0; rr < 4; ++rr) { const int m = (gw + q * NGW) * 4 + rr; const int ee = rec_e[q][rr]; elist[ee * ECAP + lbase[ee] + rec_p[q][rr]] = m * 4 + lane; } }
    __syncthreads();
}
__device__ __forceinline__ void phase_ln3(const Params& P, int l) {
    const int tid = ltid(); const int lane = tid & 63, wid = __builtin_amdgcn_readfirstlane(tid >> 6); const int gw = blockIdx.x * 8 + wid, NGW = gridDim.x * 8;
    float* xf = (float*)(P.ws + WS_XF); bf16_t* xb = (bf16_t*)(P.ws + WS_XB); const bf16_t* ys = (const bf16_t*)(P.ws + WS_YS);
    for (int m = gw; m < NTOK; m += NGW) { f32x4 v[4];
#pragma unroll
        for (int j = 0; j < 4; ++j) { v[j] = *(const f32x4*)(xf + (size_t)m * DM + j * 256 + lane * 4) * ALPHA;
#pragma unroll
            for (int k = 0; k < 4; ++k) { const u32x2 w = *(const u32x2*)(ys + ((size_t)m * 4 + k) * DM + j * 256 + lane * 4); v[j] += (f32x4){bflo(w[0]), bfhi(w[0]), bflo(w[1]), bfhi(w[1])}; } }
        ln_core(v, P.in[31] + l * DM, P.in[32] + l * DM, lane);
        if (l == 1) ln_store(v, P.out + (size_t)m * DM, nullptr, lane); else ln_store(v, xf + (size_t)m * DM, xb + (size_t)m * DM, lane); }
}

__device__ __forceinline__ void set_base(ProbBase& S, const void* A, int lda, const void* Bt, int ldb, int M, int N, int K, int G, int c) { S.A = (const char*)A; S.Bt = (const char*)Bt; S.init(M, N, G, c); }

typedef const Params __attribute__((address_space(4))) CParams;
__global__ void __launch_bounds__(512, 2) mega(Params Pk) {
    extern __shared__ __attribute__((aligned(16))) unsigned char smem[];
    LAS unsigned char* lds = (LAS unsigned char*)smem;
    cg::grid_group grid = cg::this_grid();
    CParams* kp = (CParams*)__builtin_amdgcn_kernarg_segment_ptr();
    const int lo = Pk.ph_lo, hi = Pk.ph_hi;
    int nbar = 0;
#ifndef PHMASK
#define PHMASK 0xffffffffu
#endif
#define EN(k) (((PHMASK) >> (k)) & 1u)
#ifndef REPMASK
#define REPMASK 0u
#endif
#define NREP(k) ((((REPMASK) >> (k)) & 1u) ? 2 : 1)
#define RB(k) for (int rep_ = 0; rep_ < NREP(k); ++rep_) { if (rep_) GRID_BARRIER();
#define RE }
#define GRID_BARRIER() do { asm volatile("s_waitcnt vmcnt(0) lgkmcnt(0)" ::: "memory"); __syncthreads(); \
        if (nbar == 0) grid.sync(); \
        if (ltid() == 0) { unsigned* bw = (unsigned*)(kp->ws + WS_CTL + 1024) + nbar * 160; const unsigned gx = gridDim.x, sg = blockIdx.x & 7u; const unsigned nsub = (gx + 7u - sg) >> 3; const unsigned ngrp = gx < 8u ? gx : 8u; \
            __builtin_amdgcn_fence(__ATOMIC_RELEASE, "agent"); asm volatile("s_waitcnt vmcnt(0)" ::: "memory"); \
            const unsigned old = __hip_atomic_fetch_add(bw + 16 + sg * 16, 1u, __ATOMIC_RELAXED, __HIP_MEMORY_SCOPE_AGENT); \
            if (old + 1u == nsub) __hip_atomic_fetch_add(bw, 1u, __ATOMIC_RELAXED, __HIP_MEMORY_SCOPE_AGENT); \
            while (__hip_atomic_load(bw, __ATOMIC_RELAXED, __HIP_MEMORY_SCOPE_AGENT) < ngrp) __builtin_amdgcn_s_sleep(1); \
            __builtin_amdgcn_fence(__ATOMIC_ACQUIRE, "agent"); asm volatile("s_waitcnt vmcnt(0)" ::: "memory"); } \
        __syncthreads(); ++nbar; } while (0)
#define LOCAL_SYNC() do { asm volatile("s_waitcnt vmcnt(0) lgkmcnt(0)" ::: "memory"); __syncthreads(); if (ltid() < 64) { asm volatile("buffer_inv sc1\n\ts_waitcnt vmcnt(0)" ::: "memory"); } __syncthreads(); } while (0)
#define PH_BEGIN(id) if ((id) >= lo && (id) < hi) { CParams* kq = kp; asm volatile("" : "+s"(kq)); const Params& P = *(const Params*)kq; unsigned char* ws = P.ws; \
        int G = gridDim.x, bx = blockIdx.x; asm volatile("" : "+s"(G), "+s"(bx)); (void)ws; (void)G; (void)bx;
#define PH_END(id) if ((id) + 1 < hi) GRID_BARRIER(); }
    PH_BEGIN(0) if (EN(0)) RB(0) phase_convert(P, lds);  RE PH_END(0)
#define LAYER(l, B) \
    PH_BEGIN(B + 0) if (EN(1)) RB(1) { \
        { ProbInProj S; set_base(S, ws + WS_XB, 2048, ws + WS_WIN + l * SZ_WIN, 2048, NTOK, NP, 1024, G, bx); S.out = (bf16_t*)(ws + WS_P); S.bias = P.in[3] + (size_t)l * NIN; gemm_phase(lds, S); } \
        if (l == 0) { for (int ll = 0; ll < 2; ++ll) { \
          { ProbBf16 S; set_base(S, ws + WS_MEMB, 2048, ws + WS_WK + ll * SZ_SQ, 2048, 1024, 1024, 1024, G, (bx + G - 128 - 32 * ll) % G); S.out = (bf16_t*)(ws + WS_KM + ll * SZ_SQ); S.ldc = 1024; gemm_phase(lds, S); } \
          { ProbBf16 S; set_base(S, ws + WS_MEMB, 2048, ws + WS_WV + ll * SZ_SQ, 2048, 1024, 1024, 1024, G, (bx + G - 144 - 32 * ll) % G); S.out = (bf16_t*)(ws + WS_VT + ll * SZ_SQ); S.ldc = 1024; gemm_phase(lds, S); } } } }  RE PH_END(B + 0) \
    PH_BEGIN(B + 1) if (EN(2)) RB(2) phase_mixer_local(P, l, lds);  RE PH_END(B + 1) \
    PH_BEGIN(B + 2) if (EN(3)) RB(3) { phase_scan(P); \
        if (l == 0) { for (int ll = 0; ll < 2; ++ll) { \
          { ProbVW S; S.A = (const char*)(ws + WS_WXO + ll * SZ_SQ); S.Bt = (const char*)(ws + WS_VT + ll * SZ_SQ); S.G = G; S.c = (bx + G - 128 * ll) % G; S.out = (bf16_t*)(ws + WS_OB + (size_t)ll * 4 * SZ_SQ); gemm_phase(lds, S); } \
          { ProbMT S; S.A = (const char*)(ws + WS_KM + ll * SZ_SQ); S.Bt = (const char*)(ws + WS_WQ + ll * SZ_SQ); S.G = G; S.c = (bx + G - 64 - 128 * ll) % G; S.out = (bf16_t*)(ws + WS_QB + (size_t)ll * 4 * SZ_SQ); gemm_phase(lds, S); } } } }  RE PH_END(B + 2) \
    PH_BEGIN(B + 3) if (EN(4)) RB(4) { G2R ra, rb; int it = bx; if (it < 1024) { gla2_load(P, it, ltid(), ra); for (;;) { const int i2 = it + G; const bool h2 = i2 < 1024; gla2_item(P, l, it, h2 ? i2 : -1, ra, rb, lds); if (!h2) break; const int i3 = i2 + G; const bool h3 = i3 < 1024; gla2_item(P, l, i2, h3 ? i3 : -1, rb, ra, lds); if (!h3) break; it = i3; } } }  RE PH_END(B + 3) \
    PH_BEGIN(B + 4) if (EN(5)) RB(5) { { ProbMerge<512> S; S.A = (const char*)(ws + WS_YCAT); S.Bt = (const char*)(ws + WS_WUP + l * SZ_SQ); S.G = G; S.c = bx; \
            S.p = (const bf16_t*)(ws + WS_P); S.mb = (bf16_t*)(ws + WS_MRGB); gemm_phase(lds, S); } \
            asm volatile("s_waitcnt vmcnt(0)" ::: "memory"); __syncthreads(); \
            { ProbMerge<256> S; S.A = (const char*)(ws + WS_YCAT); S.Bt = (const char*)(ws + WS_WUP + l * SZ_SQ); S.G = G; S.c = bx; \
            S.p = (const bf16_t*)(ws + WS_P); S.mb = (bf16_t*)(ws + WS_MRGB); gemm_phase(lds, S); } }  RE PH_END(B + 4) \
    PH_BEGIN(B + 5) if (EN(6)) RB(6) { ProbResLN S; set_base(S, ws + WS_MRGB, 2048, ws + WS_WO + l * SZ_SQ, 2048, NTOK, 1024, 1024, G, bx); \
            S.xres = (l == 0) ? P.in[0] : (const float*)(ws + WS_XF); S.lng = P.in[17] + l * DM; S.lnb = P.in[18] + l * DM; S.xf = (float*)(ws + WS_XF); S.xb = (bf16_t*)(ws + WS_XB); \
            S.stats = (float*)(ws + WS_STATS); S.cntp = (unsigned*)(ws + WS_CTL + 24576) + (l * 2 + 0) * 64; S.bstride = 0; gemm_phase(lds, S); }  RE PH_END(B + 5) \
    PH_BEGIN(B + 7) if (EN(8)) RB(8) { ProbAttn<0, 1024> S; S.A = (const char*)(ws + WS_XB); S.Bt = (const char*)(ws + WS_QB + (size_t)l * 4 * SZ_SQ); S.G = G; S.c = bx; S.sout = nullptr; S.oout = (bf16_t*)(ws + WS_MRGF); gemm_phase(lds, S); }  RE PH_END(B + 7) \
    PH_BEGIN(B + 10) if (EN(6)) RB(6) { ProbResLN S; set_base(S, ws + WS_MRGF, 2048, ws + WS_OB + (size_t)l * 4 * SZ_SQ, 2048, NTOK, 1024, 1024, G, bx); \
            S.xres = (const float*)(ws + WS_XF); S.lng = P.in[23] + l * DM; S.lnb = P.in[24] + l * DM; S.xf = (float*)(ws + WS_XF); S.xb = (bf16_t*)(ws + WS_XB); \
            S.stats = (float*)(ws + WS_STATS); S.cntp = (unsigned*)(ws + WS_CTL + 24576) + (l * 2 + 1) * 64; S.bstride = SZ_SQ; gemm_phase(lds, S); }  RE PH_END(B + 10) \
    PH_BEGIN(B + 11) if (EN(10)) RB(10) phase_router(P, l, lds);  RE PH_END(B + 11) \
    PH_BEGIN(B + 12) if (EN(11)) RB(11) { LAS int* tstart = (LAS int*)(lds + 131072); const int* cnt = (const int*)(ws + WS_CTL) + l * 32; \
            if (ltid() == 0) { int a = 0; for (int e = 0; e < 32; ++e) { tstart[e] = a; a += (cnt[e] + 255) >> 8; } tstart[32] = a; } \
            __syncthreads(); \
            ProbMoe1 S; S.G = G; S.c = (G % 8 == 0) ? (bx % 8) * (G / 8) + bx / 8 : bx; S.nN = 8; S.tstart = tstart; S.cnt = cnt; \
            S.A = (const char*)(ws + WS_XB); S.Bt = (const char*)(ws + WS_WGU + l * SZ_WGU); \
            S.elist = (const int*)(ws + WS_ELIST); S.bgu = P.in[28] + (size_t)l * 32 * 2048; S.abuf = (bf16_t*)(ws + WS_ABUF); gemm_phase(lds, S); }  RE PH_END(B + 12) \
    PH_BEGIN(B + 13) if (EN(12)) RB(12) { LAS int* tstart = (LAS int*)(lds + 131072); const int* cnt = (const int*)(ws + WS_CTL) + l * 32; \
            if (ltid() == 0) { int a = 0; for (int e = 0; e < 32; ++e) { tstart[e] = a; a += (cnt[e] + 255) >> 8; } tstart[32] = a; } \
            __syncthreads(); \
            ProbMoe2 S; S.G = G; S.c = (G % 8 == 0) ? (bx % 8) * (G / 8) + bx / 8 : bx; S.nN = 4; S.tstart = tstart; S.cnt = cnt; \
            S.A = (const char*)(ws + WS_ABUF); S.Bt = (const char*)(ws + WS_WD + l * SZ_WD); \
            S.elist = (const int*)(ws + WS_ELIST); S.bd = P.in[30] + (size_t)l * 32 * 1024; S.tgate = (const float*)(ws + WS_TGATE); S.ys = (bf16_t*)(ws + WS_YS); gemm_phase(lds, S); }  RE PH_END(B + 13) \
    PH_BEGIN(B + 14) if (EN(13)) RB(13) phase_ln3(P, l);  RE PH_END(B + 14)
    LAYER(0, 1)
    LAYER(1, 16)
#ifdef EXTRA_BARS
    for (int xb_ = 0; xb_ < EXTRA_BARS; ++xb_) GRID_BARRIER();
#endif
#ifdef DBG_OFF
    { GRID_BARRIER(); const Params& P = *(const Params*)kp; const int G = gridDim.x, bx = blockIdx.x; const int gt = bx * 512 + ltid();
      for (size_t i = gt; i < (size_t)NTOK * DM; i += (size_t)G * 512) {
#if DBG_BF16
          { float dv = bf2f(((const bf16_t*)(P.ws + DBG_OFF))[i]); P.out[i] = (dv == dv && fabsf(dv) < 1e30f) ? dv : 1000.f; }
#else
          P.out[i] = ((const float*)(P.ws + DBG_OFF))[i];
#endif
      } }
#endif
}

extern "C" void kernel_launch(void* const* d_in, const int* in_sizes, int n_in, void* d_out, int out_size, void* d_ws, size_t ws_size, hipStream_t stream) {
    static int grid = 0;
    if (grid == 0) {
        int dev = 0, cus = 0, per_cu = 0;
        hipGetDevice(&dev);
        hipDeviceGetAttribute(&cus, hipDeviceAttributeMultiprocessorCount, dev);
        hipFuncSetAttribute((const void*)mega, hipFuncAttributeMaxDynamicSharedMemorySize, LDS_BYTES);
        hipOccupancyMaxActiveBlocksPerMultiprocessor(&per_cu, (const void*)mega, 512, LDS_BYTES);
        if (per_cu < 1) per_cu = 1;
        grid = cus < 256 ? cus : 256;
        if (ws_size < WS_END) fprintf(stderr, "kernel_launch: workspace too small: %zu < %zu\n", ws_size, (size_t)WS_END);
        if (n_in != 33) fprintf(stderr, "kernel_launch: expected 33 inputs, got %d\n", n_in);
    }
    hipMemsetAsync((char*)d_ws + WS_CTL, 0, 32768, stream);
    Params p{};
    for (int i = 0; i < 33; ++i) p.in[i] = (const float*)d_in[i];
    p.out = (float*)d_out; p.ws = (unsigned char*)d_ws; p.ph_lo = 0; p.ph_hi = PH_HI;
    void* args[] = {&p};
    hipError_t e = hipLaunchCooperativeKernel((const void*)mega, dim3(grid), dim3(512), args, LDS_BYTES, stream);
    if (e != hipSuccess) fprintf(stderr, "cooperative launch failed: %s (grid %d)\n", hipGetErrorString(e), grid);
}
```

```cpp
#include <hip/hip_runtime.h>
#include <hip/hip_cooperative_groups.h>
#include <cstdio>
namespace cg = cooperative_groups;

#define LAS __attribute__((address_space(3)))
typedef unsigned short bf16_t;
typedef short bf16x8 __attribute__((ext_vector_type(8)));
typedef float f32x4 __attribute__((ext_vector_type(4)));
typedef unsigned u32x4 __attribute__((ext_vector_type(4)));
typedef unsigned u32x2 __attribute__((ext_vector_type(2)));

constexpr int NTOK = 16384, DM = 1024, SEQL = 4096, NP = 5632;
constexpr int COL_K = 256, COL_V = 512, COL_R = 1024, COL_UV = 1536, COL_XC = 2048, COL_GATE = 2304, COL_GL = 5376, NIN = 5392;
constexpr float LN_EPS = 1e-5f;
constexpr float ALPHA = 1.41421356237f;
constexpr int ECAP = 16384;
constexpr int LDS_BYTES = 131072 + 1024;
#ifndef PH_HI
#define PH_HI 31
#endif

constexpr size_t al256(size_t x) { return (x + 255) & ~(size_t)255; }
constexpr size_t WS_CTL = 0;
constexpr size_t WS_WIN = 32768;
constexpr size_t SZ_WIN = (size_t)NP * 1024 * 2;
constexpr size_t WS_WUP = WS_WIN + 2 * SZ_WIN;
constexpr size_t SZ_SQ = (size_t)1024 * 1024 * 2;
constexpr size_t WS_WO = WS_WUP + 2 * SZ_SQ;
constexpr size_t WS_WQ = WS_WO + 2 * SZ_SQ;
constexpr size_t WS_WK = WS_WQ + 2 * SZ_SQ;
constexpr size_t WS_WV = WS_WK + 2 * SZ_SQ;
constexpr size_t WS_WXO = WS_WV + 2 * SZ_SQ;
constexpr size_t WS_WGU = WS_WXO + 2 * SZ_SQ;
constexpr size_t SZ_WGU = (size_t)32 * 2048 * 1024 * 2;
constexpr size_t WS_WD = WS_WGU + 2 * SZ_WGU;
constexpr size_t SZ_WD = (size_t)32 * 1024 * 1024 * 2;
constexpr size_t WS_XB = WS_WD + 2 * SZ_WD;
constexpr size_t SZ_ACTB = (size_t)NTOK * 1024 * 2;
constexpr size_t SZ_ACTF = (size_t)NTOK * 1024 * 4;
constexpr size_t WS_MEMB = WS_XB + SZ_ACTB;
constexpr size_t WS_XF = WS_MEMB + SZ_SQ;
constexpr size_t WS_YBUF = WS_XF + SZ_ACTF;
constexpr size_t WS_P = WS_YBUF + SZ_ACTF;
constexpr size_t WS_YCAT = WS_P + (size_t)NTOK * NP * 2;
constexpr size_t WS_BCUM = WS_YCAT + SZ_ACTB;
constexpr size_t WS_KVT = WS_BCUM + (size_t)NTOK * 256 * 4;
constexpr size_t WS_CDEC = WS_KVT + (size_t)1024 * 8192 * 4;
constexpr size_t WS_ST = WS_CDEC + (size_t)1024 * 64 * 4;
constexpr size_t WS_MRGF = WS_ST + (size_t)1024 * 8192 * 2;
constexpr size_t WS_MRGB = WS_MRGF + SZ_ACTF;
constexpr size_t WS_QB = WS_MRGB + SZ_ACTB;
constexpr size_t WS_OB = WS_QB + SZ_ACTB;
constexpr size_t WS_KM = WS_OB + SZ_ACTB;
constexpr size_t WS_VT = WS_KM + 2 * SZ_SQ;
constexpr size_t WS_ELIST = WS_VT + 8 * SZ_SQ;
constexpr size_t WS_TGATE = WS_ELIST + (size_t)32 * ECAP * 4;
constexpr size_t WS_ABUF = WS_TGATE + (size_t)32 * ECAP * 4;
constexpr size_t WS_YS = WS_ABUF + (size_t)73728 * 1024 * 2;
constexpr size_t WS_STATS = WS_YS + (size_t)65536 * 1024 * 2;
constexpr size_t WS_END = WS_STATS + (size_t)64 * 4 * 256 * 2 * 4;

__device__ __forceinline__ float bf2f(bf16_t b) { return __uint_as_float(((unsigned)b) << 16); }
__device__ __forceinline__ unsigned pk2(float lo, float hi) { unsigned r; asm("v_cvt_pk_bf16_f32 %0, %1, %2" : "=v"(r) : "v"(lo), "v"(hi)); return r; }
__device__ __forceinline__ bf16_t f2bf(float f) { return (bf16_t)(pk2(f, 0.f) & 0xffffu); }
__device__ __forceinline__ float bflo(unsigned u) { return __uint_as_float(u << 16); }
__device__ __forceinline__ float bfhi(unsigned u) { return __uint_as_float(u & 0xffff0000u); }
__device__ __forceinline__ float wave_sum(float v) {
#pragma unroll
    for (int o = 32; o; o >>= 1) v += __shfl_xor(v, o);
    return v;
}
__device__ __forceinline__ float wave_max(float v) {
#pragma unroll
    for (int o = 32; o; o >>= 1) v = fmaxf(v, __shfl_xor(v, o));
    return v;
}
__device__ __forceinline__ float gelu_f(float v) {
    const float av = fabsf(v), t = __builtin_amdgcn_rcpf(av * 0.2316418882f + 1.0f);
    float q = t * 0.5307027145f + (-0.7265760135f); q = q * t + 0.7107068705f; q = q * t + (-0.142248368f); q = q * t + 0.127414796f; q = q * t;
    const float e = __builtin_amdgcn_exp2f((v * v) * (-0.72134752044f));
    const float m = v * (q * e);
    return v < 0.f ? m : v - m;
}
__device__ __forceinline__ float sigmoid_f(float x) { return __builtin_amdgcn_rcpf(1.f + __expf(-x)); }
__device__ __forceinline__ int ltid() { int t = threadIdx.x; asm volatile("" : "+v"(t)); return t; }
#define WBAR() do { asm volatile("" ::: "memory"); __builtin_amdgcn_wave_barrier(); asm volatile("" ::: "memory"); } while (0)

struct Params { const float* in[33]; float* out; unsigned char* ws; int ph_lo, ph_hi; };

constexpr int BM = 256, BK = 64, HALF = 128, HTB = HALF * BK * 2, NXCD = 8, WGM = 8;
__device__ __forceinline__ int lds_byte(int r, int c) { const int st = (r >> 4) * 2 + (c >> 5), rr = r & 15, cc = c & 31, ob = rr * 64 + cc * 2; return st * 1024 + (ob ^ (((ob >> 9) & 1) << 5)); }
__device__ __forceinline__ void stage_rc(int b, int& R, int& C) { const int st = b / 1024, sb = b % 1024, swz = sb ^ (((sb >> 9) & 1) << 5); R = (st >> 1) * 16 + swz / 64; C = (st & 1) * 32 + (swz % 64) / 2; }
__device__ __forceinline__ int perm32(int rho) { const int n = rho >> 4, i = rho & 15; return 8 * (i >> 2) + 4 * n + (i & 3); }

struct Unit { int pm, pn, e, aux; };
typedef f32x4 Acc[2][2][4][2];

struct OrderStatic {
    int nM, nN, nwg, G, c;
    __device__ __forceinline__ void init(int M, int N, int G_, int c_) { nM = M / BM; nN = N / BM; nwg = nM * nN; G = G_; c = c_; }
    __device__ __forceinline__ bool next(int i, Unit& u) const {
        const long L = (long)i * G + c; if (L >= nwg) return false;
        int wgid = (int)L; { const int q = nwg / NXCD, r = nwg % NXCD, xcd = wgid % NXCD, off = wgid / NXCD; wgid = (xcd < r ? xcd * (q + 1) : r * (q + 1) + (xcd - r) * q) + off; }
        const int nig = WGM * nN, gid = wgid / nig, fm = gid * WGM, gsz = (nM - fm) < WGM ? (nM - fm) : WGM;
        u.pm = fm + ((wgid % nig) % gsz); u.pn = (wgid % nig) / gsz; u.e = 0; u.aux = 0; return true;
    }
};

template <class S_t>
__device__ __forceinline__ void gemm_phase(LAS unsigned char* lds, const S_t& S) {
    const int tid = ltid(), wid = __builtin_amdgcn_readfirstlane(tid >> 6), lane = tid & 63, wr = wid >> 2, wc = wid & 3, fr = lane & 15, fq = lane >> 4;
    const int nt = S.K / BK;
    int Rr[2], Cc[2]; unsigned voffB[2]; unsigned offC[2][2], offN[2][2];
#pragma unroll
    for (int i = 0; i < 2; ++i) { stage_rc(tid * 16 + i * 8192, Rr[i], Cc[i]); const int Rb = S_t::PERM ? ((Rr[i] & ~31) + perm32(Rr[i] & 31)) : Rr[i];
        voffB[i] = (unsigned)(Rb * S.ldb + Cc[i] * 2);
        offC[0][i] = (unsigned)(Rr[i] * S.lda + Cc[i] * 2); offC[1][i] = (unsigned)((Rr[i] + HALF) * S.lda + Cc[i] * 2);
        }
    const size_t kstep = (size_t)(BK * 2);
    const size_t hstepB = (size_t)HALF * S.ldb;
    const unsigned ldsw = (unsigned)wid * 1024u;
    const int aoff = lds_byte(wr * 64 + fr, fq * 8), boff = lds_byte(wc * 32 + fr, fq * 8);
#define G_SA(b, h) (((b) * 2 + (h)) * HTB)
#define G_SB(b, h) ((4 + (b) * 2 + (h)) * HTB)
#define G_STAGE_A(bufoff, kptr, OFF, h) do { _Pragma("unroll") for (int _i = 0; _i < 2; ++_i) \
        __builtin_amdgcn_global_load_lds((const unsigned*)((const char*)(kptr) + (OFF)[h][_i]), (LAS unsigned*)(lds + (bufoff) + ldsw + _i * 8192), 16, 0, 0); } while (0)
#define G_STAGE_B(bufoff, gbase) do { _Pragma("unroll") for (int _i = 0; _i < 2; ++_i) \
        __builtin_amdgcn_global_load_lds((const unsigned*)((const char*)(gbase) + voffB[_i]), (LAS unsigned*)(lds + (bufoff) + ldsw + _i * 8192), 16, 0, 0); } while (0)
#define G_LDA(dst, b, h) do { _Pragma("unroll") for (int m = 0; m < 4; ++m) _Pragma("unroll") for (int k = 0; k < 2; ++k) dst[m][k] = *(const LAS bf16x8*)(lds + G_SA(b, h) + aoff + m * 2048 + k * 1024); } while (0)
#define G_LDB(dst, b, h) do { _Pragma("unroll") for (int n = 0; n < 2; ++n) _Pragma("unroll") for (int k = 0; k < 2; ++k) dst[n][k] = *(const LAS bf16x8*)(lds + G_SB(b, h) + boff + n * 2048 + k * 1024); } while (0)
#define G_MMA(ai, bj, At, Bt) do { __builtin_amdgcn_s_setprio(1); _Pragma("unroll") for (int m = 0; m < 4; ++m) _Pragma("unroll") for (int n = 0; n < 2; ++n) _Pragma("unroll") for (int k = 0; k < 2; ++k) \
        acc[ai][bj][m][n] = __builtin_amdgcn_mfma_f32_16x16x32_bf16(Bt[n][k], At[m][k], acc[ai][bj][m][n], 0, 0, 0); __builtin_amdgcn_s_setprio(0); } while (0)
#define G_WAIT_V(n) asm volatile("s_waitcnt vmcnt(" #n ")" ::: "memory")
#define G_WAIT_L(n) asm volatile("s_waitcnt lgkmcnt(" #n ")" ::: "memory")
#define G_BAR __builtin_amdgcn_s_barrier()
#define G_SCHED __builtin_amdgcn_sched_barrier(0)
    Unit cur, nxt; int ui = 0;
    if (!S.next(0, cur)) return;
    if (S_t::GATHER) S.gather_offs(cur, tid, offC);
    Acc acc;
#pragma unroll
    for (int a = 0; a < 2; ++a)
#pragma unroll
        for (int b = 0; b < 2; ++b)
#pragma unroll
            for (int m = 0; m < 4; ++m)
#pragma unroll
                for (int n = 0; n < 2; ++n) acc[a][b][m][n] = (f32x4){0.f, 0.f, 0.f, 0.f};
    bf16x8 At[4][2], B0[2][2], B1[2][2];
    const char* cA = S.a_ptr(cur); const char* cB = S.b_ptr(cur);
    G_STAGE_B(G_SB(0, 0), cB); G_STAGE_A(G_SA(0, 0), cA, offC, 0); G_STAGE_B(G_SB(0, 1), cB + hstepB); G_STAGE_A(G_SA(0, 1), cA, offC, 1);
    if (wr == 1) G_BAR;
    G_WAIT_V(4); G_BAR;
    G_STAGE_B(G_SB(1, 0), cB + kstep); G_STAGE_A(G_SA(1, 0), cA + kstep, offC, 0); G_STAGE_B(G_SB(1, 1), cB + hstepB + kstep);
    G_WAIT_V(6); G_BAR;
    for (;;) {
        const bool has_next = S.next(ui + 1, nxt);
        const char* nA = has_next ? S.a_ptr(nxt) : cA; const char* nB = has_next ? S.b_ptr(nxt) : cB;
        if (S_t::GATHER) { if (has_next) S.gather_offs(nxt, tid, offN); else { offN[0][0] = offC[0][0]; offN[0][1] = offC[0][1]; offN[1][0] = offC[1][0]; offN[1][1] = offC[1][1]; } }
        for (int t = 0; t < nt; t += 2) {
            const bool last = (t == nt - 2);
            const char* a1 = cA + (size_t)(t + 1) * kstep;
            const char* a2 = last ? nA : cA + (size_t)(t + 2) * kstep; const char* b2 = last ? nB : cB + (size_t)(t + 2) * kstep;
            const char* a3 = a2 + kstep; const char* b3 = b2 + kstep;
            G_LDB(B0, 0, 0); G_SCHED; G_LDA(At, 0, 0); G_STAGE_A(G_SA(1, 1), a1, offC, 1);
            if (S_t::GATHER) { if (last) { offC[0][0] = offN[0][0]; offC[0][1] = offN[0][1]; offC[1][0] = offN[1][0]; offC[1][1] = offN[1][1]; } }
            G_WAIT_L(8); G_BAR; G_WAIT_L(0); G_MMA(0, 0, At, B0); G_BAR; G_SCHED;
            G_LDB(B1, 0, 1); G_STAGE_B(G_SB(0, 0), b2);
            G_BAR; G_WAIT_L(0); G_MMA(0, 1, At, B1); G_BAR;
            G_LDA(At, 0, 1); G_STAGE_A(G_SA(0, 0), a2, offC, 0);
            G_BAR; G_WAIT_L(0); G_MMA(1, 0, At, B0); G_BAR; G_SCHED;
            G_STAGE_B(G_SB(0, 1), b2 + hstepB);
            G_WAIT_V(6); G_BAR; G_MMA(1, 1, At, B1); G_BAR;
            G_LDB(B0, 1, 0); G_SCHED; G_LDA(At, 1, 0); G_STAGE_A(G_SA(0, 1), a2, offC, 1);
            G_WAIT_L(8); G_BAR; G_WAIT_L(0); G_MMA(0, 0, At, B0); G_BAR; G_SCHED;
            G_LDB(B1, 1, 1); G_STAGE_B(G_SB(1, 0), b3);
            G_BAR; G_WAIT_L(0); G_MMA(0, 1, At, B1); G_BAR;
            G_LDA(At, 1, 1); G_STAGE_A(G_SA(1, 0), a3, offC, 0);
            G_BAR; G_WAIT_L(0); G_MMA(1, 0, At, B0); G_BAR; G_SCHED;
            G_STAGE_B(G_SB(1, 1), b3 + hstepB);
            G_WAIT_V(6); G_BAR; G_MMA(1, 1, At, B1); G_BAR;
        }
        if constexpr (!S_t::AFTER) S.epi(acc, cur, wr, wc, fr, fq);
        if (!has_next) break;
#pragma unroll
        for (int a = 0; a < 2; ++a)
#pragma unroll
            for (int b = 0; b < 2; ++b)
#pragma unroll
                for (int m = 0; m < 4; ++m)
#pragma unroll
                    for (int n = 0; n < 2; ++n) acc[a][b][m][n] = (f32x4){0.f, 0.f, 0.f, 0.f};
        cur = nxt; cA = nA; cB = nB; ++ui;
    }
    G_WAIT_V(0);
    if (wr == 0) G_BAR;
    G_BAR;
    if constexpr (S_t::AFTER) S.epi_after(acc, cur, wr, wc, fr, fq, lds);
}

struct ProbBase : OrderStatic {
    static constexpr bool GATHER = false, AFTER = false;
    const char* A; const char* Bt; static constexpr int K = 1024, lda = 2048, ldb = 2048;
    __device__ __forceinline__ const char* a_ptr(const Unit& u) const { return A + (size_t)u.pm * BM * lda; }
    __device__ __forceinline__ const char* b_ptr(const Unit& u) const { return Bt + (size_t)u.pn * BM * ldb; }
    __device__ __forceinline__ void gather_offs(const Unit&, int, unsigned (&)[2][2]) const {}
};

struct ProbInProj : ProbBase {
    static constexpr bool PERM = true;
    bf16_t* out; const float* bias;
    __device__ __forceinline__ void epi(const Acc& acc, const Unit& u, int wr, int wc, int fr, int fq) const {
        const int row0 = u.pm * BM + wr * 64 + fr, colt = u.pn * BM + wc * 32 + 8 * fq;
        f32x4 bv[2][2];
#pragma unroll
        for (int bj = 0; bj < 2; ++bj) { const int c = colt + bj * HALF; int mc = c < COL_UV ? c : (c < COL_GL ? c + 16 : c - COL_GL + COL_UV);
            if (c < NIN) { bv[bj][0] = *(const f32x4*)(bias + mc); bv[bj][1] = *(const f32x4*)(bias + mc + 4); } else { bv[bj][0] = (f32x4){0.f, 0.f, 0.f, 0.f}; bv[bj][1] = bv[bj][0]; } }
#pragma unroll
        for (int ai = 0; ai < 2; ++ai)
#pragma unroll
            for (int m = 0; m < 4; ++m) { bf16_t* rowp = out + (size_t)(row0 + ai * HALF + m * 16) * NP + colt;
#pragma unroll
                for (int bj = 0; bj < 2; ++bj) { const f32x4 v0 = acc[ai][bj][m][0] + bv[bj][0], v1 = acc[ai][bj][m][1] + bv[bj][1];
                    *(u32x4*)(rowp + bj * HALF) = (u32x4){pk2(v0[0], v0[1]), pk2(v0[2], v0[3]), pk2(v1[0], v1[1]), pk2(v1[2], v1[3])}; } }
    }
};
struct ProbBf16 : ProbBase {
    static constexpr bool PERM = true;
    bf16_t* out; int ldc;
    __device__ __forceinline__ void epi(const Acc& acc, const Unit& u, int wr, int wc, int fr, int fq) const {
        const int row0 = u.pm * BM + wr * 64 + fr, colt = u.pn * BM + wc * 32 + 8 * fq;
#pragma unroll
        for (int ai = 0; ai < 2; ++ai)
#pragma unroll
            for (int m = 0; m < 4; ++m) { bf16_t* rowp = out + (size_t)(row0 + ai * HALF + m * 16) * ldc + colt;
#pragma unroll
                for (int bj = 0; bj < 2; ++bj) { const f32x4 v0 = acc[ai][bj][m][0], v1 = acc[ai][bj][m][1];
                    *(u32x4*)(rowp + bj * HALF) = (u32x4){pk2(v0[0], v0[1]), pk2(v0[2], v0[3]), pk2(v1[0], v1[1]), pk2(v1[2], v1[3])}; } }
    }
};
struct ProbQ : ProbBf16 {
    int G2, c2;
    __device__ __forceinline__ bool next(int i, Unit& u) const { const int L = i * G2 + c2; if (L >= 256) return false; const int bh = L >> 4, mt = L & 15; u.pm = (bh >> 2) * 16 + mt; u.pn = bh & 3; u.e = 0; u.aux = 0; return true; }
};
struct ProbRes : ProbBase {
    static constexpr bool PERM = false;
    float* out; const float* xres;
    __device__ __forceinline__ void epi(const Acc& acc, const Unit& u, int wr, int wc, int fr, int fq) const {
        const int row0 = u.pm * BM + wr * 64 + fr, col0 = u.pn * BM + wc * 32 + 4 * fq;
#pragma unroll
        for (int ai = 0; ai < 2; ++ai) {
            f32x4 xr[4][2][2];
#pragma unroll
            for (int m = 0; m < 4; ++m) { const size_t ro = (size_t)(row0 + ai * HALF + m * 16) * DM + col0;
#pragma unroll
                for (int bj = 0; bj < 2; ++bj)
#pragma unroll
                    for (int n = 0; n < 2; ++n) xr[m][bj][n] = *(const f32x4*)(xres + ro + bj * HALF + n * 16); }
#pragma unroll
            for (int m = 0; m < 4; ++m) { const size_t ro = (size_t)(row0 + ai * HALF + m * 16) * DM + col0;
#pragma unroll
                for (int bj = 0; bj < 2; ++bj)
#pragma unroll
                    for (int n = 0; n < 2; ++n) *(f32x4*)(out + ro + bj * HALF + n * 16) = xr[m][bj][n] * ALPHA + acc[ai][bj][m][n]; }
        }
    }
};
struct ProbMT {
    static constexpr bool PERM = true, GATHER = false, AFTER = false;
    static constexpr int K = 256, lda = 2048, ldb = 2048;
    const char* A; const char* Bt; int G, c; bf16_t* out;
    __device__ __forceinline__ bool next(int i, Unit& u) const { const int L = i * G + c; if (L >= 64) return false; u.e = L >> 2; u.pn = L & 3; u.pm = 0; u.aux = 0; return true; }
    __device__ __forceinline__ const char* a_ptr(const Unit& u) const { const int b = u.e >> 2, h = u.e & 3; return A + (size_t)(b * 256) * lda + h * 512; }
    __device__ __forceinline__ const char* b_ptr(const Unit& u) const { const int h = u.e & 3; return Bt + (size_t)u.pn * BM * ldb + h * 512; }
    __device__ __forceinline__ void gather_offs(const Unit&, int, unsigned (&)[2][2]) const {}
    __device__ __forceinline__ void epi(const Acc& acc, const Unit& u, int wr, int wc, int fr, int fq) const {
        const int row0 = wr * 64 + fr, colt = u.pn * BM + wc * 32 + 8 * fq;
#pragma unroll
        for (int ai = 0; ai < 2; ++ai)
#pragma unroll
            for (int m = 0; m < 4; ++m) { bf16_t* rowp = out + (size_t)u.e * 256 * 1024 + (size_t)(row0 + ai * HALF + m * 16) * 1024 + colt;
#pragma unroll
                for (int bj = 0; bj < 2; ++bj) { const f32x4 v0 = acc[ai][bj][m][0], v1 = acc[ai][bj][m][1];
                    *(u32x4*)(rowp + bj * HALF) = (u32x4){pk2(v0[0], v0[1]), pk2(v0[2], v0[3]), pk2(v1[0], v1[1]), pk2(v1[2], v1[3])}; } }
    }
};
struct ProbVW {
    static constexpr bool PERM = true, GATHER = false, AFTER = false;
    static constexpr int K = 256, lda = 2048, ldb = 2048;
    const char* A; const char* Bt; int G, c; bf16_t* out;
    __device__ __forceinline__ bool next(int i, Unit& u) const { const int L = i * G + c; if (L >= 64) return false; u.e = L >> 2; u.pm = L & 3; u.pn = 0; u.aux = 0; return true; }
    __device__ __forceinline__ const char* a_ptr(const Unit& u) const { const int h = u.e & 3; return A + (size_t)u.pm * BM * lda + h * 512; }
    __device__ __forceinline__ const char* b_ptr(const Unit& u) const { const int b = u.e >> 2, h = u.e & 3; return Bt + (size_t)(b * 256) * ldb + h * 512; }
    __device__ __forceinline__ void gather_offs(const Unit&, int, unsigned (&)[2][2]) const {}
    __device__ __forceinline__ void epi(const Acc& acc, const Unit& u, int wr, int wc, int fr, int fq) const {
        const int b = u.e >> 2, h = u.e & 3; const int row0 = u.pm * BM + wr * 64 + fr, colt = h * 256 + wc * 32 + 8 * fq;
#pragma unroll
        for (int ai = 0; ai < 2; ++ai)
#pragma unroll
            for (int m = 0; m < 4; ++m) { bf16_t* rowp = out + (size_t)b * 1024 * 1024 + (size_t)(row0 + ai * HALF + m * 16) * 1024 + colt;
#pragma unroll
                for (int bj = 0; bj < 2; ++bj) { const f32x4 v0 = acc[ai][bj][m][0], v1 = acc[ai][bj][m][1];
                    *(u32x4*)(rowp + bj * HALF) = (u32x4){pk2(v0[0], v0[1]), pk2(v0[2], v0[3]), pk2(v1[0], v1[1]), pk2(v1[2], v1[3])}; } }
    }
};
struct ProbResLN : ProbBase {
    static constexpr bool PERM = false, AFTER = true;
    const float* xres; const float* lng; const float* lnb; float* xf; bf16_t* xb; float* stats; unsigned* cntp; size_t bstride;
    __device__ __forceinline__ const char* b_ptr(const Unit& u) const { return Bt + (size_t)(u.pm >> 4) * bstride + (size_t)u.pn * BM * ldb; }
    __device__ __forceinline__ void epi(const Acc&, const Unit&, int, int, int, int) const {}
    __device__ __forceinline__ void epi_after(Acc& acc, const Unit& u, int wr, int wc, int fr, int fq, LAS unsigned char* lds) const {
        const int tid = ltid();
        const int col0 = u.pn * BM + wc * 32 + 4 * fq;
        LAS float* red = (LAS float*)lds;
        LAS float* tab = (LAS float*)(lds + 8192);
#pragma unroll
        for (int ai = 0; ai < 2; ++ai)
#pragma unroll
            for (int m = 0; m < 4; ++m) { const int rowl = ai * HALF + wr * 64 + m * 16 + fr; const size_t ro = (size_t)(u.pm * BM + rowl) * DM + col0;
                float sv = 0.f, sq = 0.f;
#pragma unroll
                for (int bj = 0; bj < 2; ++bj)
#pragma unroll
                    for (int n = 0; n < 2; ++n) { const f32x4 xr = *(const f32x4*)(xres + ro + bj * HALF + n * 16); const f32x4 y = xr * ALPHA + acc[ai][bj][m][n]; acc[ai][bj][m][n] = y;
                        sv += (y[0] + y[1]) + (y[2] + y[3]); sq += (y[0] * y[0] + y[1] * y[1]) + (y[2] * y[2] + y[3] * y[3]); }
                sv += __shfl_xor(sv, 16); sv += __shfl_xor(sv, 32); sq += __shfl_xor(sq, 16); sq += __shfl_xor(sq, 32);
                if (fq == 0) { red[(rowl * 4 + wc) * 2] = sv; red[(rowl * 4 + wc) * 2 + 1] = sq; } }
        __syncthreads();
        if (tid < 256) { float S = 0.f, SS = 0.f;
#pragma unroll
            for (int w = 0; w < 4; ++w) { S += red[(tid * 4 + w) * 2]; SS += red[(tid * 4 + w) * 2 + 1]; }
            float* st = stats + ((size_t)(u.pm * 4 + u.pn) * 256 + tid) * 2; st[0] = S; st[1] = SS; }
        asm volatile("s_waitcnt vmcnt(0)" ::: "memory");
        __syncthreads();
        if (tid == 0) { unsigned* cw = cntp + u.pm;
            __builtin_amdgcn_fence(__ATOMIC_RELEASE, "agent"); asm volatile("s_waitcnt vmcnt(0)" ::: "memory");
            __hip_atomic_fetch_add(cw, 1u, __ATOMIC_RELAXED, __HIP_MEMORY_SCOPE_AGENT);
            while (__hip_atomic_load(cw, __ATOMIC_RELAXED, __HIP_MEMORY_SCOPE_AGENT) < 4u) __builtin_amdgcn_s_sleep(1);
            __builtin_amdgcn_fence(__ATOMIC_ACQUIRE, "agent"); asm volatile("s_waitcnt vmcnt(0)" ::: "memory"); }
        __syncthreads();
        if (tid < 256) { float S = 0.f, SS = 0.f;
#pragma unroll
            for (int w = 0; w < 4; ++w) { const float* st = stats + ((size_t)(u.pm * 4 + w) * 256 + tid) * 2;
                S += __hip_atomic_load(st, __ATOMIC_RELAXED, __HIP_MEMORY_SCOPE_AGENT); SS += __hip_atomic_load(st + 1, __ATOMIC_RELAXED, __HIP_MEMORY_SCOPE_AGENT); }
            const float mean = S * (1.f / DM), var = fmaxf(SS * (1.f / DM) - mean * mean, 0.f);
            tab[tid * 2] = mean; tab[tid * 2 + 1] = rsqrtf(var + LN_EPS); }
        __syncthreads();
        f32x4 gv[2][2], bv[2][2];
#pragma unroll
        for (int bj = 0; bj < 2; ++bj)
#pragma unroll
            for (int n = 0; n < 2; ++n) { gv[bj][n] = *(const f32x4*)(lng + col0 + bj * HALF + n * 16); bv[bj][n] = *(const f32x4*)(lnb + col0 + bj * HALF + n * 16); }
#pragma unroll
        for (int ai = 0; ai < 2; ++ai)
#pragma unroll
            for (int m = 0; m < 4; ++m) { const int rowl = ai * HALF + wr * 64 + m * 16 + fr; const size_t ro = (size_t)(u.pm * BM + rowl) * DM + col0;
                const float mean = tab[rowl * 2], rstd = tab[rowl * 2 + 1];
#pragma unroll
                for (int bj = 0; bj < 2; ++bj)
#pragma unroll
                    for (int n = 0; n < 2; ++n) { const f32x4 v = (acc[ai][bj][m][n] - mean) * rstd * gv[bj][n] + bv[bj][n];
                        *(f32x4*)(xf + ro + bj * HALF + n * 16) = v; *(u32x2*)(xb + ro + bj * HALF + n * 16) = (u32x2){pk2(v[0], v[1]), pk2(v[2], v[3])}; } }
        __syncthreads();
    }
};
template <int KK> struct ProbMerge {
    static constexpr bool PERM = false, GATHER = false, AFTER = false;
    const char* A; const char* Bt; static constexpr int K = KK, lda = 2048, ldb = 2048; int G, c;
    const bf16_t* p; bf16_t* mb;
    __device__ __forceinline__ bool next(int i, Unit& u) const { const int tile = (KK == 512 ? i : (i >> 1)) * G + c; if (tile >= 256) return false; u.pm = tile >> 2; u.pn = tile & 3; u.e = KK == 512 ? 0 : 1 + (i & 1); u.aux = 0; return true; }
    __device__ __forceinline__ const char* a_ptr(const Unit& u) const { return A + (size_t)u.pm * BM * lda + (KK == 512 ? 0 : 1024 + (u.e - 1) * 512); }
    __device__ __forceinline__ const char* b_ptr(const Unit& u) const { return Bt + (size_t)u.pn * BM * ldb + (KK == 512 ? 0 : 1024 + (u.e - 1) * 512); }
    __device__ __forceinline__ void gather_offs(const Unit&, int, unsigned (&)[2][2]) const {}
    __device__ __forceinline__ void epi(const Acc& acc, const Unit& u, int wr, int wc, int fr, int fq) const {
        const int row0 = u.pm * BM + wr * 64 + fr, col0 = u.pn * BM + wc * 32 + 4 * fq;
        const int gi = u.e;
        const bf16_t* __restrict__ mbr = mb; bf16_t* __restrict__ mbw = mb; const bf16_t* __restrict__ pr = p;
        u32x2 gr[2][2][2]; u32x2 pv[2][2][2];
#define MRG_LOAD(q, buf) do { const int row_ = row0 + ((q) >> 2) * HALF + ((q) & 3) * 16; const size_t ro_ = (size_t)row_ * DM + col0; \
            const bf16_t* gp_ = pr + (size_t)row_ * NP + COL_GATE + gi * 1024 + col0; \
            _Pragma("unroll") for (int bj = 0; bj < 2; ++bj) _Pragma("unroll") for (int n = 0; n < 2; ++n) { gr[buf][bj][n] = *(const u32x2*)(gp_ + bj * HALF + n * 16); \
                pv[buf][bj][n] = (KK != 512) ? *(const u32x2*)(mbr + ro_ + bj * HALF + n * 16) : (u32x2){0u, 0u}; } } while (0)
        MRG_LOAD(0, 0);
#pragma unroll
        for (int q = 0; q < 8; ++q) { const int ai = q >> 2, m = q & 3, buf = q & 1;
            if (q + 1 < 8) MRG_LOAD(q + 1, buf ^ 1);
            const int row = row0 + ai * HALF + m * 16; const size_t ro = (size_t)row * DM + col0;
#pragma unroll
            for (int bj = 0; bj < 2; ++bj)
#pragma unroll
                for (int n = 0; n < 2; ++n) { const u32x2 g2 = gr[buf][bj][n], p2 = pv[buf][bj][n];
                    f32x4 g; g[0] = sigmoid_f(bflo(g2[0])); g[1] = sigmoid_f(bfhi(g2[0])); g[2] = sigmoid_f(bflo(g2[1])); g[3] = sigmoid_f(bfhi(g2[1]));
                    const f32x4 v = g * acc[ai][bj][m][n] + (f32x4){bflo(p2[0]), bfhi(p2[0]), bflo(p2[1]), bfhi(p2[1])};
                    *(u32x2*)(mbw + ro + bj * HALF + n * 16) = (u32x2){pk2(v[0], v[1]), pk2(v[2], v[3])}; } }
#undef MRG_LOAD
    }
};
struct MoeOrder {
    int G, c, nN; const LAS int* tstart; const int* cnt;
    __device__ __forceinline__ bool next(int i, Unit& u) const {
        const int L = i * G + c; const int total = tstart[32] * nN; if (L >= total) return false;
        const int mt = L / nN; u.pn = L % nN; int e = 0;
        for (int k = 1; k < 32; ++k) e += (tstart[k] <= mt) ? 1 : 0;
        u.e = e; u.pm = mt; u.aux = (mt - tstart[e]) * BM; return true;
    }
};
__device__ __forceinline__ float swiglu_f(float g, float l) { g = fminf(g, 7.f); l = fminf(fmaxf(l, -7.f), 7.f); return g * sigmoid_f(1.702f * g) * (l + 1.f); }
struct ProbMoe1 : MoeOrder {
    static constexpr bool PERM = false, GATHER = true, AFTER = false;
    const char* A; const char* Bt; static constexpr int K = 1024, lda = 2048, ldb = 2048; const int* elist; const float* bgu; bf16_t* abuf;
    __device__ __forceinline__ const char* a_ptr(const Unit&) const { return A; }
    __device__ __forceinline__ const char* b_ptr(const Unit& u) const { return Bt + (size_t)u.e * 2048 * ldb + (size_t)u.pn * BM * ldb; }
    __device__ __forceinline__ void gather_offs(const Unit& u, int tid, unsigned (&off)[2][2]) const {
        const int n = cnt[u.e];
#pragma unroll
        for (int i = 0; i < 2; ++i) { int R, C; stage_rc(tid * 16 + i * 8192, R, C);
#pragma unroll
            for (int h = 0; h < 2; ++h) { const int rr = u.aux + h * HALF + R; const int tok = rr < n ? (elist[u.e * ECAP + rr] >> 2) : 0; off[h][i] = (unsigned)(tok * lda + C * 2); } }
    }
    __device__ __forceinline__ void epi(const Acc& acc, const Unit& u, int wr, int wc, int fr, int fq) const {
        const int row0 = u.pm * BM + wr * 64 + fr;
        const float* bb = bgu + (size_t)u.e * 2048;
#pragma unroll
        for (int bj = 0; bj < 2; ++bj) { const int g = u.pn * 8 + bj * 4 + wc; const int ac = 16 * g + 4 * fq;
            const f32x4 bg = *(const f32x4*)(bb + ac), bl = *(const f32x4*)(bb + 1024 + ac);
#pragma unroll
            for (int ai = 0; ai < 2; ++ai)
#pragma unroll
                for (int m = 0; m < 4; ++m) { const f32x4 vg = acc[ai][bj][m][0] + bg, vl = acc[ai][bj][m][1] + bl;
                    *(u32x2*)(abuf + (size_t)(row0 + ai * HALF + m * 16) * 1024 + ac) =
                        (u32x2){pk2(swiglu_f(vg[0], vl[0]), swiglu_f(vg[1], vl[1])), pk2(swiglu_f(vg[2], vl[2]), swiglu_f(vg[3], vl[3]))}; } }
    }
};
struct ProbMoe2 : MoeOrder {
    static constexpr bool PERM = false, GATHER = false, AFTER = false;
    const char* A; const char* Bt; static constexpr int K = 1024, lda = 2048, ldb = 2048; const int* elist; const float* bd; const float* tgate; bf16_t* ys;
    __device__ __forceinline__ const char* a_ptr(const Unit& u) const { return A + (size_t)u.pm * BM * lda; }
    __device__ __forceinline__ const char* b_ptr(const Unit& u) const { return Bt + (size_t)u.e * 1024 * ldb + (size_t)u.pn * BM * ldb; }
    __device__ __forceinline__ void gather_offs(const Unit&, int, unsigned (&)[2][2]) const {}
    __device__ __forceinline__ void epi(const Acc& acc, const Unit& u, int wr, int wc, int fr, int fq) const {
        const int n = cnt[u.e]; const int col0 = u.pn * BM + wc * 32 + 4 * fq;
        const float* bb = bd + (size_t)u.e * 1024 + col0;
        f32x4 bv[2][2];
#pragma unroll
        for (int bj = 0; bj < 2; ++bj)
#pragma unroll
            for (int nn = 0; nn < 2; ++nn) bv[bj][nn] = *(const f32x4*)(bb + bj * HALF + nn * 16);
        int aidx[2][4]; float gts[2][4];
#pragma unroll
        for (int ai = 0; ai < 2; ++ai)
#pragma unroll
            for (int m = 0; m < 4; ++m) { const int rr = u.aux + ai * HALF + wr * 64 + m * 16 + fr; aidx[ai][m] = (rr < n) ? elist[u.e * ECAP + rr] : -1; gts[ai][m] = (rr < n) ? tgate[u.e * ECAP + rr] : 0.f; }
#pragma unroll
        for (int ai = 0; ai < 2; ++ai)
#pragma unroll
            for (int m = 0; m < 4; ++m) {
                if (aidx[ai][m] >= 0) { const float g = gts[ai][m]; bf16_t* rowp = ys + (size_t)aidx[ai][m] * 1024 + col0;
#pragma unroll
                    for (int bj = 0; bj < 2; ++bj)
#pragma unroll
                        for (int nn = 0; nn < 2; ++nn) { const f32x4 v = (acc[ai][bj][m][nn] + bv[bj][nn]) * g;
                            *(u32x2*)(rowp + bj * HALF + nn * 16) = (u32x2){pk2(v[0], v[1]), pk2(v[2], v[3])}; } } }
    }
};

template <int MODE, int KK = 256> struct ProbAttn {
    static constexpr bool PERM = (MODE == 1), GATHER = false, AFTER = (MODE == 0);
    static constexpr int K = KK, lda = 2048, ldb = 2048;
    const char* A; const char* Bt; int G, c; float* sout; bf16_t* oout;
    __device__ __forceinline__ bool next(int i, Unit& u) const { const int L = i * G + c; if (L >= 256) return false; u.e = L >> 4; u.pm = L & 15; u.pn = 0; u.aux = 0; return true; }
    __device__ __forceinline__ const char* a_ptr(const Unit& u) const { const int b = u.e >> 2, h = u.e & 3; return A + ((size_t)(b * SEQL + u.pm * BM) * DM + (KK == 1024 ? 0 : h * 256)) * 2; }
    __device__ __forceinline__ const char* b_ptr(const Unit& u) const { const int b = u.e >> 2, h = u.e & 3;
        if (KK == 1024) return Bt + (size_t)u.e * 256 * 2048;
        return MODE == 0 ? Bt + ((size_t)(b * 256) * DM + h * 256) * 2 : Bt + ((size_t)b * 1024 * 1024 + (size_t)h * 256 * 1024) * 2; }
    __device__ __forceinline__ void gather_offs(const Unit&, int, unsigned (&)[2][2]) const {}
    __device__ __forceinline__ void epi_after(Acc& acc, const Unit& u, int wr, int wc, int fr, int fq, LAS unsigned char* lds) const {
        const int b = u.e >> 2, h = u.e & 3; const int grow0 = b * SEQL + u.pm * BM;
        LAS float* redm = (LAS float*)lds; LAS float* reds = (LAS float*)(lds + 4096);
#pragma unroll
        for (int ai = 0; ai < 2; ++ai)
#pragma unroll
            for (int m = 0; m < 4; ++m) { float v = -3e38f;
#pragma unroll
                for (int bj = 0; bj < 2; ++bj)
#pragma unroll
                    for (int n = 0; n < 2; ++n) v = fmaxf(v, fmaxf(fmaxf(acc[ai][bj][m][n][0], acc[ai][bj][m][n][1]), fmaxf(acc[ai][bj][m][n][2], acc[ai][bj][m][n][3])));
                v = fmaxf(v, __shfl_xor(v, 16)); v = fmaxf(v, __shfl_xor(v, 32));
                if (fq == 0) redm[(ai * HALF + wr * 64 + m * 16 + fr) * 4 + wc] = v; }
        __syncthreads();
#pragma unroll
        for (int ai = 0; ai < 2; ++ai)
#pragma unroll
            for (int m = 0; m < 4; ++m) { const int row = ai * HALF + wr * 64 + m * 16 + fr; const f32x4 r = *(const LAS f32x4*)(redm + row * 4);
                const float M = fmaxf(fmaxf(r[0], r[1]), fmaxf(r[2], r[3])); float sm = 0.f;
#pragma unroll
                for (int bj = 0; bj < 2; ++bj)
#pragma unroll
                    for (int n = 0; n < 2; ++n)
#pragma unroll
                        for (int j = 0; j < 4; ++j) { const float e = __expf((acc[ai][bj][m][n][j] - M) * 0.0625f); acc[ai][bj][m][n][j] = e; sm += e; }
                sm += __shfl_xor(sm, 16); sm += __shfl_xor(sm, 32);
                if (fq == 0) reds[row * 4 + wc] = sm; }
        __syncthreads();
#pragma unroll
        for (int ai = 0; ai < 2; ++ai)
#pragma unroll
            for (int m = 0; m < 4; ++m) { const int row = ai * HALF + wr * 64 + m * 16 + fr; const f32x4 r = *(const LAS f32x4*)(reds + row * 4);
                const float inv = __builtin_amdgcn_rcpf((r[0] + r[1]) + (r[2] + r[3]));
                bf16_t* rowp = oout + (size_t)(grow0 + row) * DM + h * 256 + wc * 32 + 4 * fq;
#pragma unroll
                for (int bj = 0; bj < 2; ++bj)
#pragma unroll
                    for (int n = 0; n < 2; ++n) { const f32x4 v = acc[ai][bj][m][n] * inv; *(u32x2*)(rowp + bj * HALF + n * 16) = (u32x2){pk2(v[0], v[1]), pk2(v[2], v[3])}; } }
        __syncthreads();
    }
    __device__ __forceinline__ void epi(const Acc& acc, const Unit& u, int wr, int wc, int fr, int fq) const {
        const int b = u.e >> 2, h = u.e & 3; const int row0 = b * SEQL + u.pm * BM + wr * 64 + fr;
        if (MODE == 0) { const int col0 = h * 256 + wc * 32 + 4 * fq;
#pragma unroll
            for (int ai = 0; ai < 2; ++ai)
#pragma unroll
                for (int m = 0; m < 4; ++m) { float* rowp = sout + (size_t)(row0 + ai * HALF + m * 16) * DM + col0;
#pragma unroll
                    for (int bj = 0; bj < 2; ++bj)
#pragma unroll
                        for (int n = 0; n < 2; ++n) *(f32x4*)(rowp + bj * HALF + n * 16) = acc[ai][bj][m][n] * 0.0625f; }
        } else { const int colt = h * 256 + wc * 32 + 8 * fq;
#pragma unroll
            for (int ai = 0; ai < 2; ++ai)
#pragma unroll
                for (int m = 0; m < 4; ++m) { bf16_t* rowp = oout + (size_t)(row0 + ai * HALF + m * 16) * DM + colt;
#pragma unroll
                    for (int bj = 0; bj < 2; ++bj) { const f32x4 v0 = acc[ai][bj][m][0], v1 = acc[ai][bj][m][1];
                        *(u32x4*)(rowp + bj * HALF) = (u32x4){pk2(v0[0], v0[1]), pk2(v0[2], v0[3]), pk2(v1[0], v1[1]), pk2(v1[2], v1[3])}; } }
        }
    }
};
__device__ __forceinline__ void phase_softmax(const Params& P) {
    const int tid = ltid(); const int lane = tid & 63, wid = __builtin_amdgcn_readfirstlane(tid >> 6); const int gw = blockIdx.x * 8 + wid, NGW = gridDim.x * 8;
    const float* S = (const float*)(P.ws + WS_MRGF); bf16_t* Pb = (bf16_t*)(P.ws + WS_QB);
    for (int r = gw; r < NTOK * 4; r += NGW) { const size_t o = (size_t)r * 256 + lane * 4;
        const f32x4 v = *(const f32x4*)(S + o);
        const float mx = wave_max(fmaxf(fmaxf(v[0], v[1]), fmaxf(v[2], v[3])));
        const float e0 = __expf(v[0] - mx), e1 = __expf(v[1] - mx), e2 = __expf(v[2] - mx), e3 = __expf(v[3] - mx);
        const float inv = 1.f / wave_sum((e0 + e1) + (e2 + e3));
        *(u32x2*)(Pb + o) = (u32x2){pk2(e0 * inv, e1 * inv), pk2(e2 * inv, e3 * inv)}; }
}

__device__ __forceinline__ void tr_item(const float* __restrict__ src, int ldn, int scol, int k0, bf16_t* dst0, int ldk, LAS unsigned char* wl, int lane) {
    float v[64];
    const bool valid = scol >= 0;
    const float* s = src + (size_t)k0 * ldn + (valid ? scol : 0);
#pragma unroll
    for (int kk = 0; kk < 64; ++kk) v[kk] = s[(size_t)kk * ldn];
#pragma unroll
    for (int c = 0; c < 8; ++c) { u32x4 w;
#pragma unroll
        for (int q = 0; q < 4; ++q) w[q] = valid ? pk2(v[8 * c + 2 * q], v[8 * c + 2 * q + 1]) : 0u;
        *(LAS u32x4*)(wl + lane * 144 + c * 16) = w; }
    WBAR();
#pragma unroll
    for (int it = 0; it < 8; ++it) { const int row = it * 8 + (lane >> 3), c16 = lane & 7; const u32x4 w = *(const LAS u32x4*)(wl + row * 144 + c16 * 16);
        *(u32x4*)(dst0 + (size_t)row * ldk + c16 * 8) = w; }
    WBAR();
}
__device__ __forceinline__ void row_to_bf16(const float* src, bf16_t* dst, int lane) {
#pragma unroll
    for (int j = 0; j < 4; ++j) { const f32x4 v = *(const f32x4*)(src + j * 256 + lane * 4); *(u32x2*)(dst + j * 256 + lane * 4) = (u32x2){pk2(v[0], v[1]), pk2(v[2], v[3])}; }
}
__device__ __forceinline__ void phase_convert(const Params& P, LAS unsigned char* lds) {
    const int tid = ltid(); const int lane = tid & 63, wid = __builtin_amdgcn_readfirstlane(tid >> 6);
    const int gw = blockIdx.x * 8 + wid, NGW = gridDim.x * 8;
    LAS unsigned char* wl = lds + wid * 9216;
    unsigned char* ws = P.ws;
    constexpr int I_WIN = 16 * 88, I_SQ = 256, I_GU = 32 * 512, I_D = 32 * 256, I_L = I_WIN + 6 * I_SQ + I_GU + I_D;
    for (int it = gw; it < 2 * I_L; it += NGW) {
        const int l = it / I_L; int r = it % I_L;
        if (r < I_WIN) { const int ntl = r % 88, kt = r / 88; const int n = ntl * 64 + lane;
            const int sc = n < COL_UV ? n : (n < COL_GL ? n + 16 : (n < NIN ? n - COL_GL + COL_UV : -1));
            tr_item(P.in[2] + (size_t)l * 1024 * NIN, NIN, sc, kt * 64, (bf16_t*)(ws + WS_WIN + l * SZ_WIN) + (size_t)ntl * 64 * 1024 + kt * 64, 1024, wl, lane); continue; }
        r -= I_WIN;
        if (r < I_SQ) {
            const int ntl = r % 16, kt = r / 16; const float* src; int kk;
            if (kt < 8) { src = P.in[13] + (size_t)l * 512 * 1024; kk = kt; } else if (kt < 12) { src = P.in[14] + (size_t)l * 256 * 1024; kk = kt - 8; } else { src = P.in[15] + (size_t)l * 256 * 1024; kk = kt - 12; }
            tr_item(src, 1024, ntl * 64 + lane, kk * 64, (bf16_t*)(ws + WS_WUP + l * SZ_SQ) + (size_t)ntl * 64 * 1024 + kt * 64, 1024, wl, lane); continue; }
        r -= I_SQ;
        if (r < 5 * I_SQ) { const int w = r / I_SQ; const int rr = r % I_SQ; const int ntl = rr % 16, kt = rr / 16;
            const int ii = w == 0 ? 16 : 18 + w;
            const size_t wso = w == 0 ? WS_WO : (w == 1 ? WS_OB : (w == 2 ? WS_WK : (w == 3 ? WS_WV : WS_WXO)));
            tr_item(P.in[ii] + (size_t)l * 1024 * 1024, 1024, ntl * 64 + lane, kt * 64, (bf16_t*)(ws + wso + l * SZ_SQ) + (size_t)ntl * 64 * 1024 + kt * 64, 1024, wl, lane); continue; }
        r -= 5 * I_SQ;
        if (r < I_GU) { const int e = r / 512; const int rr = r % 512; const int ntl = rr % 32, kt = rr / 32; const int n = ntl * 64 + lane; const int g = n >> 5, w = n & 31;
            const int sc = w < 16 ? 16 * g + w : 1024 + 16 * g + (w - 16);
            tr_item(P.in[27] + ((size_t)l * 32 + e) * 1024 * 2048, 2048, sc, kt * 64, (bf16_t*)(ws + WS_WGU + l * SZ_WGU) + ((size_t)e * 2048 + ntl * 64) * 1024 + kt * 64, 1024, wl, lane); continue; }
        r -= I_GU;
        { const int e = r / 256; const int rr = r % 256; const int ntl = rr % 16, kt = rr / 16;
            tr_item(P.in[29] + ((size_t)l * 32 + e) * 1024 * 1024, 1024, ntl * 64 + lane, kt * 64, (bf16_t*)(ws + WS_WD + l * SZ_WD) + ((size_t)e * 1024 + ntl * 64) * 1024 + kt * 64, 1024, wl, lane); }
    }
    for (int m = gw; m < NTOK + 1024 + 2048; m += NGW) {
        if (m < NTOK) row_to_bf16(P.in[0] + (size_t)m * DM, (bf16_t*)(ws + WS_XB) + (size_t)m * DM, lane);
        else if (m >= NTOK + 1024) row_to_bf16(P.in[19] + (size_t)(m - NTOK - 1024) * DM, (bf16_t*)(ws + WS_WQ) + (size_t)(m - NTOK - 1024) * DM, lane);
        else row_to_bf16(P.in[1] + (size_t)(m - NTOK) * DM, (bf16_t*)(ws + WS_MEMB) + (size_t)(m - NTOK) * DM, lane);
    }
}

__device__ __forceinline__ bf16x8 ldfrag(const LAS bf16_t* base, int row, int stride, int k) { return *(const LAS bf16x8*)(base + row * stride + k); }

__device__ __forceinline__ void sgu_item(const Params& P, int l, int item, LAS unsigned char* lds) {
    const int tid = ltid(), lane = tid & 63, wid = tid >> 6, fr = lane & 15, fq = lane >> 4;
    const bf16_t* p = (const bf16_t*)(P.ws + WS_P); bf16_t* ycat = (bf16_t*)(P.ws + WS_YCAT);
    const int t0 = item * 128;
    LAS bf16_t* vnT = (LAS bf16_t*)lds;
    LAS bf16_t* wsb = (LAS bf16_t*)(lds + 69632);
    LAS float* red = (LAS float*)(lds + 69632 + 34816);
    {
        const int t = tid & 127, qd = tid >> 7;
        const bf16_t* src = p + (size_t)(t0 + t) * NP + COL_UV + 256 + qd * 64;
        float s = 0.f, ss = 0.f;
#pragma unroll
        for (int c = 0; c < 8; ++c) { const u32x4 w = *(const u32x4*)(src + c * 8);
#pragma unroll
            for (int q = 0; q < 4; ++q) { const float a = gelu_f(bflo(w[q])), b = gelu_f(bfhi(w[q])); s += a + b; ss += a * a + b * b; } }
        red[(t * 4 + qd) * 2] = s; red[(t * 4 + qd) * 2 + 1] = ss;
        __syncthreads();
        float S = 0.f, SS = 0.f;
#pragma unroll
        for (int q = 0; q < 4; ++q) { S += red[(t * 4 + q) * 2]; SS += red[(t * 4 + q) * 2 + 1]; }
        const float mean = S * (1.f / 256.f), var = fmaxf(SS * (1.f / 256.f) - mean * mean, 0.f), rstd = rsqrtf(var + LN_EPS);
        const float* lg = P.in[7] + l * 256 + qd * 64; const float* lb = P.in[8] + l * 256 + qd * 64;
#pragma unroll 2
        for (int c = 0; c < 8; ++c) { const u32x4 w = *(const u32x4*)(src + c * 8);
#pragma unroll
            for (int q = 0; q < 4; ++q) { const float a = gelu_f(bflo(w[q])), b = gelu_f(bfhi(w[q])); const int ch = c * 8 + 2 * q;
                vnT[(qd * 64 + ch) * 136 + t] = f2bf((a - mean) * rstd * lg[ch] + lb[ch]);
                vnT[(qd * 64 + ch + 1) * 136 + t] = f2bf((b - mean) * rstd * lg[ch + 1] + lb[ch + 1]); } }
    }
    for (int g = 0; g < 4; ++g) {
        __syncthreads();
        const float* wsg = P.in[9] + ((size_t)l * 4 + g) * 128 * 128;
#pragma unroll
        for (int i = 0; i < 4; ++i) { const int id = tid + i * 512; const int t = id >> 4, s8 = (id & 15) * 8;
            const f32x4 a = *(const f32x4*)(wsg + t * 128 + s8), b = *(const f32x4*)(wsg + t * 128 + s8 + 4);
            float w[8] = {a[0], a[1], a[2], a[3], b[0], b[1], b[2], b[3]};
#pragma unroll
            for (int q = 0; q < 8; ++q) w[q] = (s8 + q <= t) ? w[q] : 0.f;
            *(LAS u32x4*)(wsb + t * 136 + s8) = (u32x4){pk2(w[0], w[1]), pk2(w[2], w[3]), pk2(w[4], w[5]), pk2(w[6], w[7])}; }
        __syncthreads();
#pragma unroll
        for (int q = 0; q < 4; ++q) { const int tile = wid * 4 + q; const int ti = tile >> 2, di = tile & 3;
            f32x4 acc = {0.f, 0.f, 0.f, 0.f};
            const int ksmax = (ti * 16 + 15) >> 5;
            for (int ks = 0; ks <= ksmax; ++ks) {
                const bf16x8 a = ldfrag(wsb, ti * 16 + fr, 136, ks * 32 + 8 * fq), b = ldfrag(vnT, g * 64 + di * 16 + fr, 136, ks * 32 + 8 * fq);
                acc = __builtin_amdgcn_mfma_f32_16x16x32_bf16(a, b, acc, 0, 0, 0); }
            const int ch = g * 64 + di * 16 + fr;
#pragma unroll
            for (int j = 0; j < 4; ++j) { const int t = ti * 16 + 4 * fq + j;
                const float sv = acc[j] + P.in[10][((size_t)l * 4 + g) * 128 + t];
                const float u = gelu_f(bf2f(p[(size_t)(t0 + t) * NP + COL_UV + ch]));
                ycat[(size_t)(t0 + t) * DM + 512 + ch] = f2bf(u * sv); } }
    }
    __syncthreads();
}

__device__ __forceinline__ void gla1_item(const Params& P, int l, int idx, LAS unsigned char* lds) {
    const int tid = ltid();
    const bf16_t* p = (const bf16_t*)(P.ws + WS_P);
    float* bcum = (float*)(P.ws + WS_BCUM); float* kvT = (float*)(P.ws + WS_KVT); float* cdec = (float*)(P.ws + WS_CDEC);
    const int h = idx & 3, bn = idx >> 2; const int t0 = bn * 64;
    LAS float* gl = (LAS float*)lds;
    LAS float* tot = (LAS float*)(lds + 4096);
    LAS float* kt = (LAS float*)(lds + 8192);
    LAS float* vs = (LAS float*)(lds + 8192 + 16384);
#pragma unroll
    for (int i = 0; i < 2; ++i) { const int id = tid + i * 512; gl[id] = bf2f(p[(size_t)(t0 + (id >> 4)) * NP + COL_GL + (id & 15)]); }
#pragma unroll
    for (int i = 0; i < 2; ++i) { const int id = tid + i * 512; const int t = id >> 4, e8 = (id & 15) * 8;
        const u32x4 w = *(const u32x4*)(p + (size_t)(t0 + t) * NP + COL_V + h * 128 + e8);
        *(LAS f32x4*)(vs + t * 128 + e8) = (f32x4){bflo(w[0]), bfhi(w[0]), bflo(w[1]), bfhi(w[1])};
        *(LAS f32x4*)(vs + t * 128 + e8 + 4) = (f32x4){bflo(w[2]), bfhi(w[2]), bflo(w[3]), bfhi(w[3])}; }
    __syncthreads();
    {
        const int tq = tid >> 6, d = tid & 63;
        float wreg[16];
#pragma unroll
        for (int r = 0; r < 16; ++r) wreg[r] = P.in[4][((size_t)l * 16 + r) * 256 + h * 64 + d];
        const float bgv = P.in[5][l * 256 + h * 64 + d];
        float pre[8]; float run = 0.f;
#pragma unroll
        for (int i = 0; i < 8; ++i) { const int t = tq * 8 + i; float z = bgv;
#pragma unroll
            for (int r = 0; r < 16; ++r) z += gl[t * 16 + r] * wreg[r];
            const float ls = fminf(z, 0.f) - log1pf(__expf(-fabsf(z)));
            run += ls * (1.f / 16.f); pre[i] = run; }
        tot[tq * 64 + d] = run;
        __syncthreads();
        float off = 0.f, total = 0.f;
#pragma unroll
        for (int g = 0; g < 8; ++g) { const float x = tot[g * 64 + d]; total += x; off += (g < tq) ? x : 0.f; }
#pragma unroll
        for (int i = 0; i < 8; ++i) { const int t = tq * 8 + i; const float bv = off + pre[i];
            bcum[(size_t)(t0 + t) * 256 + h * 64 + d] = bv;
            kt[t * 64 + d] = bf2f(p[(size_t)(t0 + t) * NP + COL_K + h * 64 + d]) * __expf(total - bv); }
        if (tq == 0) cdec[idx * 64 + d] = __expf(total);
    }
    __syncthreads();
    {
        const int d4 = tid & 15, e4 = tid >> 4;
        f32x4 a0 = {0.f, 0.f, 0.f, 0.f}, a1 = a0, a2 = a0, a3 = a0;
        for (int t = 0; t < 64; ++t) { const f32x4 kv = *(const LAS f32x4*)(kt + t * 64 + 4 * d4), vv = *(const LAS f32x4*)(vs + t * 128 + 4 * e4);
            a0 += kv * vv[0]; a1 += kv * vv[1]; a2 += kv * vv[2]; a3 += kv * vv[3]; }
        float* o = kvT + (size_t)idx * 8192 + (4 * e4) * 64 + 4 * d4;
        *(f32x4*)(o) = a0; *(f32x4*)(o + 64) = a1; *(f32x4*)(o + 128) = a2; *(f32x4*)(o + 192) = a3;
    }
    __syncthreads();
}

__device__ __forceinline__ void pool_item(const Params& P, int l, int item, LAS unsigned char* lds) {
    const int tid = ltid(), lane = tid & 63, wid = tid >> 6, fr = lane & 15, fq = lane >> 4;
    const bf16_t* p = (const bf16_t*)(P.ws + WS_P); bf16_t* ycat = (bf16_t*)(P.ws + WS_YCAT);
    const int T0 = item * 64, pos0 = T0 & (SEQL - 1);
    LAS bf16_t* xs = (LAS bf16_t*)lds;
    LAS bf16_t* ybf = (LAS bf16_t*)(lds + 42240);
    LAS bf16_t* pwT = (LAS bf16_t*)(lds + 42240 + 33792);
#pragma unroll
    for (int i = 0; i < 5; ++i) { const int id = tid + i * 512; const int r = id >> 5, c8 = (id & 31) * 8;
        u32x4 w = {0u, 0u, 0u, 0u};
        if (pos0 - 16 + r >= 0) w = *(const u32x4*)(p + (size_t)(T0 - 16 + r) * NP + COL_XC + c8);
        *(LAS u32x4*)(xs + r * 264 + c8) = w; }
    const float* pw = P.in[11] + (size_t)l * 4 * 64 * 64;
#pragma unroll 4
    for (int i = 0; i < 32; ++i) { const int id = tid + i * 512; const int g = id >> 12, c = (id >> 6) & 63, dd = id & 63; pwT[(g * 64 + dd) * 72 + c] = f2bf(pw[id]); }
    __syncthreads();
    {
        const int ch = tid & 255, th = tid >> 8; const int gi = ch >> 6, w = 2 << gi;
        float sum = 0.f;
        for (int j = 1; j < w; ++j) sum += bf2f(xs[(16 + th * 32 - j) * 264 + ch]);
        for (int tt = 0; tt < 32; ++tt) { const int t = th * 32 + tt; const float x = bf2f(xs[(16 + t) * 264 + ch]);
            sum += x; const int pos = pos0 + t; const float cntf = (float)min(pos + 1, w);
            ybf[t * 264 + ch] = f2bf(sum / cntf - x);
            sum -= bf2f(xs[(16 + t - w + 1) * 264 + ch]); }
    }
    __syncthreads();
#pragma unroll
    for (int q = 0; q < 8; ++q) { const int tile = wid * 8 + q; const int g = tile >> 4, ti = (tile >> 2) & 3, di = tile & 3;
        f32x4 acc = {0.f, 0.f, 0.f, 0.f};
#pragma unroll
        for (int ks = 0; ks < 2; ++ks) { const bf16x8 a = ldfrag(ybf, ti * 16 + fr, 264, g * 64 + ks * 32 + 8 * fq), b = ldfrag(pwT, g * 64 + di * 16 + fr, 72, ks * 32 + 8 * fq);
            acc = __builtin_amdgcn_mfma_f32_16x16x32_bf16(a, b, acc, 0, 0, 0); }
        const int ch = g * 64 + di * 16 + fr; const float sc = P.in[12][l * 256 + ch];
#pragma unroll
        for (int j = 0; j < 4; ++j) ycat[(size_t)(T0 + ti * 16 + 4 * fq + j) * DM + 768 + ch] = f2bf(acc[j] * sc); }
    __syncthreads();
}

__device__ __forceinline__ void phase_mixer_local(const Params& P, int l, LAS unsigned char* lds) {
    constexpr int N_SGU = 128, N_GLA = 1024, N_POOL = 256;
    if (gridDim.x == 256) {
        const int b = blockIdx.x; int first, cntn;
        if (b < N_SGU) { sgu_item(P, l, b, lds); first = b * 3; cntn = 3; } else { first = 384 + (b - N_SGU) * 7; cntn = 7; }
        for (int k = 0; k < cntn; ++k) { const int it = first + k; if (it < N_GLA) gla1_item(P, l, it, lds); else pool_item(P, l, it - N_GLA, lds); }
        return;
    }
    for (int it = blockIdx.x; it < N_SGU + N_GLA + N_POOL; it += gridDim.x) {
        if (it < N_SGU) sgu_item(P, l, it, lds);
        else if (it < N_SGU + N_GLA) gla1_item(P, l, it - N_SGU, lds);
        else pool_item(P, l, it - N_SGU - N_GLA, lds);
    }
}

__device__ __forceinline__ void phase_scan(const Params& P) {
    const float* kvT = (const float*)(P.ws + WS_KVT); const float* cdec = (const float*)(P.ws + WS_CDEC); bf16_t* sT = (bf16_t*)(P.ws + WS_ST);
    for (int g = blockIdx.x * 512 + ltid(); g < 16 * 8192; g += gridDim.x * 512) {
        const int bh = g >> 13, ed = g & 8191, d = ed & 63, b = bh >> 2, h = bh & 3;
        float S = 0.f;
#pragma unroll 8
        for (int n = 0; n < 64; ++n) { const int ci = (b * 64 + n) * 4 + h;
            sT[(size_t)ci * 8192 + ed] = f2bf(S);
            S = cdec[ci * 64 + d] * S + kvT[(size_t)ci * 8192 + ed]; }
    }
}

struct G2R { u32x4 qw, kw, vw0, vw1, sw0, sw1, r0, r1; f32x4 b0, b1; };
__device__ __forceinline__ void gla2_load(const Params& P, int idx, int tid, G2R& r) {
    const bf16_t* p = (const bf16_t*)(P.ws + WS_P); const float* bcum = (const float*)(P.ws + WS_BCUM); const bf16_t* sT = (const bf16_t*)(P.ws + WS_ST);
    const int h = idx & 3, bn = idx >> 2; const int t0 = bn * 64;
    const int t = tid >> 3, c8 = (tid & 7) * 8;
    r.qw = *(const u32x4*)(p + (size_t)(t0 + t) * NP + h * 64 + c8); r.kw = *(const u32x4*)(p + (size_t)(t0 + t) * NP + COL_K + h * 64 + c8);
    r.b0 = *(const f32x4*)(bcum + (size_t)(t0 + t) * 256 + h * 64 + c8); r.b1 = *(const f32x4*)(bcum + (size_t)(t0 + t) * 256 + h * 64 + c8 + 4);
    { const int id = tid; const int tt = id >> 4, e8 = (id & 15) * 8; r.vw0 = *(const u32x4*)(p + (size_t)(t0 + tt) * NP + COL_V + h * 128 + e8); }
    { const int id = tid + 512; const int tt = id >> 4, e8 = (id & 15) * 8; r.vw1 = *(const u32x4*)(p + (size_t)(t0 + tt) * NP + COL_V + h * 128 + e8); }
    { const int id = tid; const int e = id >> 3, d8 = (id & 7) * 8; r.sw0 = *(const u32x4*)(sT + (size_t)idx * 8192 + e * 64 + d8); }
    { const int id = tid + 512; const int e = id >> 3, d8 = (id & 7) * 8; r.sw1 = *(const u32x4*)(sT + (size_t)idx * 8192 + e * 64 + d8); }
    { const int seg = tid & 7; const bf16_t* rp = p + (size_t)(t0 + t) * NP + COL_R + h * 128 + seg * 16; r.r0 = *(const u32x4*)rp; r.r1 = *(const u32x4*)(rp + 8); }
}
__device__ __forceinline__ void gla2_item(const Params& P, int l, int idx, int nidx, const G2R& R, G2R& RN, LAS unsigned char* lds) {
    const int tid = ltid(), lane = tid & 63, wid = tid >> 6, fr = lane & 15, fq = lane >> 4;
    bf16_t* ycat = (bf16_t*)(P.ws + WS_YCAT);
    const int h = idx & 3, bn = idx >> 2; const int t0 = bn * 64;
    LAS bf16_t* qd = (LAS bf16_t*)lds;
    LAS bf16_t* kd = (LAS bf16_t*)(lds + 9216);
    LAS bf16_t* vT = (LAS bf16_t*)(lds + 18432);
    LAS bf16_t* Ps = (LAS bf16_t*)(lds + 36864);
    LAS bf16_t* sTs = (LAS bf16_t*)(lds + 46080);
    LAS float* of = (LAS float*)(lds + 64512);
    {
        const int t = tid >> 3, c8 = (tid & 7) * 8;
        const u32x4 qw = R.qw, kw = R.kw; const f32x4 b0 = R.b0, b1 = R.b1;
        float bb[8] = {b0[0], b0[1], b0[2], b0[3], b1[0], b1[1], b1[2], b1[3]}; float qv[8], kv[8];
#pragma unroll
        for (int q = 0; q < 4; ++q) { qv[2 * q] = bflo(qw[q]); qv[2 * q + 1] = bfhi(qw[q]); kv[2 * q] = bflo(kw[q]); kv[2 * q + 1] = bfhi(kw[q]); }
#pragma unroll
        for (int q = 0; q < 8; ++q) { const float e = __expf(bb[q]); qv[q] = qv[q] * 0.125f * e; kv[q] = kv[q] * __expf(-bb[q]); }
        *(LAS u32x4*)(qd + t * 72 + c8) = (u32x4){pk2(qv[0], qv[1]), pk2(qv[2], qv[3]), pk2(qv[4], qv[5]), pk2(qv[6], qv[7])};
        *(LAS u32x4*)(kd + t * 72 + c8) = (u32x4){pk2(kv[0], kv[1]), pk2(kv[2], kv[3]), pk2(kv[4], kv[5]), pk2(kv[6], kv[7])};
#pragma unroll
        for (int i = 0; i < 2; ++i) { const int id = tid + i * 512; const int tt = id >> 4, e8 = (id & 15) * 8;
            const u32x4 w = i == 0 ? R.vw0 : R.vw1;
#pragma unroll
            for (int q = 0; q < 4; ++q) { vT[(e8 + 2 * q) * 72 + tt] = (bf16_t)(w[q] & 0xffffu); vT[(e8 + 2 * q + 1) * 72 + tt] = (bf16_t)(w[q] >> 16); } }
#pragma unroll
        for (int i = 0; i < 2; ++i) { const int id = tid + i * 512; const int e = id >> 3, d8 = (id & 7) * 8;
            *(LAS u32x4*)(sTs + e * 72 + d8) = i == 0 ? R.sw0 : R.sw1; }
    }
    __syncthreads();
    if (nidx >= 0) gla2_load(P, nidx, tid, RN);
#pragma unroll
    for (int q = 0; q < 2; ++q) { const int tile = wid * 2 + q; const int ti = tile >> 2, si = tile & 3;
        f32x4 acc = {0.f, 0.f, 0.f, 0.f};
        if (si <= ti) {
#pragma unroll
            for (int ks = 0; ks < 2; ++ks) { const bf16x8 a = ldfrag(qd, ti * 16 + fr, 72, ks * 32 + 8 * fq), b = ldfrag(kd, si * 16 + fr, 72, ks * 32 + 8 * fq);
                acc = __builtin_amdgcn_mfma_f32_16x16x32_bf16(a, b, acc, 0, 0, 0); } }
        const int s = si * 16 + fr;
#pragma unroll
        for (int j = 0; j < 4; ++j) { const int t = ti * 16 + 4 * fq + j; Ps[t * 72 + s] = f2bf(s <= t ? acc[j] : 0.f); } }
    __syncthreads();
#pragma unroll
    for (int q = 0; q < 4; ++q) { const int tile = wid * 4 + q; const int ti = tile >> 3, ei = tile & 7;
        f32x4 acc = {0.f, 0.f, 0.f, 0.f};
#pragma unroll
        for (int ks = 0; ks < 2; ++ks) { const bf16x8 a = ldfrag(Ps, ti * 16 + fr, 72, ks * 32 + 8 * fq), b = ldfrag(vT, ei * 16 + fr, 72, ks * 32 + 8 * fq);
            acc = __builtin_amdgcn_mfma_f32_16x16x32_bf16(a, b, acc, 0, 0, 0); }
#pragma unroll
        for (int ks = 0; ks < 2; ++ks) { const bf16x8 a = ldfrag(qd, ti * 16 + fr, 72, ks * 32 + 8 * fq), b = ldfrag(sTs, ei * 16 + fr, 72, ks * 32 + 8 * fq);
            acc = __builtin_amdgcn_mfma_f32_16x16x32_bf16(a, b, acc, 0, 0, 0); }
#pragma unroll
        for (int j = 0; j < 4; ++j) of[(ti * 16 + 4 * fq + j) * 132 + ei * 16 + fr] = acc[j]; }
    __syncthreads();
    {
        const int t = tid >> 3, seg = tid & 7;
        float o[16]; float ss = 0.f;
#pragma unroll
        for (int q = 0; q < 4; ++q) { const f32x4 v = *(const LAS f32x4*)(of + t * 132 + seg * 16 + 4 * q); o[4 * q] = v[0]; o[4 * q + 1] = v[1]; o[4 * q + 2] = v[2]; o[4 * q + 3] = v[3]; ss += v[0] * v[0] + v[1] * v[1] + v[2] * v[2] + v[3] * v[3]; }
        ss += __shfl_xor(ss, 1); ss += __shfl_xor(ss, 2); ss += __shfl_xor(ss, 4);
        const float rstd = rsqrtf(ss * (1.f / 128.f) + LN_EPS);
        const float* gn = P.in[6] + l * 512 + h * 128 + seg * 16;
        const u32x4 r0 = R.r0, r1 = R.r1;
        float rv[16];
#pragma unroll
        for (int q = 0; q < 4; ++q) { rv[2 * q] = bflo(r0[q]); rv[2 * q + 1] = bfhi(r0[q]); rv[8 + 2 * q] = bflo(r1[q]); rv[8 + 2 * q + 1] = bfhi(r1[q]); }
        float y[16];
#pragma unroll
        for (int q = 0; q < 16; ++q) y[q] = o[q] * rstd * gn[q] * (rv[q] * sigmoid_f(rv[q]));
        bf16_t* yo = ycat + (size_t)(t0 + t) * DM + h * 128 + seg * 16;
        *(u32x4*)yo = (u32x4){pk2(y[0], y[1]), pk2(y[2], y[3]), pk2(y[4], y[5]), pk2(y[6], y[7])};
        *(u32x4*)(yo + 8) = (u32x4){pk2(y[8], y[9]), pk2(y[10], y[11]), pk2(y[12], y[13]), pk2(y[14], y[15])};
    }
    __syncthreads();
}

__device__ __forceinline__ void attn_item(const Params& P, int l, int item, LAS unsigned char* lds) {
    const int tid = ltid(), lane = tid & 63, wid = tid >> 6, fr = lane & 15, fq = lane >> 4;
    const int qt = item & 31, h = (item >> 5) & 3, b = item >> 7;
    const bf16_t* qb = (const bf16_t*)(P.ws + WS_QB) + (size_t)(b * SEQL + qt * 128) * DM + h * 256;
    const bf16_t* km = (const bf16_t*)(P.ws + WS_KM + l * SZ_SQ) + (size_t)(b * 256) * DM + h * 256;
    const bf16_t* vt = (const bf16_t*)(P.ws + WS_VT + l * SZ_SQ) + ((size_t)b * 1024 + h * 256) * 256;
    bf16_t* ob = (bf16_t*)(P.ws + WS_OB) + (size_t)(b * SEQL + qt * 128) * DM + h * 256;
    LAS bf16_t* QP = (LAS bf16_t*)lds;
    LAS bf16_t* KV = (LAS bf16_t*)(lds + 67584);
#pragma unroll
    for (int i = 0; i < 8; ++i) { const int id = tid + i * 512; const int r = id >> 5, c8 = (id & 31) * 8; *(LAS u32x4*)(QP + r * 264 + c8) = *(const u32x4*)(qb + (size_t)r * DM + c8); }
    u32x4 pre[4];
#pragma unroll
    for (int i = 0; i < 4; ++i) { const int id = tid + i * 512; const int r = id >> 5, c8 = (id & 31) * 8; pre[i] = *(const u32x4*)(km + (size_t)r * DM + c8); }
#pragma unroll
    for (int i = 0; i < 4; ++i) { const int id = tid + i * 512; const int r = id >> 5, c8 = (id & 31) * 8; *(LAS u32x4*)(KV + r * 264 + c8) = pre[i]; }
    __syncthreads();
#ifdef ATT_DBG0
    {
#if ATT_DBG0 == 1
#pragma unroll
    for (int i = 0; i < 8; ++i) { const int id = tid + i * 512; const int r = id >> 5, c8 = (id & 31) * 8; *(u32x4*)(ob + (size_t)r * DM + c8) = *(const LAS u32x4*)(QP + r * 264 + c8); }
#else
#pragma unroll
    for (int i = 0; i < 4; ++i) { const int id = tid + i * 512; const int r = id >> 5, c8 = (id & 31) * 8; *(u32x4*)(ob + (size_t)r * DM + c8) = *(const LAS u32x4*)(KV + r * 264 + c8); *(u32x4*)(ob + (size_t)(r + 64) * DM + c8) = *(const LAS u32x4*)(KV + r * 264 + c8); }
#endif
    __syncthreads(); return; }
#endif
    bf16x8 aq[8];
#pragma unroll
    for (int ks = 0; ks < 8; ++ks) aq[ks] = ldfrag(QP, wid * 16 + fr, 264, ks * 32 + 8 * fq);
    f32x4 acc[16];
#pragma unroll
    for (int i = 0; i < 16; ++i) acc[i] = (f32x4){0.f, 0.f, 0.f, 0.f};
#pragma unroll
    for (int c = 0; c < 4; ++c) {
#pragma unroll
        for (int kt = 0; kt < 4; ++kt)
#pragma unroll
            for (int ks = 0; ks < 8; ++ks) acc[c * 4 + kt] = __builtin_amdgcn_mfma_f32_16x16x32_bf16(aq[ks], ldfrag(KV, kt * 16 + fr, 264, ks * 32 + 8 * fq), acc[c * 4 + kt], 0, 0, 0);
        __syncthreads();
#pragma unroll
        for (int i = 0; i < 4; ++i) { const int id = tid + i * 512; const int r = id >> 5, c8 = (id & 31) * 8;
            *(LAS u32x4*)(KV + r * 264 + c8) = (c < 3) ? *(const u32x4*)(km + (size_t)((c + 1) * 64 + r) * DM + c8) : *(const u32x4*)(vt + (size_t)r * 256 + c8); }
        __syncthreads();
    }
#ifdef ATT_DBG1
    {
#pragma unroll
    for (int i = 0; i < 16; ++i)
#pragma unroll
        for (int j = 0; j < 4; ++j) ob[(size_t)(wid * 16 + 4 * fq + j) * DM + i * 16 + fr] = f2bf(acc[i][j]);
    return; }
#endif
#pragma unroll
    for (int j = 0; j < 4; ++j) {
        float mx = -1e30f;
#pragma unroll
        for (int i = 0; i < 16; ++i) mx = fmaxf(mx, acc[i][j]);
        mx = fmaxf(mx, __shfl_xor(mx, 1)); mx = fmaxf(mx, __shfl_xor(mx, 2)); mx = fmaxf(mx, __shfl_xor(mx, 4)); mx = fmaxf(mx, __shfl_xor(mx, 8));
        float sm = 0.f;
#pragma unroll
        for (int i = 0; i < 16; ++i) { const float e = __expf((acc[i][j] - mx) * 0.0625f); acc[i][j] = e; sm += e; }
        sm += __shfl_xor(sm, 1); sm += __shfl_xor(sm, 2); sm += __shfl_xor(sm, 4); sm += __shfl_xor(sm, 8);
        const float inv = 1.f / sm;
#pragma unroll
        for (int i = 0; i < 16; ++i) QP[(wid * 16 + 4 * fq + j) * 264 + i * 16 + fr] = f2bf(acc[i][j] * inv);
    }
    WBAR();
#pragma unroll
    for (int ks = 0; ks < 8; ++ks) aq[ks] = ldfrag(QP, wid * 16 + fr, 264, ks * 32 + 8 * fq);
#pragma unroll
    for (int i = 0; i < 16; ++i) acc[i] = (f32x4){0.f, 0.f, 0.f, 0.f};
#pragma unroll
    for (int c = 0; c < 4; ++c) {
#pragma unroll
        for (int dt = 0; dt < 4; ++dt)
#pragma unroll
            for (int ks = 0; ks < 8; ++ks) acc[c * 4 + dt] = __builtin_amdgcn_mfma_f32_16x16x32_bf16(aq[ks], ldfrag(KV, dt * 16 + fr, 264, ks * 32 + 8 * fq), acc[c * 4 + dt], 0, 0, 0);
        __syncthreads();
        if (c < 3) {
#pragma unroll
            for (int i = 0; i < 4; ++i) { const int id = tid + i * 512; const int r = id >> 5, c8 = (id & 31) * 8; *(LAS u32x4*)(KV + r * 264 + c8) = *(const u32x4*)(vt + (size_t)((c + 1) * 64 + r) * 256 + c8); } }
        __syncthreads();
    }
#pragma unroll
    for (int i = 0; i < 16; ++i)
#pragma unroll
        for (int j = 0; j < 4; ++j) ob[(size_t)(wid * 16 + 4 * fq + j) * DM + i * 16 + fr] = f2bf(acc[i][j]);
}

__device__ __forceinline__ void ln_core(f32x4 (&v)[4], const float* g, const float* b, int lane) {
    float s = 0.f;
#pragma unroll
    for (int j = 0; j < 4; ++j) s += (v[j][0] + v[j][1]) + (v[j][2] + v[j][3]);
    const float mean = wave_sum(s) * (1.f / DM);
    float s2 = 0.f;
#pragma unroll
    for (int j = 0; j < 4; ++j) { v[j] = v[j] - mean; s2 += (v[j][0] * v[j][0] + v[j][1] * v[j][1]) + (v[j][2] * v[j][2] + v[j][3] * v[j][3]); }
    const float rstd = rsqrtf(wave_sum(s2) * (1.f / DM) + LN_EPS);
#pragma unroll
    for (int j = 0; j < 4; ++j) { const f32x4 gg = *(const f32x4*)(g + j * 256 + lane * 4), bb = *(const f32x4*)(b + j * 256 + lane * 4); v[j] = v[j] * rstd * gg + bb; }
}
__device__ __forceinline__ void ln_store(const f32x4 (&v)[4], float* of, bf16_t* obf, int lane) {
#pragma unroll
    for (int j = 0; j < 4; ++j) { *(f32x4*)(of + j * 256 + lane * 4) = v[j]; if (obf) *(u32x2*)(obf + j * 256 + lane * 4) = (u32x2){pk2(v[j][0], v[j][1]), pk2(v[j][2], v[j][3])}; }
}
__device__ __forceinline__ void phase_ln1(const Params& P, int l) {
    const int tid = ltid(); const int lane = tid & 63, wid = __builtin_amdgcn_readfirstlane(tid >> 6); const int gw = blockIdx.x * 8 + wid, NGW = gridDim.x * 8;
    const float* y = (const float*)(P.ws + WS_YBUF); float* xf = (float*)(P.ws + WS_XF); bf16_t* xb = (bf16_t*)(P.ws + WS_XB);
    for (int m = gw; m < NTOK; m += NGW) { f32x4 v[4];
#pragma unroll
        for (int j = 0; j < 4; ++j) v[j] = *(const f32x4*)(y + (size_t)m * DM + j * 256 + lane * 4);
        ln_core(v, P.in[17] + l * DM, P.in[18] + l * DM, lane);
        ln_store(v, xf + (size_t)m * DM, xb + (size_t)m * DM, lane); }
}
__device__ __forceinline__ void phase_ln2_router(const Params& P, int l, LAS unsigned char* lds) {
    const int tid = ltid(); const int lane = tid & 63, wid = __builtin_amdgcn_readfirstlane(tid >> 6); const int gw = blockIdx.x * 8 + wid, NGW = gridDim.x * 8;
    const float* y = (const float*)(P.ws + WS_YBUF); float* xf = (float*)(P.ws + WS_XF); bf16_t* xb = (bf16_t*)(P.ws + WS_XB);
    int* cnt = (int*)(P.ws + WS_CTL) + l * 32; int* elist = (int*)(P.ws + WS_ELIST); float* tgate = (float*)(P.ws + WS_TGATE);
    LAS float* xs = (LAS float*)(lds + wid * 16384);
    const float* rw = P.in[25] + (size_t)l * 1024 * 32; const float* rb = P.in[26] + l * 32;
    for (int pr = gw; pr < NTOK / 4; pr += NGW) {
#pragma unroll
        for (int rr = 0; rr < 4; ++rr) { const int m = pr * 4 + rr; f32x4 v[4];
#pragma unroll
            for (int j = 0; j < 4; ++j) v[j] = *(const f32x4*)(y + (size_t)m * DM + j * 256 + lane * 4);
            ln_core(v, P.in[23] + l * DM, P.in[24] + l * DM, lane);
            ln_store(v, xf + (size_t)m * DM, xb + (size_t)m * DM, lane);
#pragma unroll
            for (int j = 0; j < 4; ++j) *(LAS f32x4*)(xs + rr * 1024 + j * 256 + lane * 4) = v[j]; }
        WBAR();
        const int e = lane & 31, hf = lane >> 5;
        float a[4] = {0.f, 0.f, 0.f, 0.f};
        for (int kb = 0; kb < 16; ++kb) { const int k0 = hf * 512 + kb * 32;
            float w[32];
#pragma unroll
            for (int j = 0; j < 32; ++j) w[j] = rw[(k0 + j) * 32 + e];
#pragma unroll
            for (int j4 = 0; j4 < 8; ++j4)
#pragma unroll
                for (int rr = 0; rr < 4; ++rr) { const f32x4 x = *(const LAS f32x4*)(xs + rr * 1024 + k0 + j4 * 4);
                    a[rr] += x[0] * w[4 * j4]; a[rr] += x[1] * w[4 * j4 + 1]; a[rr] += x[2] * w[4 * j4 + 2]; a[rr] += x[3] * w[4 * j4 + 3]; } }
        const float bias = rb[e];
#pragma unroll
        for (int rr = 0; rr < 4; ++rr) { const int m = pr * 4 + rr;
            float lg = a[rr] + __shfl_xor(a[rr], 32) + bias; lg = (lg == lg) ? fminf(fmaxf(lg, -1e30f), 1e30f) : -1e30f; float v = (lane < 32) ? lg : -3e38f;
            float tv[4]; int te[4];
#pragma unroll
            for (int k = 0; k < 4; ++k) { const float mx = wave_max(v); const unsigned long long bal = __ballot(v == mx); const int idx = (__ffsll((long long)bal) - 1) & 31; tv[k] = mx; te[k] = idx; if (lane == idx) v = -3e38f; }
            const float e1 = __expf(tv[1] - tv[0]), e2 = __expf(tv[2] - tv[0]), e3 = __expf(tv[3] - tv[0]); const float inv = 1.f / (1.f + e1 + e2 + e3);
            if (lane < 4) { const int ee = lane == 0 ? te[0] : (lane == 1 ? te[1] : (lane == 2 ? te[2] : te[3])); const float gg = (lane == 0 ? 1.f : (lane == 1 ? e1 : (lane == 2 ? e2 : e3))) * inv;
                const int pos = atomicAdd(cnt + ee, 1); elist[ee * ECAP + pos] = m * 4 + lane; tgate[ee * ECAP + pos] = gg; } }
        WBAR();
    }
}
__device__ __forceinline__ void phase_router_old(const Params& P, int l, LAS unsigned char* lds) {
    const int tid = ltid(); const int lane = tid & 63, wid = __builtin_amdgcn_readfirstlane(tid >> 6); const int gw = blockIdx.x * 8 + wid, NGW = gridDim.x * 8;
    const float* y = (const float*)(P.ws + WS_YBUF); float* xf = (float*)(P.ws + WS_XF); bf16_t* xb = (bf16_t*)(P.ws + WS_XB);
    int* cnt = (int*)(P.ws + WS_CTL) + l * 32; int* elist = (int*)(P.ws + WS_ELIST); float* tgate = (float*)(P.ws + WS_TGATE);
    LAS float* xs = (LAS float*)(lds + wid * 16384);
    const float* rw = P.in[25] + (size_t)l * 1024 * 32; const float* rb = P.in[26] + l * 32;
    for (int pr = gw; pr < NTOK / 4; pr += NGW) {
#pragma unroll
        for (int rr = 0; rr < 4; ++rr) { const int m = pr * 4 + rr; f32x4 v[4];
#pragma unroll
            for (int j = 0; j < 4; ++j) v[j] = *(const f32x4*)(xf + (size_t)m * DM + j * 256 + lane * 4);
#pragma unroll
            for (int j = 0; j < 4; ++j) *(LAS f32x4*)(xs + rr * 1024 + j * 256 + lane * 4) = v[j]; }
        WBAR();
        const int e = lane & 31, hf = lane >> 5;
        float a[4] = {0.f, 0.f, 0.f, 0.f};
        for (int kb = 0; kb < 16; ++kb) { const int k0 = hf * 512 + kb * 32;
            float w[32];
#pragma unroll
            for (int j = 0; j < 32; ++j) w[j] = rw[(k0 + j) * 32 + e];
#pragma unroll
            for (int j4 = 0; j4 < 8; ++j4)
#pragma unroll
                for (int rr = 0; rr < 4; ++rr) { const f32x4 x = *(const LAS f32x4*)(xs + rr * 1024 + k0 + j4 * 4);
                    a[rr] += x[0] * w[4 * j4]; a[rr] += x[1] * w[4 * j4 + 1]; a[rr] += x[2] * w[4 * j4 + 2]; a[rr] += x[3] * w[4 * j4 + 3]; } }
        const float bias = rb[e];
#pragma unroll
        for (int rr = 0; rr < 4; ++rr) { const int m = pr * 4 + rr;
            float lg = a[rr] + __shfl_xor(a[rr], 32) + bias; lg = (lg == lg) ? fminf(fmaxf(lg, -1e30f), 1e30f) : -1e30f; float v = (lane < 32) ? lg : -3e38f;
            float tv[4]; int te[4];
#pragma unroll
            for (int k = 0; k < 4; ++k) { const float mx = wave_max(v); const unsigned long long bal = __ballot(v == mx); const int idx = (__ffsll((long long)bal) - 1) & 31; tv[k] = mx; te[k] = idx; if (lane == idx) v = -3e38f; }
            const float e1 = __expf(tv[1] - tv[0]), e2 = __expf(tv[2] - tv[0]), e3 = __expf(tv[3] - tv[0]); const float inv = 1.f / (1.f + e1 + e2 + e3);
            if (lane < 4) { const int ee = lane == 0 ? te[0] : (lane == 1 ? te[1] : (lane == 2 ? te[2] : te[3])); const float gg = (lane == 0 ? 1.f : (lane == 1 ? e1 : (lane == 2 ? e2 : e3))) * inv;
                const int pos = atomicAdd(cnt + ee, 1); elist[ee * ECAP + pos] = m * 4 + lane; tgate[ee * ECAP + pos] = gg; } }
        WBAR();
    }
}
__device__ __forceinline__ void phase_router(const Params& P, int l, LAS unsigned char* lds) {
    if (gridDim.x != 256) { phase_router_old(P, l, lds); return; }
    const int tid = ltid(); const int lane = tid & 63, wid = __builtin_amdgcn_readfirstlane(tid >> 6); const int gw = blockIdx.x * 8 + wid, NGW = gridDim.x * 8;
    const float* xf = (const float*)(P.ws + WS_XF);
    int* cnt = (int*)(P.ws + WS_CTL) + l * 32; int* elist = (int*)(P.ws + WS_ELIST); float* tgate = (float*)(P.ws + WS_TGATE);
    LAS float* xs = (LAS float*)(lds + wid * 16384);
    LAS int* lcnt = (LAS int*)(lds + 131072 + 256); LAS int* lbase = (LAS int*)(lds + 131072 + 384);
    const float* rw = P.in[25] + (size_t)l * 1024 * 32; const float* rb = P.in[26] + l * 32;
    if (tid < 32) lcnt[tid] = 0;
    __syncthreads();
    int rec_e[2][4], rec_p[2][4]; float rec_g[2][4];
    {
        const int e = lane & 31, hf = lane >> 5;
        float a[8] = {0.f, 0.f, 0.f, 0.f, 0.f, 0.f, 0.f, 0.f};
#pragma unroll 1
        for (int ps = 0; ps < 2; ++ps) {
#pragma unroll
            for (int r8 = 0; r8 < 8; ++r8) { const int m = (gw + (r8 >> 2) * NGW) * 4 + (r8 & 3);
#pragma unroll
                for (int j = 0; j < 2; ++j) *(LAS f32x4*)(xs + r8 * 512 + j * 256 + lane * 4) = *(const f32x4*)(xf + (size_t)m * DM + ps * 512 + j * 256 + lane * 4); }
            WBAR();
            for (int kb = 0; kb < 8; ++kb) { const int kl = hf * 256 + kb * 32;
                float w[32];
#pragma unroll
                for (int j = 0; j < 32; ++j) w[j] = rw[(ps * 512 + kl + j) * 32 + e];
#pragma unroll
                for (int j4 = 0; j4 < 8; ++j4)
#pragma unroll
                    for (int r8 = 0; r8 < 8; ++r8) { const f32x4 x = *(const LAS f32x4*)(xs + r8 * 512 + kl + j4 * 4);
                        a[r8] += x[0] * w[4 * j4]; a[r8] += x[1] * w[4 * j4 + 1]; a[r8] += x[2] * w[4 * j4 + 2]; a[r8] += x[3] * w[4 * j4 + 3]; } }
            WBAR();
        }
        const float bias = rb[e];
#pragma unroll
        for (int r8 = 0; r8 < 8; ++r8) { const int q = r8 >> 2, rr = r8 & 3; const int m = (gw + q * NGW) * 4 + rr;
            float lg = a[r8] + __shfl_xor(a[r8], 32) + bias; lg = (lg == lg) ? fminf(fmaxf(lg, -1e30f), 1e30f) : -1e30f; float v = (lane < 32) ? lg : -3e38f;
            float tv[4]; int te[4];
#pragma unroll
            for (int k = 0; k < 4; ++k) { const float mx = wave_max(v); const unsigned long long bal = __ballot(v == mx); const int idx = (__ffsll((long long)bal) - 1) & 31; tv[k] = mx; te[k] = idx; if (lane == idx) v = -3e38f; }
            const float e1 = __expf(tv[1] - tv[0]), e2 = __expf(tv[2] - tv[0]), e3 = __expf(tv[3] - tv[0]); const float inv = 1.f / (1.f + e1 + e2 + e3);
            rec_e[q][rr] = 0; rec_p[q][rr] = 0; rec_g[q][rr] = 0.f;
            if (lane < 4) { const int ee = lane == 0 ? te[0] : (lane == 1 ? te[1] : (lane == 2 ? te[2] : te[3])); const float gg = (lane == 0 ? 1.f : (lane == 1 ? e1 : (lane == 2 ? e2 : e3))) * inv;
                rec_e[q][rr] = ee; rec_p[q][rr] = __hip_atomic_fetch_add(lcnt + ee, 1, __ATOMIC_RELAXED, __HIP_MEMORY_SCOPE_WORKGROUP); rec_g[q][rr] = gg; } }
    }
    __syncthreads();
    if (tid < 32) lbase[tid] = atomicAdd(cnt + tid, lcnt[tid]);
    __syncthreads();
    if (lane < 4) {
#pragma unroll
        for (int q = 0; q < 2; ++q)
#pragma unroll
            for (int rr = 0; rr < 4; ++rr) { const int m = (gw + q * NGW) * 4 + rr; const int ee = rec_e[q][rr]; const int slot = ee * ECAP + lbase[ee] + rec_p[q][rr]; elist[slot] = m * 4 + lane; tgate[slot] = rec_g[q][rr]; } }
    __syncthreads();
}
__device__ __forceinline__ void phase_ln3(const Params& P, int l) {
    const int tid = ltid(); const int lane = tid & 63, wid = __builtin_amdgcn_readfirstlane(tid >> 6); const int gw = blockIdx.x * 8 + wid, NGW = gridDim.x * 8;
    float* xf = (float*)(P.ws + WS_XF); bf16_t* xb = (bf16_t*)(P.ws + WS_XB); const bf16_t* ys = (const bf16_t*)(P.ws + WS_YS);
    for (int m = gw; m < NTOK; m += NGW) { f32x4 v[4];
#pragma unroll
        for (int j = 0; j < 4; ++j) { v[j] = *(const f32x4*)(xf + (size_t)m * DM + j * 256 + lane * 4) * ALPHA;
#pragma unroll
            for (int k = 0; k < 4; ++k) { const u32x2 w = *(const u32x2*)(ys + ((size_t)m * 4 + k) * DM + j * 256 + lane * 4); v[j] += (f32x4){bflo(w[0]), bfhi(w[0]), bflo(w[1]), bfhi(w[1])}; } }
        ln_core(v, P.in[31] + l * DM, P.in[32] + l * DM, lane);
        if (l == 1) ln_store(v, P.out + (size_t)m * DM, nullptr, lane); else ln_store(v, xf + (size_t)m * DM, xb + (size_t)m * DM, lane); }
}

__device__ __forceinline__ void set_base(ProbBase& S, const void* A, int lda, const void* Bt, int ldb, int M, int N, int K, int G, int c) { S.A = (const char*)A; S.Bt = (const char*)Bt; S.init(M, N, G, c); }

typedef const Params __attribute__((address_space(4))) CParams;
__global__ void __launch_bounds__(512, 2) mega(Params Pk) {
    extern __shared__ __attribute__((aligned(16))) unsigned char smem[];
    LAS unsigned char* lds = (LAS unsigned char*)smem;
    cg::grid_group grid = cg::this_grid();
    CParams* kp = (CParams*)__builtin_amdgcn_kernarg_segment_ptr();
    const int lo = Pk.ph_lo, hi = Pk.ph_hi;
    int nbar = 0;
#ifndef PHMASK
#define PHMASK 0xffffffffu
#endif
#define EN(k) (((PHMASK) >> (k)) & 1u)
#ifndef REPMASK
#define REPMASK 0u
#endif
#define NREP(k) ((((REPMASK) >> (k)) & 1u) ? 2 : 1)
#define RB(k) for (int rep_ = 0; rep_ < NREP(k); ++rep_) { if (rep_) GRID_BARRIER();
#define RE }
#define GRID_BARRIER() do { asm volatile("s_waitcnt vmcnt(0) lgkmcnt(0)" ::: "memory"); __syncthreads(); \
        if (nbar == 0) grid.sync(); \
        if (ltid() == 0) { unsigned* bw = (unsigned*)(kp->ws + WS_CTL + 1024) + nbar * 160; const unsigned gx = gridDim.x, sg = blockIdx.x & 7u; const unsigned nsub = (gx + 7u - sg) >> 3; const unsigned ngrp = gx < 8u ? gx : 8u; \
            __builtin_amdgcn_fence(__ATOMIC_RELEASE, "agent"); asm volatile("s_waitcnt vmcnt(0)" ::: "memory"); \
            const unsigned old = __hip_atomic_fetch_add(bw + 16 + sg * 16, 1u, __ATOMIC_RELAXED, __HIP_MEMORY_SCOPE_AGENT); \
            if (old + 1u == nsub) __hip_atomic_fetch_add(bw, 1u, __ATOMIC_RELAXED, __HIP_MEMORY_SCOPE_AGENT); \
            while (__hip_atomic_load(bw, __ATOMIC_RELAXED, __HIP_MEMORY_SCOPE_AGENT) < ngrp) __builtin_amdgcn_s_sleep(1); \
            __builtin_amdgcn_fence(__ATOMIC_ACQUIRE, "agent"); asm volatile("s_waitcnt vmcnt(0)" ::: "memory"); } \
        __syncthreads(); ++nbar; } while (0)
#define LOCAL_SYNC() do { asm volatile("s_waitcnt vmcnt(0) lgkmcnt(0)" ::: "memory"); __syncthreads(); if (ltid() < 64) { asm volatile("buffer_inv sc1\n\ts_waitcnt vmcnt(0)" ::: "memory"); } __syncthreads(); } while (0)
#define PH_BEGIN(id) if ((id) >= lo && (id) < hi) { CParams* kq = kp; asm volatile("" : "+s"(kq)); const Params& P = *(const Params*)kq; unsigned char* ws = P.ws; \
        int G = gridDim.x, bx = blockIdx.x; asm volatile("" : "+s"(G), "+s"(bx)); (void)ws; (void)G; (void)bx;
#define PH_END(id) if ((id) + 1 < hi) GRID_BARRIER(); }
    PH_BEGIN(0) if (EN(0)) RB(0) phase_convert(P, lds);  RE PH_END(0)
#define LAYER(l, B) \
    PH_BEGIN(B + 0) if (EN(1)) RB(1) { \
        { ProbInProj S; set_base(S, ws + WS_XB, 2048, ws + WS_WIN + l * SZ_WIN, 2048, NTOK, NP, 1024, G, bx); S.out = (bf16_t*)(ws + WS_P); S.bias = P.in[3] + (size_t)l * NIN; gemm_phase(lds, S); } \
        if (l == 0) { for (int ll = 0; ll < 2; ++ll) { \
          { ProbBf16 S; set_base(S, ws + WS_MEMB, 2048, ws + WS_WK + ll * SZ_SQ, 2048, 1024, 1024, 1024, G, (bx + G - 128 - 32 * ll) % G); S.out = (bf16_t*)(ws + WS_KM + ll * SZ_SQ); S.ldc = 1024; gemm_phase(lds, S); } \
          { ProbBf16 S; set_base(S, ws + WS_MEMB, 2048, ws + WS_WV + ll * SZ_SQ, 2048, 1024, 1024, 1024, G, (bx + G - 144 - 32 * ll) % G); S.out = (bf16_t*)(ws + WS_VT + ll * SZ_SQ); S.ldc = 1024; gemm_phase(lds, S); } } } }  RE PH_END(B + 0) \
    PH_BEGIN(B + 1) if (EN(2)) RB(2) phase_mixer_local(P, l, lds);  RE PH_END(B + 1) \
    PH_BEGIN(B + 2) if (EN(3)) RB(3) { phase_scan(P); \
        if (l == 0) { for (int ll = 0; ll < 2; ++ll) { \
          { ProbVW S; S.A = (const char*)(ws + WS_WXO + ll * SZ_SQ); S.Bt = (const char*)(ws + WS_VT + ll * SZ_SQ); S.G = G; S.c = (bx + G - 128 * ll) % G; S.out = (bf16_t*)(ws + WS_OB + (size_t)ll * 4 * SZ_SQ); gemm_phase(lds, S); } \
          { ProbMT S; S.A = (const char*)(ws + WS_KM + ll * SZ_SQ); S.Bt = (const char*)(ws + WS_WQ + ll * SZ_SQ); S.G = G; S.c = (bx + G - 64 - 128 * ll) % G; S.out = (bf16_t*)(ws + WS_QB + (size_t)ll * 4 * SZ_SQ); gemm_phase(lds, S); } } } }  RE PH_END(B + 2) \
    PH_BEGIN(B + 3) if (EN(4)) RB(4) { G2R ra, rb; int it = bx; if (it < 1024) { gla2_load(P, it, ltid(), ra); for (;;) { const int i2 = it + G; const bool h2 = i2 < 1024; gla2_item(P, l, it, h2 ? i2 : -1, ra, rb, lds); if (!h2) break; const int i3 = i2 + G; const bool h3 = i3 < 1024; gla2_item(P, l, i2, h3 ? i3 : -1, rb, ra, lds); if (!h3) break; it = i3; } } }  RE PH_END(B + 3) \
    PH_BEGIN(B + 4) if (EN(5)) RB(5) { { ProbMerge<512> S; S.A = (const char*)(ws + WS_YCAT); S.Bt = (const char*)(ws + WS_WUP + l * SZ_SQ); S.G = G; S.c = bx; \
            S.p = (const bf16_t*)(ws + WS_P); S.mb = (bf16_t*)(ws + WS_MRGB); gemm_phase(lds, S); } \
            asm volatile("s_waitcnt vmcnt(0)" ::: "memory"); __syncthreads(); \
            { ProbMerge<256> S; S.A = (const char*)(ws + WS_YCAT); S.Bt = (const char*)(ws + WS_WUP + l * SZ_SQ); S.G = G; S.c = bx; \
            S.p = (const bf16_t*)(ws + WS_P); S.mb = (bf16_t*)(ws + WS_MRGB); gemm_phase(lds, S); } }  RE PH_END(B + 4) \
    PH_BEGIN(B + 5) if (EN(6)) RB(6) { ProbResLN S; set_base(S, ws + WS_MRGB, 2048, ws + WS_WO + l * SZ_SQ, 2048, NTOK, 1024, 1024, G, bx); \
            S.xres = (l == 0) ? P.in[0] : (const float*)(ws + WS_XF); S.lng = P.in[17] + l * DM; S.lnb = P.in[18] + l * DM; S.xf = (float*)(ws + WS_XF); S.xb = (bf16_t*)(ws + WS_XB); \
            S.stats = (float*)(ws + WS_STATS); S.cntp = (unsigned*)(ws + WS_CTL + 24576) + (l * 2 + 0) * 64; S.bstride = 0; gemm_phase(lds, S); }  RE PH_END(B + 5) \
    PH_BEGIN(B + 7) if (EN(8)) RB(8) { ProbAttn<0, 1024> S; S.A = (const char*)(ws + WS_XB); S.Bt = (const char*)(ws + WS_QB + (size_t)l * 4 * SZ_SQ); S.G = G; S.c = bx; S.sout = nullptr; S.oout = (bf16_t*)(ws + WS_MRGF); gemm_phase(lds, S); }  RE PH_END(B + 7) \
    PH_BEGIN(B + 10) if (EN(6)) RB(6) { ProbResLN S; set_base(S, ws + WS_MRGF, 2048, ws + WS_OB + (size_t)l * 4 * SZ_SQ, 2048, NTOK, 1024, 1024, G, bx); \
            S.xres = (const float*)(ws + WS_XF); S.lng = P.in[23] + l * DM; S.lnb = P.in[24] + l * DM; S.xf = (float*)(ws + WS_XF); S.xb = (bf16_t*)(ws + WS_XB); \
            S.stats = (float*)(ws + WS_STATS); S.cntp = (unsigned*)(ws + WS_CTL + 24576) + (l * 2 + 1) * 64; S.bstride = SZ_SQ; gemm_phase(lds, S); }  RE PH_END(B + 10) \
    PH_BEGIN(B + 11) if (EN(10)) RB(10) phase_router(P, l, lds);  RE PH_END(B + 11) \
    PH_BEGIN(B + 12) if (EN(11)) RB(11) { LAS int* tstart = (LAS int*)(lds + 131072); const int* cnt = (const int*)(ws + WS_CTL) + l * 32; \
            if (ltid() == 0) { int a = 0; for (int e = 0; e < 32; ++e) { tstart[e] = a; a += (cnt[e] + 255) >> 8; } tstart[32] = a; } \
            __syncthreads(); \
            ProbMoe1 S; S.G = G; S.c = (G % 8 == 0) ? (bx % 8) * (G / 8) + bx / 8 : bx; S.nN = 8; S.tstart = tstart; S.cnt = cnt; \
            S.A = (const char*)(ws + WS_XB); S.Bt = (const char*)(ws + WS_WGU + l * SZ_WGU); \
            S.elist = (const int*)(ws + WS_ELIST); S.bgu = P.in[28] + (size_t)l * 32 * 2048; S.abuf = (bf16_t*)(ws + WS_ABUF); gemm_phase(lds, S); }  RE PH_END(B + 12) \
    PH_BEGIN(B + 13) if (EN(12)) RB(12) { LAS int* tstart = (LAS int*)(lds + 131072); const int* cnt = (const int*)(ws + WS_CTL) + l * 32; \
            if (ltid() == 0) { int a = 0; for (int e = 0; e < 32; ++e) { tstart[e] = a; a += (cnt[e] + 255) >> 8; } tstart[32] = a; } \
            __syncthreads(); \
            ProbMoe2 S; S.G = G; S.c = (G % 8 == 0) ? (bx % 8) * (G / 8) + bx / 8 : bx; S.nN = 4; S.tstart = tstart; S.cnt = cnt; \
            S.A = (const char*)(ws + WS_ABUF); S.Bt = (const char*)(ws + WS_WD + l * SZ_WD); \
            S.elist = (const int*)(ws + WS_ELIST); S.bd = P.in[30] + (size_t)l * 32 * 1024; S.tgate = (const float*)(ws + WS_TGATE); S.ys = (bf16_t*)(ws + WS_YS); gemm_phase(lds, S); }  RE PH_END(B + 13) \
    PH_BEGIN(B + 14) if (EN(13)) RB(13) phase_ln3(P, l);  RE PH_END(B + 14)
    LAYER(0, 1)
    LAYER(1, 16)
#ifdef EXTRA_BARS
    for (int xb_ = 0; xb_ < EXTRA_BARS; ++xb_) GRID_BARRIER();
#endif
#ifdef DBG_OFF
    { GRID_BARRIER(); const Params& P = *(const Params*)kp; const int G = gridDim.x, bx = blockIdx.x; const int gt = bx * 512 + ltid();
      for (size_t i = gt; i < (size_t)NTOK * DM; i += (size_t)G * 512) {
#if DBG_BF16
          { float dv = bf2f(((const bf16_t*)(P.ws + DBG_OFF))[i]); P.out[i] = (dv == dv && fabsf(dv) < 1e30f) ? dv : 1000.f; }
#else
          P.out[i] = ((const float*)(P.ws + DBG_OFF))[i];
#endif
      } }
#endif
}

extern "C" void kernel_launch(void* const* d_in, const int* in_sizes, int n_in, void* d_out, int out_size, void* d_ws, size_t ws_size, hipStream_t stream) {
    static int grid = 0;
    if (grid == 0) {
        int dev = 0, cus = 0, per_cu = 0;
        hipGetDevice(&dev);
        hipDeviceGetAttribute(&cus, hipDeviceAttributeMultiprocessorCount, dev);
        hipFuncSetAttribute((const void*)mega, hipFuncAttributeMaxDynamicSharedMemorySize, LDS_BYTES);
        hipOccupancyMaxActiveBlocksPerMultiprocessor(&per_cu, (const void*)mega, 512, LDS_BYTES);
        if (per_cu < 1) per_cu = 1;
        grid = cus < 256 ? cus : 256;
        if (ws_size < WS_END) fprintf(stderr, "kernel_launch: workspace too small: %zu < %zu\n", ws_size, (size_t)WS_END);
        if (n_in != 33) fprintf(stderr, "kernel_launch: expected 33 inputs, got %d\n", n_in);
    }
    hipMemsetAsync((char*)d_ws + WS_CTL, 0, 32768, stream);
    Params p{};
    for (int i = 0; i < 33; ++i) p.in[i] = (const float*)d_in[i];
    p.out = (float*)d_out; p.ws = (unsigned char*)d_ws; p.ph_lo = 0; p.ph_hi = PH_HI;
    void* args[] = {&p};
    hipError_t e = hipLaunchCooperativeKernel((const void*)mega, dim3(grid), dim3(512), args, LDS_BYTES, stream);
    if (e != hipSuccess) fprintf(stderr, "cooperative launch failed: %s (grid %d)\n", hipGetErrorString(e), grid);
}
```

```cpp
#include <hip/hip_runtime.h>
#include <hip/hip_cooperative_groups.h>
#include <cstdio>
namespace cg = cooperative_groups;

#define LAS __attribute__((address_space(3)))
typedef unsigned short bf16_t;
typedef short bf16x8 __attribute__((ext_vector_type(8)));
typedef float f32x4 __attribute__((ext_vector_type(4)));
typedef unsigned u32x4 __attribute__((ext_vector_type(4)));
typedef unsigned u32x2 __attribute__((ext_vector_type(2)));

constexpr int NTOK = 16384, DM = 1024, SEQL = 4096, NP = 5632;
constexpr int COL_K = 256, COL_V = 512, COL_R = 1024, COL_UV = 1536, COL_XC = 2048, COL_GATE = 2304, COL_GL = 5376, NIN = 5392;
constexpr float LN_EPS = 1e-5f;
constexpr float ALPHA = 1.41421356237f;
constexpr int ECAP = 16384;
constexpr int LDS_BYTES = 131072 + 1024;
#ifndef PH_HI
#define PH_HI 31
#endif

constexpr size_t al256(size_t x) { return (x + 255) & ~(size_t)255; }
constexpr size_t WS_CTL = 0;
constexpr size_t WS_WIN = 32768;
constexpr size_t SZ_WIN = (size_t)NP * 1024 * 2;
constexpr size_t WS_WUP = WS_WIN + 2 * SZ_WIN;
constexpr size_t SZ_SQ = (size_t)1024 * 1024 * 2;
constexpr size_t WS_WO = WS_WUP + 2 * SZ_SQ;
constexpr size_t WS_WQ = WS_WO + 2 * SZ_SQ;
constexpr size_t WS_WK = WS_WQ + 2 * SZ_SQ;
constexpr size_t WS_WV = WS_WK + 2 * SZ_SQ;
constexpr size_t WS_WXO = WS_WV + 2 * SZ_SQ;
constexpr size_t WS_WGU = WS_WXO + 2 * SZ_SQ;
constexpr size_t SZ_WGU = (size_t)32 * 2048 * 1024 * 2;
constexpr size_t WS_WD = WS_WGU + 2 * SZ_WGU;
constexpr size_t SZ_WD = (size_t)32 * 1024 * 1024 * 2;
constexpr size_t WS_XB = WS_WD + 2 * SZ_WD;
constexpr size_t SZ_ACTB = (size_t)NTOK * 1024 * 2;
constexpr size_t SZ_ACTF = (size_t)NTOK * 1024 * 4;
constexpr size_t WS_MEMB = WS_XB + SZ_ACTB;
constexpr size_t WS_XF = WS_MEMB + SZ_SQ;
constexpr size_t WS_YBUF = WS_XF + SZ_ACTF;
constexpr size_t WS_P = WS_YBUF + SZ_ACTF;
constexpr size_t WS_YCAT = WS_P + (size_t)NTOK * NP * 2;
constexpr size_t WS_BCUM = WS_YCAT + SZ_ACTB;
constexpr size_t WS_KVT = WS_BCUM + (size_t)NTOK * 256 * 4;
constexpr size_t WS_CDEC = WS_KVT + (size_t)1024 * 8192 * 4;
constexpr size_t WS_ST = WS_CDEC + (size_t)1024 * 64 * 4;
constexpr size_t WS_MRGF = WS_ST + (size_t)1024 * 8192 * 2;
constexpr size_t WS_MRGB = WS_MRGF + SZ_ACTF;
constexpr size_t WS_QB = WS_MRGB + SZ_ACTB;
constexpr size_t WS_OB = WS_QB + SZ_ACTB;
constexpr size_t WS_KM = WS_OB + SZ_ACTB;
constexpr size_t WS_VT = WS_KM + 2 * SZ_SQ;
constexpr size_t WS_ELIST = WS_VT + 8 * SZ_SQ;
constexpr size_t WS_TGATE = WS_ELIST + (size_t)32 * ECAP * 4;
constexpr size_t WS_ABUF = WS_TGATE + (size_t)32 * ECAP * 4;
constexpr size_t WS_YS = WS_ABUF + (size_t)73728 * 1024 * 2;
constexpr size_t WS_STATS = WS_YS + (size_t)65536 * 1024 * 2;
constexpr size_t WS_END = WS_STATS + (size_t)64 * 4 * 256 * 2 * 4;

__device__ __forceinline__ float bf2f(bf16_t b) { return __uint_as_float(((unsigned)b) << 16); }
__device__ __forceinline__ unsigned pk2(float lo, float hi) { unsigned r; asm("v_cvt_pk_bf16_f32 %0, %1, %2" : "=v"(r) : "v"(lo), "v"(hi)); return r; }
__device__ __forceinline__ bf16_t f2bf(float f) { return (bf16_t)(pk2(f, 0.f) & 0xffffu); }
__device__ __forceinline__ float bflo(unsigned u) { return __uint_as_float(u << 16); }
__device__ __forceinline__ float bfhi(unsigned u) { return __uint_as_float(u & 0xffff0000u); }
__device__ __forceinline__ float wave_sum(float v) {
#pragma unroll
    for (int o = 32; o; o >>= 1) v += __shfl_xor(v, o);
    return v;
}
__device__ __forceinline__ float wave_max(float v) {
#pragma unroll
    for (int o = 32; o; o >>= 1) v = fmaxf(v, __shfl_xor(v, o));
    return v;
}
__device__ __forceinline__ float gelu_f(float v) {
    const float av = fabsf(v), t = __builtin_amdgcn_rcpf(av * 0.2316418882f + 1.0f);
    float q = t * 0.5307027145f + (-0.7265760135f); q = q * t + 0.7107068705f; q = q * t + (-0.142248368f); q = q * t + 0.127414796f; q = q * t;
    const float e = __builtin_amdgcn_exp2f((v * v) * (-0.72134752044f));
    const float m = v * (q * e);
    return v < 0.f ? m : v - m;
}
__device__ __forceinline__ float sigmoid_f(float x) { return __builtin_amdgcn_rcpf(1.f + __expf(-x)); }
__device__ __forceinline__ int ltid() { int t = threadIdx.x; asm volatile("" : "+v"(t)); return t; }
#define WBAR() do { asm volatile("" ::: "memory"); __builtin_amdgcn_wave_barrier(); asm volatile("" ::: "memory"); } while (0)

struct Params { const float* in[33]; float* out; unsigned char* ws; int ph_lo, ph_hi; };

constexpr int BM = 256, BK = 64, HALF = 128, HTB = HALF * BK * 2, NXCD = 8, WGM = 8;
__device__ __forceinline__ int lds_byte(int r, int c) { const int st = (r >> 4) * 2 + (c >> 5), rr = r & 15, cc = c & 31, ob = rr * 64 + cc * 2; return st * 1024 + (ob ^ (((ob >> 9) & 1) << 5)); }
__device__ __forceinline__ void stage_rc(int b, int& R, int& C) { const int st = b / 1024, sb = b % 1024, swz = sb ^ (((sb >> 9) & 1) << 5); R = (st >> 1) * 16 + swz / 64; C = (st & 1) * 32 + (swz % 64) / 2; }
__device__ __forceinline__ int perm32(int rho) { const int n = rho >> 4, i = rho & 15; return 8 * (i >> 2) + 4 * n + (i & 3); }

struct Unit { int pm, pn, e, aux; };
typedef f32x4 Acc[2][2][4][2];

struct OrderStatic {
    int nM, nN, nwg, G, c;
    __device__ __forceinline__ void init(int M, int N, int G_, int c_) { nM = M / BM; nN = N / BM; nwg = nM * nN; G = G_; c = c_; }
    __device__ __forceinline__ bool next(int i, Unit& u) const {
        const long L = (long)i * G + c; if (L >= nwg) return false;
        int wgid = (int)L; { const int q = nwg / NXCD, r = nwg % NXCD, xcd = wgid % NXCD, off = wgid / NXCD; wgid = (xcd < r ? xcd * (q + 1) : r * (q + 1) + (xcd - r) * q) + off; }
        const int nig = WGM * nN, gid = wgid / nig, fm = gid * WGM, gsz = (nM - fm) < WGM ? (nM - fm) : WGM;
        u.pm = fm + ((wgid % nig) % gsz); u.pn = (wgid % nig) / gsz; u.e = 0; u.aux = 0; return true;
    }
};

template <class S_t>
__device__ __forceinline__ void gemm_phase(LAS unsigned char* lds, const S_t& S) {
    const int tid = ltid(), wid = __builtin_amdgcn_readfirstlane(tid >> 6), lane = tid & 63, wr = wid >> 2, wc = wid & 3, fr = lane & 15, fq = lane >> 4;
    const int nt = S.K / BK;
    int Rr[2], Cc[2]; unsigned voffB[2]; unsigned offC[2][2], offN[2][2];
#pragma unroll
    for (int i = 0; i < 2; ++i) { stage_rc(tid * 16 + i * 8192, Rr[i], Cc[i]); const int Rb = S_t::PERM ? ((Rr[i] & ~31) + perm32(Rr[i] & 31)) : Rr[i];
        voffB[i] = (unsigned)(Rb * S.ldb + Cc[i] * 2);
        offC[0][i] = (unsigned)(Rr[i] * S.lda + Cc[i] * 2); offC[1][i] = (unsigned)((Rr[i] + HALF) * S.lda + Cc[i] * 2);
        }
    const size_t kstep = (size_t)(BK * 2);
    const size_t hstepB = (size_t)HALF * S.ldb;
    const unsigned ldsw = (unsigned)wid * 1024u;
    const int aoff = lds_byte(wr * 64 + fr, fq * 8), boff = lds_byte(wc * 32 + fr, fq * 8);
#define G_SA(b, h) (((b) * 2 + (h)) * HTB)
#define G_SB(b, h) ((4 + (b) * 2 + (h)) * HTB)
#define G_STAGE_A(bufoff, kptr, OFF, h) do { _Pragma("unroll") for (int _i = 0; _i < 2; ++_i) \
        __builtin_amdgcn_global_load_lds((const unsigned*)((const char*)(kptr) + (OFF)[h][_i]), (LAS unsigned*)(lds + (bufoff) + ldsw + _i * 8192), 16, 0, 0); } while (0)
#define G_STAGE_B(bufoff, gbase) do { _Pragma("unroll") for (int _i = 0; _i < 2; ++_i) \
        __builtin_amdgcn_global_load_lds((const unsigned*)((const char*)(gbase) + voffB[_i]), (LAS unsigned*)(lds + (bufoff) + ldsw + _i * 8192), 16, 0, 0); } while (0)
#define G_LDA(dst, b, h) do { _Pragma("unroll") for (int m = 0; m < 4; ++m) _Pragma("unroll") for (int k = 0; k < 2; ++k) dst[m][k] = *(const LAS bf16x8*)(lds + G_SA(b, h) + aoff + m * 2048 + k * 1024); } while (0)
#define G_LDB(dst, b, h) do { _Pragma("unroll") for (int n = 0; n < 2; ++n) _Pragma("unroll") for (int k = 0; k < 2; ++k) dst[n][k] = *(const LAS bf16x8*)(lds + G_SB(b, h) + boff + n * 2048 + k * 1024); } while (0)
#define G_MMA(ai, bj, At, Bt) do { __builtin_amdgcn_s_setprio(1); _Pragma("unroll") for (int m = 0; m < 4; ++m) _Pragma("unroll") for (int n = 0; n < 2; ++n) _Pragma("unroll") for (int k = 0; k < 2; ++k) \
        acc[ai][bj][m][n] = __builtin_amdgcn_mfma_f32_16x16x32_bf16(Bt[n][k], At[m][k], acc[ai][bj][m][n], 0, 0, 0); __builtin_amdgcn_s_setprio(0); } while (0)
#define G_WAIT_V(n) asm volatile("s_waitcnt vmcnt(" #n ")" ::: "memory")
#define G_WAIT_L(n) asm volatile("s_waitcnt lgkmcnt(" #n ")" ::: "memory")
#define G_BAR __builtin_amdgcn_s_barrier()
#define G_SCHED __builtin_amdgcn_sched_barrier(0)
    Unit cur, nxt; int ui = 0;
    if (!S.next(0, cur)) return;
    if (S_t::GATHER) S.gather_offs(cur, tid, offC);
    Acc acc;
#pragma unroll
    for (int a = 0; a < 2; ++a)
#pragma unroll
        for (int b = 0; b < 2; ++b)
#pragma unroll
            for (int m = 0; m < 4; ++m)
#pragma unroll
                for (int n = 0; n < 2; ++n) acc[a][b][m][n] = (f32x4){0.f, 0.f, 0.f, 0.f};
    bf16x8 At[4][2], B0[2][2], B1[2][2];
    const char* cA = S.a_ptr(cur); const char* cB = S.b_ptr(cur);
    G_STAGE_B(G_SB(0, 0), cB); G_STAGE_A(G_SA(0, 0), cA, offC, 0); G_STAGE_B(G_SB(0, 1), cB + hstepB); G_STAGE_A(G_SA(0, 1), cA, offC, 1);
    if (wr == 1) G_BAR;
    G_WAIT_V(4); G_BAR;
    G_STAGE_B(G_SB(1, 0), cB + kstep); G_STAGE_A(G_SA(1, 0), cA + kstep, offC, 0); G_STAGE_B(G_SB(1, 1), cB + hstepB + kstep);
    G_WAIT_V(6); G_BAR;
    for (;;) {
        const bool has_next = S.next(ui + 1, nxt);
        const char* nA = has_next ? S.a_ptr(nxt) : cA; const char* nB = has_next ? S.b_ptr(nxt) : cB;
        if (S_t::GATHER) { if (has_next) S.gather_offs(nxt, tid, offN); else { offN[0][0] = offC[0][0]; offN[0][1] = offC[0][1]; offN[1][0] = offC[1][0]; offN[1][1] = offC[1][1]; } }
        for (int t = 0; t < nt; t += 2) {
            const bool last = (t == nt - 2);
            const char* a1 = cA + (size_t)(t + 1) * kstep;
            const char* a2 = last ? nA : cA + (size_t)(t + 2) * kstep; const char* b2 = last ? nB : cB + (size_t)(t + 2) * kstep;
            const char* a3 = a2 + kstep; const char* b3 = b2 + kstep;
            G_LDB(B0, 0, 0); G_SCHED; G_LDA(At, 0, 0); G_STAGE_A(G_SA(1, 1), a1, offC, 1);
            if (S_t::GATHER) { if (last) { offC[0][0] = offN[0][0]; offC[0][1] = offN[0][1]; offC[1][0] = offN[1][0]; offC[1][1] = offN[1][1]; } }
            G_WAIT_L(8); G_BAR; G_WAIT_L(0); G_MMA(0, 0, At, B0); G_BAR; G_SCHED;
            G_LDB(B1, 0, 1); G_STAGE_B(G_SB(0, 0), b2);
            G_BAR; G_WAIT_L(0); G_MMA(0, 1, At, B1); G_BAR;
            G_LDA(At, 0, 1); G_STAGE_A(G_SA(0, 0), a2, offC, 0);
            G_BAR; G_WAIT_L(0); G_MMA(1, 0, At, B0); G_BAR; G_SCHED;
            G_STAGE_B(G_SB(0, 1), b2 + hstepB);
            G_WAIT_V(6); G_BAR; G_MMA(1, 1, At, B1); G_BAR;
            G_LDB(B0, 1, 0); G_SCHED; G_LDA(At, 1, 0); G_STAGE_A(G_SA(0, 1), a2, offC, 1);
            G_WAIT_L(8); G_BAR; G_WAIT_L(0); G_MMA(0, 0, At, B0); G_BAR; G_SCHED;
            G_LDB(B1, 1, 1); G_STAGE_B(G_SB(1, 0), b3);
            G_BAR; G_WAIT_L(0); G_MMA(0, 1, At, B1); G_BAR;
            G_LDA(At, 1, 1); G_STAGE_A(G_SA(1, 0), a3, offC, 0);
            G_BAR; G_WAIT_L(0); G_MMA(1, 0, At, B0); G_BAR; G_SCHED;
            G_STAGE_B(G_SB(1, 1), b3 + hstepB);
            G_WAIT_V(6); G_BAR; G_MMA(1, 1, At, B1); G_BAR;
        }
        if constexpr (!S_t::AFTER) S.epi(acc, cur, wr, wc, fr, fq);
        if (!has_next) break;
#pragma unroll
        for (int a = 0; a < 2; ++a)
#pragma unroll
            for (int b = 0; b < 2; ++b)
#pragma unroll
                for (int m = 0; m < 4; ++m)
#pragma unroll
                    for (int n = 0; n < 2; ++n) acc[a][b][m][n] = (f32x4){0.f, 0.f, 0.f, 0.f};
        cur = nxt; cA = nA; cB = nB; ++ui;
    }
    G_WAIT_V(0);
    if (wr == 0) G_BAR;
    G_BAR;
    if constexpr (S_t::AFTER) S.epi_after(acc, cur, wr, wc, fr, fq, lds);
}

struct ProbBase : OrderStatic {
    static constexpr bool GATHER = false, AFTER = false;
    const char* A; const char* Bt; static constexpr int K = 1024, lda = 2048, ldb = 2048;
    __device__ __forceinline__ const char* a_ptr(const Unit& u) const { return A + (size_t)u.pm * BM * lda; }
    __device__ __forceinline__ const char* b_ptr(const Unit& u) const { return Bt + (size_t)u.pn * BM * ldb; }
    __device__ __forceinline__ void gather_offs(const Unit&, int, unsigned (&)[2][2]) const {}
};

struct ProbInProj : ProbBase {
    static constexpr bool PERM = true;
    bf16_t* out; const float* bias;
    __device__ __forceinline__ void epi(const Acc& acc, const Unit& u, int wr, int wc, int fr, int fq) const {
        const int row0 = u.pm * BM + wr * 64 + fr, colt = u.pn * BM + wc * 32 + 8 * fq;
        f32x4 bv[2][2];
#pragma unroll
        for (int bj = 0; bj < 2; ++bj) { const int c = colt + bj * HALF; int mc = c < COL_UV ? c : (c < COL_GL ? c + 16 : c - COL_GL + COL_UV);
            if (c < NIN) { bv[bj][0] = *(const f32x4*)(bias + mc); bv[bj][1] = *(const f32x4*)(bias + mc + 4); } else { bv[bj][0] = (f32x4){0.f, 0.f, 0.f, 0.f}; bv[bj][1] = bv[bj][0]; } }
#pragma unroll
        for (int ai = 0; ai < 2; ++ai)
#pragma unroll
            for (int m = 0; m < 4; ++m) { bf16_t* rowp = out + (size_t)(row0 + ai * HALF + m * 16) * NP + colt;
#pragma unroll
                for (int bj = 0; bj < 2; ++bj) { const f32x4 v0 = acc[ai][bj][m][0] + bv[bj][0], v1 = acc[ai][bj][m][1] + bv[bj][1];
                    *(u32x4*)(rowp + bj * HALF) = (u32x4){pk2(v0[0], v0[1]), pk2(v0[2], v0[3]), pk2(v1[0], v1[1]), pk2(v1[2], v1[3])}; } }
    }
};
struct ProbBf16 : ProbBase {
    static constexpr bool PERM = true;
    bf16_t* out; int ldc;
    __device__ __forceinline__ void epi(const Acc& acc, const Unit& u, int wr, int wc, int fr, int fq) const {
        const int row0 = u.pm * BM + wr * 64 + fr, colt = u.pn * BM + wc * 32 + 8 * fq;
#pragma unroll
        for (int ai = 0; ai < 2; ++ai)
#pragma unroll
            for (int m = 0; m < 4; ++m) { bf16_t* rowp = out + (size_t)(row0 + ai * HALF + m * 16) * ldc + colt;
#pragma unroll
                for (int bj = 0; bj < 2; ++bj) { const f32x4 v0 = acc[ai][bj][m][0], v1 = acc[ai][bj][m][1];
                    *(u32x4*)(rowp + bj * HALF) = (u32x4){pk2(v0[0], v0[1]), pk2(v0[2], v0[3]), pk2(v1[0], v1[1]), pk2(v1[2], v1[3])}; } }
    }
};
struct ProbQ : ProbBf16 {
    int G2, c2;
    __device__ __forceinline__ bool next(int i, Unit& u) const { const int L = i * G2 + c2; if (L >= 256) return false; const int bh = L >> 4, mt = L & 15; u.pm = (bh >> 2) * 16 + mt; u.pn = bh & 3; u.e = 0; u.aux = 0; return true; }
};
struct ProbRes : ProbBase {
    static constexpr bool PERM = false;
    float* out; const float* xres;
    __device__ __forceinline__ void epi(const Acc& acc, const Unit& u, int wr, int wc, int fr, int fq) const {
        const int row0 = u.pm * BM + wr * 64 + fr, col0 = u.pn * BM + wc * 32 + 4 * fq;
#pragma unroll
        for (int ai = 0; ai < 2; ++ai) {
            f32x4 xr[4][2][2];
#pragma unroll
            for (int m = 0; m < 4; ++m) { const size_t ro = (size_t)(row0 + ai * HALF + m * 16) * DM + col0;
#pragma unroll
                for (int bj = 0; bj < 2; ++bj)
#pragma unroll
                    for (int n = 0; n < 2; ++n) xr[m][bj][n] = *(const f32x4*)(xres + ro + bj * HALF + n * 16); }
#pragma unroll
            for (int m = 0; m < 4; ++m) { const size_t ro = (size_t)(row0 + ai * HALF + m * 16) * DM + col0;
#pragma unroll
                for (int bj = 0; bj < 2; ++bj)
#pragma unroll
                    for (int n = 0; n < 2; ++n) *(f32x4*)(out + ro + bj * HALF + n * 16) = xr[m][bj][n] * ALPHA + acc[ai][bj][m][n]; }
        }
    }
};
struct ProbMT {
    static constexpr bool PERM = true, GATHER = false, AFTER = false;
    static constexpr int K = 256, lda = 2048, ldb = 2048;
    const char* A; const char* Bt; int G, c; bf16_t* out;
    __device__ __forceinline__ bool next(int i, Unit& u) const { const int L = i * G + c; if (L >= 64) return false; u.e = L >> 2; u.pn = L & 3; u.pm = 0; u.aux = 0; return true; }
    __device__ __forceinline__ const char* a_ptr(const Unit& u) const { const int b = u.e >> 2, h = u.e & 3; return A + (size_t)(b * 256) * lda + h * 512; }
    __device__ __forceinline__ const char* b_ptr(const Unit& u) const { const int h = u.e & 3; return Bt + (size_t)u.pn * BM * ldb + h * 512; }
    __device__ __forceinline__ void gather_offs(const Unit&, int, unsigned (&)[2][2]) const {}
    __device__ __forceinline__ void epi(const Acc& acc, const Unit& u, int wr, int wc, int fr, int fq) const {
        const int row0 = wr * 64 + fr, colt = u.pn * BM + wc * 32 + 8 * fq;
#pragma unroll
        for (int ai = 0; ai < 2; ++ai)
#pragma unroll
            for (int m = 0; m < 4; ++m) { bf16_t* rowp = out + (size_t)u.e * 256 * 1024 + (size_t)(row0 + ai * HALF + m * 16) * 1024 + colt;
#pragma unroll
                for (int bj = 0; bj < 2; ++bj) { const f32x4 v0 = acc[ai][bj][m][0], v1 = acc[ai][bj][m][1];
                    *(u32x4*)(rowp + bj * HALF) = (u32x4){pk2(v0[0], v0[1]), pk2(v0[2], v0[3]), pk2(v1[0], v1[1]), pk2(v1[2], v1[3])}; } }
    }
};
struct ProbVW {
    static constexpr bool PERM = true, GATHER = false, AFTER = false;
    static constexpr int K = 256, lda = 2048, ldb = 2048;
    const char* A; const char* Bt; int G, c; bf16_t* out;
    __device__ __forceinline__ bool next(int i, Unit& u) const { const int L = i * G + c; if (L >= 64) return false; u.e = L >> 2; u.pm = L & 3; u.pn = 0; u.aux = 0; return true; }
    __device__ __forceinline__ const char* a_ptr(const Unit& u) const { const int h = u.e & 3; return A + (size_t)u.pm * BM * lda + h * 512; }
    __device__ __forceinline__ const char* b_ptr(const Unit& u) const { const int b = u.e >> 2, h = u.e & 3; return Bt + (size_t)(b * 256) * ldb + h * 512; }
    __device__ __forceinline__ void gather_offs(const Unit&, int, unsigned (&)[2][2]) const {}
    __device__ __forceinline__ void epi(const Acc& acc, const Unit& u, int wr, int wc, int fr, int fq) const {
        const int b = u.e >> 2, h = u.e & 3; const int row0 = u.pm * BM + wr * 64 + fr, colt = h * 256 + wc * 32 + 8 * fq;
#pragma unroll
        for (int ai = 0; ai < 2; ++ai)
#pragma unroll
            for (int m = 0; m < 4; ++m) { bf16_t* rowp = out + (size_t)b * 1024 * 1024 + (size_t)(row0 + ai * HALF + m * 16) * 1024 + colt;
#pragma unroll
                for (int bj = 0; bj < 2; ++bj) { const f32x4 v0 = acc[ai][bj][m][0], v1 = acc[ai][bj][m][1];
                    *(u32x4*)(rowp + bj * HALF) = (u32x4){pk2(v0[0], v0[1]), pk2(v0[2], v0[3]), pk2(v1[0], v1[1]), pk2(v1[2], v1[3])}; } }
    }
};
struct ProbResLN : ProbBase {
    static constexpr bool PERM = false, AFTER = true;
    const float* xres; const float* lng; const float* lnb; float* xf; bf16_t* xb; float* stats; unsigned* cntp; size_t bstride;
    __device__ __forceinline__ const char* b_ptr(const Unit& u) const { return Bt + (size_t)(u.pm >> 4) * bstride + (size_t)u.pn * BM * ldb; }
    __device__ __forceinline__ void epi(const Acc&, const Unit&, int, int, int, int) const {}
    __device__ __forceinline__ void epi_after(Acc& acc, const Unit& u, int wr, int wc, int fr, int fq, LAS unsigned char* lds) const {
        const int tid = ltid();
        const int col0 = u.pn * BM + wc * 32 + 4 * fq;
        LAS float* red = (LAS float*)lds;
        LAS float* tab = (LAS float*)(lds + 8192);
#pragma unroll
        for (int ai = 0; ai < 2; ++ai)
#pragma unroll
            for (int m = 0; m < 4; ++m) { const int rowl = ai * HALF + wr * 64 + m * 16 + fr; const size_t ro = (size_t)(u.pm * BM + rowl) * DM + col0;
                float sv = 0.f, sq = 0.f;
#pragma unroll
                for (int bj = 0; bj < 2; ++bj)
#pragma unroll
                    for (int n = 0; n < 2; ++n) { const f32x4 xr = *(const f32x4*)(xres + ro + bj * HALF + n * 16); const f32x4 y = xr * ALPHA + acc[ai][bj][m][n]; acc[ai][bj][m][n] = y;
                        sv += (y[0] + y[1]) + (y[2] + y[3]); sq += (y[0] * y[0] + y[1] * y[1]) + (y[2] * y[2] + y[3] * y[3]); }
                sv += __shfl_xor(sv, 16); sv += __shfl_xor(sv, 32); sq += __shfl_xor(sq, 16); sq += __shfl_xor(sq, 32);
                if (fq == 0) { red[(rowl * 4 + wc) * 2] = sv; red[(rowl * 4 + wc) * 2 + 1] = sq; } }
        __syncthreads();
        if (tid < 256) { float S = 0.f, SS = 0.f;
#pragma unroll
            for (int w = 0; w < 4; ++w) { S += red[(tid * 4 + w) * 2]; SS += red[(tid * 4 + w) * 2 + 1]; }
            float* st = stats + ((size_t)(u.pm * 4 + u.pn) * 256 + tid) * 2; st[0] = S; st[1] = SS; }
        asm volatile("s_waitcnt vmcnt(0)" ::: "memory");
        __syncthreads();
        if (tid == 0) { unsigned* cw = cntp + u.pm;
            __builtin_amdgcn_fence(__ATOMIC_RELEASE, "agent"); asm volatile("s_waitcnt vmcnt(0)" ::: "memory");
            __hip_atomic_fetch_add(cw, 1u, __ATOMIC_RELAXED, __HIP_MEMORY_SCOPE_AGENT);
            while (__hip_atomic_load(cw, __ATOMIC_RELAXED, __HIP_MEMORY_SCOPE_AGENT) < 4u) __builtin_amdgcn_s_sleep(1);
            __builtin_amdgcn_fence(__ATOMIC_ACQUIRE, "agent"); asm volatile("s_waitcnt vmcnt(0)" ::: "memory"); }
        __syncthreads();
        if (tid < 256) { float S = 0.f, SS = 0.f;
#pragma unroll
            for (int w = 0; w < 4; ++w) { const float* st = stats + ((size_t)(u.pm * 4 + w) * 256 + tid) * 2;
                S += __hip_atomic_load(st, __ATOMIC_RELAXED, __HIP_MEMORY_SCOPE_AGENT); SS += __hip_atomic_load(st + 1, __ATOMIC_RELAXED, __HIP_MEMORY_SCOPE_AGENT); }
            const float mean = S * (1.f / DM), var = fmaxf(SS * (1.f / DM) - mean * mean, 0.f);
            tab[tid * 2] = mean; tab[tid * 2 + 1] = rsqrtf(var + LN_EPS); }
        __syncthreads();
        f32x4 gv[2][2], bv[2][2];
#pragma unroll
        for (int bj = 0; bj < 2; ++bj)
#pragma unroll
            for (int n = 0; n < 2; ++n) { gv[bj][n] = *(const f32x4*)(lng + col0 + bj * HALF + n * 16); bv[bj][n] = *(const f32x4*)(lnb + col0 + bj * HALF + n * 16); }
#pragma unroll
        for (int ai = 0; ai < 2; ++ai)
#pragma unroll
            for (int m = 0; m < 4; ++m) { const int rowl = ai * HALF + wr * 64 + m * 16 + fr; const size_t ro = (size_t)(u.pm * BM + rowl) * DM + col0;
                const float mean = tab[rowl * 2], rstd = tab[rowl * 2 + 1];
#pragma unroll
                for (int bj = 0; bj < 2; ++bj)
#pragma unroll
                    for (int n = 0; n < 2; ++n) { const f32x4 v = (acc[ai][bj][m][n] - mean) * rstd * gv[bj][n] + bv[bj][n];
                        *(f32x4*)(xf + ro + bj * HALF + n * 16) = v; *(u32x2*)(xb + ro + bj * HALF + n * 16) = (u32x2){pk2(v[0], v[1]), pk2(v[2], v[3])}; } }
        __syncthreads();
    }
};
template <int KK> struct ProbMerge {
    static constexpr bool PERM = false, GATHER = false, AFTER = false;
    const char* A; const char* Bt; static constexpr int K = KK, lda = 2048, ldb = 2048; int G, c;
    const bf16_t* p; bf16_t* mb;
    __device__ __forceinline__ bool next(int i, Unit& u) const { const int tile = (KK == 512 ? i : (i >> 1)) * G + c; if (tile >= 256) return false; u.pm = tile >> 2; u.pn = tile & 3; u.e = KK == 512 ? 0 : 1 + (i & 1); u.aux = 0; return true; }
    __device__ __forceinline__ const char* a_ptr(const Unit& u) const { return A + (size_t)u.pm * BM * lda + (KK == 512 ? 0 : 1024 + (u.e - 1) * 512); }
    __device__ __forceinline__ const char* b_ptr(const Unit& u) const { return Bt + (size_t)u.pn * BM * ldb + (KK == 512 ? 0 : 1024 + (u.e - 1) * 512); }
    __device__ __forceinline__ void gather_offs(const Unit&, int, unsigned (&)[2][2]) const {}
    __device__ __forceinline__ void epi(const Acc& acc, const Unit& u, int wr, int wc, int fr, int fq) const {
        const int row0 = u.pm * BM + wr * 64 + fr, col0 = u.pn * BM + wc * 32 + 4 * fq;
        const int gi = u.e;
        const bf16_t* __restrict__ mbr = mb; bf16_t* __restrict__ mbw = mb; const bf16_t* __restrict__ pr = p;
        u32x2 gr[2][2][2]; u32x2 pv[2][2][2];
#define MRG_LOAD(q, buf) do { const int row_ = row0 + ((q) >> 2) * HALF + ((q) & 3) * 16; const size_t ro_ = (size_t)row_ * DM + col0; \
            const bf16_t* gp_ = pr + (size_t)row_ * NP + COL_GATE + gi * 1024 + col0; \
            _Pragma("unroll") for (int bj = 0; bj < 2; ++bj) _Pragma("unroll") for (int n = 0; n < 2; ++n) { gr[buf][bj][n] = *(const u32x2*)(gp_ + bj * HALF + n * 16); \
                pv[buf][bj][n] = (KK != 512) ? *(const u32x2*)(mbr + ro_ + bj * HALF + n * 16) : (u32x2){0u, 0u}; } } while (0)
        MRG_LOAD(0, 0);
#pragma unroll
        for (int q = 0; q < 8; ++q) { const int ai = q >> 2, m = q & 3, buf = q & 1;
            if (q + 1 < 8) MRG_LOAD(q + 1, buf ^ 1);
            const int row = row0 + ai * HALF + m * 16; const size_t ro = (size_t)row * DM + col0;
#pragma unroll
            for (int bj = 0; bj < 2; ++bj)
#pragma unroll
                for (int n = 0; n < 2; ++n) { const u32x2 g2 = gr[buf][bj][n], p2 = pv[buf][bj][n];
                    f32x4 g; g[0] = sigmoid_f(bflo(g2[0])); g[1] = sigmoid_f(bfhi(g2[0])); g[2] = sigmoid_f(bflo(g2[1])); g[3] = sigmoid_f(bfhi(g2[1]));
                    const f32x4 v = g * acc[ai][bj][m][n] + (f32x4){bflo(p2[0]), bfhi(p2[0]), bflo(p2[1]), bfhi(p2[1])};
                    *(u32x2*)(mbw + ro + bj * HALF + n * 16) = (u32x2){pk2(v[0], v[1]), pk2(v[2], v[3])}; } }
#undef MRG_LOAD
    }
};
struct MoeOrder {
    int G, c, nN; const LAS int* tstart; const int* cnt;
    __device__ __forceinline__ bool next(int i, Unit& u) const {
        const int L = i * G + c; const int total = tstart[32] * nN; if (L >= total) return false;
        const int mt = L / nN; u.pn = L % nN; int e = 0;
        for (int k = 1; k < 32; ++k) e += (tstart[k] <= mt) ? 1 : 0;
        u.e = e; u.pm = mt; u.aux = (mt - tstart[e]) * BM; return true;
    }
};
__device__ __forceinline__ float swiglu_f(float g, float l) { g = fminf(g, 7.f); l = fminf(fmaxf(l, -7.f), 7.f); return g * sigmoid_f(1.702f * g) * (l + 1.f); }
struct ProbMoe1 : MoeOrder {
    static constexpr bool PERM = false, GATHER = true, AFTER = false;
    const char* A; const char* Bt; static constexpr int K = 1024, lda = 2048, ldb = 2048; const int* elist; const float* bgu; bf16_t* abuf;
    __device__ __forceinline__ const char* a_ptr(const Unit&) const { return A; }
    __device__ __forceinline__ const char* b_ptr(const Unit& u) const { return Bt + (size_t)u.e * 2048 * ldb + (size_t)u.pn * BM * ldb; }
    __device__ __forceinline__ void gather_offs(const Unit& u, int tid, unsigned (&off)[2][2]) const {
        const int n = cnt[u.e];
#pragma unroll
        for (int i = 0; i < 2; ++i) { int R, C; stage_rc(tid * 16 + i * 8192, R, C);
#pragma unroll
            for (int h = 0; h < 2; ++h) { const int rr = u.aux + h * HALF + R; const int tok = rr < n ? (elist[u.e * ECAP + rr] >> 2) : 0; off[h][i] = (unsigned)(tok * lda + C * 2); } }
    }
    __device__ __forceinline__ void epi(const Acc& acc, const Unit& u, int wr, int wc, int fr, int fq) const {
        const int row0 = u.pm * BM + wr * 64 + fr;
        const float* bb = bgu + (size_t)u.e * 2048;
#pragma unroll
        for (int bj = 0; bj < 2; ++bj) { const int g = u.pn * 8 + bj * 4 + wc; const int ac = 16 * g + 4 * fq;
            const f32x4 bg = *(const f32x4*)(bb + ac), bl = *(const f32x4*)(bb + 1024 + ac);
#pragma unroll
            for (int ai = 0; ai < 2; ++ai)
#pragma unroll
                for (int m = 0; m < 4; ++m) { const f32x4 vg = acc[ai][bj][m][0] + bg, vl = acc[ai][bj][m][1] + bl;
                    *(u32x2*)(abuf + (size_t)(row0 + ai * HALF + m * 16) * 1024 + ac) =
                        (u32x2){pk2(swiglu_f(vg[0], vl[0]), swiglu_f(vg[1], vl[1])), pk2(swiglu_f(vg[2], vl[2]), swiglu_f(vg[3], vl[3]))}; } }
    }
};
struct ProbMoe2 : MoeOrder {
    static constexpr bool PERM = true, GATHER = false, AFTER = false;
    const char* A; const char* Bt; static constexpr int K = 1024, lda = 2048, ldb = 2048; const int* elist; const float* bd; const float* tgate; bf16_t* ys;
    __device__ __forceinline__ const char* a_ptr(const Unit& u) const { return A + (size_t)u.pm * BM * lda; }
    __device__ __forceinline__ const char* b_ptr(const Unit& u) const { return Bt + (size_t)u.e * 1024 * ldb + (size_t)u.pn * BM * ldb; }
    __device__ __forceinline__ void gather_offs(const Unit&, int, unsigned (&)[2][2]) const {}
    __device__ __forceinline__ void epi(const Acc& acc, const Unit& u, int wr, int wc, int fr, int fq) const {
        const int n = cnt[u.e]; const int col0 = u.pn * BM + wc * 32 + 8 * fq;
        const float* bb = bd + (size_t)u.e * 1024 + col0;
        f32x4 bv[2][2];
#pragma unroll
        for (int bj = 0; bj < 2; ++bj)
#pragma unroll
            for (int nn = 0; nn < 2; ++nn) bv[bj][nn] = *(const f32x4*)(bb + bj * HALF + nn * 4);
        int aidx[2][4]; float gts[2][4];
#pragma unroll
        for (int ai = 0; ai < 2; ++ai)
#pragma unroll
            for (int m = 0; m < 4; ++m) { const int rr = u.aux + ai * HALF + wr * 64 + m * 16 + fr; aidx[ai][m] = (rr < n) ? elist[u.e * ECAP + rr] : -1; gts[ai][m] = (rr < n) ? tgate[u.e * ECAP + rr] : 0.f; }
#pragma unroll
        for (int ai = 0; ai < 2; ++ai)
#pragma unroll
            for (int m = 0; m < 4; ++m) {
                if (aidx[ai][m] >= 0) { const float g = gts[ai][m]; bf16_t* rowp = ys + (size_t)aidx[ai][m] * 1024 + col0;
#pragma unroll
                    for (int bj = 0; bj < 2; ++bj) { const f32x4 v0 = (acc[ai][bj][m][0] + bv[bj][0]) * g, v1 = (acc[ai][bj][m][1] + bv[bj][1]) * g;
                        *(u32x4*)(rowp + bj * HALF) = (u32x4){pk2(v0[0], v0[1]), pk2(v0[2], v0[3]), pk2(v1[0], v1[1]), pk2(v1[2], v1[3])}; } } }
    }
};

template <int MODE, int KK = 256> struct ProbAttn {
    static constexpr bool PERM = true, GATHER = false, AFTER = (MODE == 0);
    static constexpr int K = KK, lda = 2048, ldb = 2048;
    const char* A; const char* Bt; int G, c; float* sout; bf16_t* oout;
    __device__ __forceinline__ bool next(int i, Unit& u) const { const int L = i * G + c; if (L >= 256) return false; u.e = L >> 4; u.pm = L & 15; u.pn = 0; u.aux = 0; return true; }
    __device__ __forceinline__ const char* a_ptr(const Unit& u) const { const int b = u.e >> 2, h = u.e & 3; return A + ((size_t)(b * SEQL + u.pm * BM) * DM + (KK == 1024 ? 0 : h * 256)) * 2; }
    __device__ __forceinline__ const char* b_ptr(const Unit& u) const { const int b = u.e >> 2, h = u.e & 3;
        if (KK == 1024) return Bt + (size_t)u.e * 256 * 2048;
        return MODE == 0 ? Bt + ((size_t)(b * 256) * DM + h * 256) * 2 : Bt + ((size_t)b * 1024 * 1024 + (size_t)h * 256 * 1024) * 2; }
    __device__ __forceinline__ void gather_offs(const Unit&, int, unsigned (&)[2][2]) const {}
    __device__ __forceinline__ void epi_after(Acc& acc, const Unit& u, int wr, int wc, int fr, int fq, LAS unsigned char* lds) const {
        const int b = u.e >> 2, h = u.e & 3; const int grow0 = b * SEQL + u.pm * BM;
        LAS float* redm = (LAS float*)lds; LAS float* reds = (LAS float*)(lds + 4096);
#pragma unroll
        for (int ai = 0; ai < 2; ++ai)
#pragma unroll
            for (int m = 0; m < 4; ++m) { float v = -3e38f;
#pragma unroll
                for (int bj = 0; bj < 2; ++bj)
#pragma unroll
                    for (int n = 0; n < 2; ++n) v = fmaxf(v, fmaxf(fmaxf(acc[ai][bj][m][n][0], acc[ai][bj][m][n][1]), fmaxf(acc[ai][bj][m][n][2], acc[ai][bj][m][n][3])));
                v = fmaxf(v, __shfl_xor(v, 16)); v = fmaxf(v, __shfl_xor(v, 32));
                if (fq == 0) redm[(ai * HALF + wr * 64 + m * 16 + fr) * 4 + wc] = v; }
        __syncthreads();
#pragma unroll
        for (int ai = 0; ai < 2; ++ai)
#pragma unroll
            for (int m = 0; m < 4; ++m) { const int row = ai * HALF + wr * 64 + m * 16 + fr; const f32x4 r = *(const LAS f32x4*)(redm + row * 4);
                const float M = fmaxf(fmaxf(r[0], r[1]), fmaxf(r[2], r[3])); float sm = 0.f;
#pragma unroll
                for (int bj = 0; bj < 2; ++bj)
#pragma unroll
                    for (int n = 0; n < 2; ++n)
#pragma unroll
                        for (int j = 0; j < 4; ++j) { const float e = __expf((acc[ai][bj][m][n][j] - M) * 0.0625f); acc[ai][bj][m][n][j] = e; sm += e; }
                sm += __shfl_xor(sm, 16); sm += __shfl_xor(sm, 32);
                if (fq == 0) reds[row * 4 + wc] = sm; }
        __syncthreads();
#pragma unroll
        for (int ai = 0; ai < 2; ++ai)
#pragma unroll
            for (int m = 0; m < 4; ++m) { const int row = ai * HALF + wr * 64 + m * 16 + fr; const f32x4 r = *(const LAS f32x4*)(reds + row * 4);
                const float inv = __builtin_amdgcn_rcpf((r[0] + r[1]) + (r[2] + r[3]));
                bf16_t* rowp = oout + (size_t)(grow0 + row) * DM + h * 256 + wc * 32 + 8 * fq;
#pragma unroll
                for (int bj = 0; bj < 2; ++bj) { const f32x4 v0 = acc[ai][bj][m][0] * inv, v1 = acc[ai][bj][m][1] * inv;
                    *(u32x4*)(rowp + bj * HALF) = (u32x4){pk2(v0[0], v0[1]), pk2(v0[2], v0[3]), pk2(v1[0], v1[1]), pk2(v1[2], v1[3])}; } }
        __syncthreads();
    }
    __device__ __forceinline__ void epi(const Acc& acc, const Unit& u, int wr, int wc, int fr, int fq) const {
        const int b = u.e >> 2, h = u.e & 3; const int row0 = b * SEQL + u.pm * BM + wr * 64 + fr;
        if (MODE == 0) { const int col0 = h * 256 + wc * 32 + 4 * fq;
#pragma unroll
            for (int ai = 0; ai < 2; ++ai)
#pragma unroll
                for (int m = 0; m < 4; ++m) { float* rowp = sout + (size_t)(row0 + ai * HALF + m * 16) * DM + col0;
#pragma unroll
                    for (int bj = 0; bj < 2; ++bj)
#pragma unroll
                        for (int n = 0; n < 2; ++n) *(f32x4*)(rowp + bj * HALF + n * 16) = acc[ai][bj][m][n] * 0.0625f; }
        } else { const int colt = h * 256 + wc * 32 + 8 * fq;
#pragma unroll
            for (int ai = 0; ai < 2; ++ai)
#pragma unroll
                for (int m = 0; m < 4; ++m) { bf16_t* rowp = oout + (size_t)(row0 + ai * HALF + m * 16) * DM + colt;
#pragma unroll
                    for (int bj = 0; bj < 2; ++bj) { const f32x4 v0 = acc[ai][bj][m][0], v1 = acc[ai][bj][m][1];
                        *(u32x4*)(rowp + bj * HALF) = (u32x4){pk2(v0[0], v0[1]), pk2(v0[2], v0[3]), pk2(v1[0], v1[1]), pk2(v1[2], v1[3])}; } }
        }
    }
};
__device__ __forceinline__ void phase_softmax(const Params& P) {
    const int tid = ltid(); const int lane = tid & 63, wid = __builtin_amdgcn_readfirstlane(tid >> 6); const int gw = blockIdx.x * 8 + wid, NGW = gridDim.x * 8;
    const float* S = (const float*)(P.ws + WS_MRGF); bf16_t* Pb = (bf16_t*)(P.ws + WS_QB);
    for (int r = gw; r < NTOK * 4; r += NGW) { const size_t o = (size_t)r * 256 + lane * 4;
        const f32x4 v = *(const f32x4*)(S + o);
        const float mx = wave_max(fmaxf(fmaxf(v[0], v[1]), fmaxf(v[2], v[3])));
        const float e0 = __expf(v[0] - mx), e1 = __expf(v[1] - mx), e2 = __expf(v[2] - mx), e3 = __expf(v[3] - mx);
        const float inv = 1.f / wave_sum((e0 + e1) + (e2 + e3));
        *(u32x2*)(Pb + o) = (u32x2){pk2(e0 * inv, e1 * inv), pk2(e2 * inv, e3 * inv)}; }
}

__device__ __forceinline__ void tr_item(const float* __restrict__ src, int ldn, int scol, int k0, bf16_t* dst0, int ldk, LAS unsigned char* wl, int lane) {
    float v[64];
    const bool valid = scol >= 0;
    const float* s = src + (size_t)k0 * ldn + (valid ? scol : 0);
#pragma unroll
    for (int kk = 0; kk < 64; ++kk) v[kk] = s[(size_t)kk * ldn];
#pragma unroll
    for (int c = 0; c < 8; ++c) { u32x4 w;
#pragma unroll
        for (int q = 0; q < 4; ++q) w[q] = valid ? pk2(v[8 * c + 2 * q], v[8 * c + 2 * q + 1]) : 0u;
        *(LAS u32x4*)(wl + lane * 144 + c * 16) = w; }
    WBAR();
#pragma unroll
    for (int it = 0; it < 8; ++it) { const int row = it * 8 + (lane >> 3), c16 = lane & 7; const u32x4 w = *(const LAS u32x4*)(wl + row * 144 + c16 * 16);
        *(u32x4*)(dst0 + (size_t)row * ldk + c16 * 8) = w; }
    WBAR();
}
__device__ __forceinline__ void row_to_bf16(const float* src, bf16_t* dst, int lane) {
#pragma unroll
    for (int j = 0; j < 4; ++j) { const f32x4 v = *(const f32x4*)(src + j * 256 + lane * 4); *(u32x2*)(dst + j * 256 + lane * 4) = (u32x2){pk2(v[0], v[1]), pk2(v[2], v[3])}; }
}
__device__ __forceinline__ void phase_convert(const Params& P, LAS unsigned char* lds) {
    const int tid = ltid(); const int lane = tid & 63, wid = __builtin_amdgcn_readfirstlane(tid >> 6);
    const int gw = blockIdx.x * 8 + wid, NGW = gridDim.x * 8;
    LAS unsigned char* wl = lds + wid * 9216;
    unsigned char* ws = P.ws;
    constexpr int I_WIN = 16 * 88, I_SQ = 256, I_GU = 32 * 512, I_D = 32 * 256, I_L = I_WIN + 6 * I_SQ + I_GU + I_D;
    for (int it = gw; it < 2 * I_L; it += NGW) {
        const int l = it / I_L; int r = it % I_L;
        if (r < I_WIN) { const int ntl = r % 88, kt = r / 88; const int n = ntl * 64 + lane;
            const int sc = n < COL_UV ? n : (n < COL_GL ? n + 16 : (n < NIN ? n - COL_GL + COL_UV : -1));
            tr_item(P.in[2] + (size_t)l * 1024 * NIN, NIN, sc, kt * 64, (bf16_t*)(ws + WS_WIN + l * SZ_WIN) + (size_t)ntl * 64 * 1024 + kt * 64, 1024, wl, lane); continue; }
        r -= I_WIN;
        if (r < I_SQ) {
            const int ntl = r % 16, kt = r / 16; const float* src; int kk;
            if (kt < 8) { src = P.in[13] + (size_t)l * 512 * 1024; kk = kt; } else if (kt < 12) { src = P.in[14] + (size_t)l * 256 * 1024; kk = kt - 8; } else { src = P.in[15] + (size_t)l * 256 * 1024; kk = kt - 12; }
            tr_item(src, 1024, ntl * 64 + lane, kk * 64, (bf16_t*)(ws + WS_WUP + l * SZ_SQ) + (size_t)ntl * 64 * 1024 + kt * 64, 1024, wl, lane); continue; }
        r -= I_SQ;
        if (r < 5 * I_SQ) { const int w = r / I_SQ; const int rr = r % I_SQ; const int ntl = rr % 16, kt = rr / 16;
            const int ii = w == 0 ? 16 : 18 + w;
            const size_t wso = w == 0 ? WS_WO : (w == 1 ? WS_OB : (w == 2 ? WS_WK : (w == 3 ? WS_WV : WS_WXO)));
            tr_item(P.in[ii] + (size_t)l * 1024 * 1024, 1024, ntl * 64 + lane, kt * 64, (bf16_t*)(ws + wso + l * SZ_SQ) + (size_t)ntl * 64 * 1024 + kt * 64, 1024, wl, lane); continue; }
        r -= 5 * I_SQ;
        if (r < I_GU) { const int e = r / 512; const int rr = r % 512; const int ntl = rr % 32, kt = rr / 32; const int n = ntl * 64 + lane; const int g = n >> 5, w = n & 31;
            const int sc = w < 16 ? 16 * g + w : 1024 + 16 * g + (w - 16);
            tr_item(P.in[27] + ((size_t)l * 32 + e) * 1024 * 2048, 2048, sc, kt * 64, (bf16_t*)(ws + WS_WGU + l * SZ_WGU) + ((size_t)e * 2048 + ntl * 64) * 1024 + kt * 64, 1024, wl, lane); continue; }
        r -= I_GU;
        { const int e = r / 256; const int rr = r % 256; const int ntl = rr % 16, kt = rr / 16;
            tr_item(P.in[29] + ((size_t)l * 32 + e) * 1024 * 1024, 1024, ntl * 64 + lane, kt * 64, (bf16_t*)(ws + WS_WD + l * SZ_WD) + ((size_t)e * 1024 + ntl * 64) * 1024 + kt * 64, 1024, wl, lane); }
    }
    for (int m = gw; m < NTOK + 1024 + 2048; m += NGW) {
        if (m < NTOK) row_to_bf16(P.in[0] + (size_t)m * DM, (bf16_t*)(ws + WS_XB) + (size_t)m * DM, lane);
        else if (m >= NTOK + 1024) row_to_bf16(P.in[19] + (size_t)(m - NTOK - 1024) * DM, (bf16_t*)(ws + WS_WQ) + (size_t)(m - NTOK - 1024) * DM, lane);
        else row_to_bf16(P.in[1] + (size_t)(m - NTOK) * DM, (bf16_t*)(ws + WS_MEMB) + (size_t)(m - NTOK) * DM, lane);
    }
}

__device__ __forceinline__ bf16x8 ldfrag(const LAS bf16_t* base, int row, int stride, int k) { return *(const LAS bf16x8*)(base + row * stride + k); }

__device__ __forceinline__ void sgu_item(const Params& P, int l, int item, LAS unsigned char* lds) {
    const int tid = ltid(), lane = tid & 63, wid = tid >> 6, fr = lane & 15, fq = lane >> 4;
    const bf16_t* p = (const bf16_t*)(P.ws + WS_P); bf16_t* ycat = (bf16_t*)(P.ws + WS_YCAT);
    const int t0 = item * 128;
    LAS bf16_t* vnT = (LAS bf16_t*)lds;
    LAS bf16_t* wsb = (LAS bf16_t*)(lds + 69632);
    LAS float* red = (LAS float*)(lds + 69632 + 34816);
    {
        const int t = tid & 127, qd = tid >> 7;
        const bf16_t* src = p + (size_t)(t0 + t) * NP + COL_UV + 256 + qd * 64;
        float s = 0.f, ss = 0.f;
#pragma unroll
        for (int c = 0; c < 8; ++c) { const u32x4 w = *(const u32x4*)(src + c * 8);
#pragma unroll
            for (int q = 0; q < 4; ++q) { const float a = gelu_f(bflo(w[q])), b = gelu_f(bfhi(w[q])); s += a + b; ss += a * a + b * b; } }
        red[(t * 4 + qd) * 2] = s; red[(t * 4 + qd) * 2 + 1] = ss;
        __syncthreads();
        float S = 0.f, SS = 0.f;
#pragma unroll
        for (int q = 0; q < 4; ++q) { S += red[(t * 4 + q) * 2]; SS += red[(t * 4 + q) * 2 + 1]; }
        const float mean = S * (1.f / 256.f), var = fmaxf(SS * (1.f / 256.f) - mean * mean, 0.f), rstd = rsqrtf(var + LN_EPS);
        const float* lg = P.in[7] + l * 256 + qd * 64; const float* lb = P.in[8] + l * 256 + qd * 64;
#pragma unroll 2
        for (int c = 0; c < 8; ++c) { const u32x4 w = *(const u32x4*)(src + c * 8);
#pragma unroll
            for (int q = 0; q < 4; ++q) { const float a = gelu_f(bflo(w[q])), b = gelu_f(bfhi(w[q])); const int ch = c * 8 + 2 * q;
                vnT[(qd * 64 + ch) * 136 + t] = f2bf((a - mean) * rstd * lg[ch] + lb[ch]);
                vnT[(qd * 64 + ch + 1) * 136 + t] = f2bf((b - mean) * rstd * lg[ch + 1] + lb[ch + 1]); } }
    }
    for (int g = 0; g < 4; ++g) {
        __syncthreads();
        const float* wsg = P.in[9] + ((size_t)l * 4 + g) * 128 * 128;
#pragma unroll
        for (int i = 0; i < 4; ++i) { const int id = tid + i * 512; const int t = id >> 4, s8 = (id & 15) * 8;
            const f32x4 a = *(const f32x4*)(wsg + t * 128 + s8), b = *(const f32x4*)(wsg + t * 128 + s8 + 4);
            float w[8] = {a[0], a[1], a[2], a[3], b[0], b[1], b[2], b[3]};
#pragma unroll
            for (int q = 0; q < 8; ++q) w[q] = (s8 + q <= t) ? w[q] : 0.f;
            *(LAS u32x4*)(wsb + t * 136 + s8) = (u32x4){pk2(w[0], w[1]), pk2(w[2], w[3]), pk2(w[4], w[5]), pk2(w[6], w[7])}; }
        __syncthreads();
#pragma unroll
        for (int q = 0; q < 4; ++q) { const int tile = wid * 4 + q; const int ti = tile >> 2, di = tile & 3;
            f32x4 acc = {0.f, 0.f, 0.f, 0.f};
            const int ksmax = (ti * 16 + 15) >> 5;
            for (int ks = 0; ks <= ksmax; ++ks) {
                const bf16x8 a = ldfrag(wsb, ti * 16 + fr, 136, ks * 32 + 8 * fq), b = ldfrag(vnT, g * 64 + di * 16 + fr, 136, ks * 32 + 8 * fq);
                acc = __builtin_amdgcn_mfma_f32_16x16x32_bf16(a, b, acc, 0, 0, 0); }
            const int ch = g * 64 + di * 16 + fr;
#pragma unroll
            for (int j = 0; j < 4; ++j) { const int t = ti * 16 + 4 * fq + j;
                const float sv = acc[j] + P.in[10][((size_t)l * 4 + g) * 128 + t];
                const float u = gelu_f(bf2f(p[(size_t)(t0 + t) * NP + COL_UV + ch]));
                ycat[(size_t)(t0 + t) * DM + 512 + ch] = f2bf(u * sv); } }
    }
    __syncthreads();
}

__device__ __forceinline__ void gla1_item(const Params& P, int l, int idx, LAS unsigned char* lds) {
    const int tid = ltid();
    const bf16_t* p = (const bf16_t*)(P.ws + WS_P);
    float* bcum = (float*)(P.ws + WS_BCUM); float* kvT = (float*)(P.ws + WS_KVT); float* cdec = (float*)(P.ws + WS_CDEC);
    const int h = idx & 3, bn = idx >> 2; const int t0 = bn * 64;
    LAS float* gl = (LAS float*)lds;
    LAS float* tot = (LAS float*)(lds + 4096);
    LAS float* kt = (LAS float*)(lds + 8192);
    LAS float* vs = (LAS float*)(lds + 8192 + 16384);
#pragma unroll
    for (int i = 0; i < 2; ++i) { const int id = tid + i * 512; gl[id] = bf2f(p[(size_t)(t0 + (id >> 4)) * NP + COL_GL + (id & 15)]); }
#pragma unroll
    for (int i = 0; i < 2; ++i) { const int id = tid + i * 512; const int t = id >> 4, e8 = (id & 15) * 8;
        const u32x4 w = *(const u32x4*)(p + (size_t)(t0 + t) * NP + COL_V + h * 128 + e8);
        *(LAS f32x4*)(vs + t * 128 + e8) = (f32x4){bflo(w[0]), bfhi(w[0]), bflo(w[1]), bfhi(w[1])};
        *(LAS f32x4*)(vs + t * 128 + e8 + 4) = (f32x4){bflo(w[2]), bfhi(w[2]), bflo(w[3]), bfhi(w[3])}; }
    __syncthreads();
    {
        const int tq = tid >> 6, d = tid & 63;
        float wreg[16];
#pragma unroll
        for (int r = 0; r < 16; ++r) wreg[r] = P.in[4][((size_t)l * 16 + r) * 256 + h * 64 + d];
        const float bgv = P.in[5][l * 256 + h * 64 + d];
        float pre[8]; float run = 0.f;
#pragma unroll
        for (int i = 0; i < 8; ++i) { const int t = tq * 8 + i; float z = bgv;
#pragma unroll
            for (int r = 0; r < 16; ++r) z += gl[t * 16 + r] * wreg[r];
            const float ls = fminf(z, 0.f) - log1pf(__expf(-fabsf(z)));
            run += ls * (1.f / 16.f); pre[i] = run; }
        tot[tq * 64 + d] = run;
        __syncthreads();
        float off = 0.f, total = 0.f;
#pragma unroll
        for (int g = 0; g < 8; ++g) { const float x = tot[g * 64 + d]; total += x; off += (g < tq) ? x : 0.f; }
#pragma unroll
        for (int i = 0; i < 8; ++i) { const int t = tq * 8 + i; const float bv = off + pre[i];
            bcum[(size_t)(t0 + t) * 256 + h * 64 + d] = bv;
            kt[t * 64 + d] = bf2f(p[(size_t)(t0 + t) * NP + COL_K + h * 64 + d]) * __expf(total - bv); }
        if (tq == 0) cdec[idx * 64 + d] = __expf(total);
    }
    __syncthreads();
    {
        const int d4 = tid & 15, e4 = tid >> 4;
        f32x4 a0 = {0.f, 0.f, 0.f, 0.f}, a1 = a0, a2 = a0, a3 = a0;
        for (int t = 0; t < 64; ++t) { const f32x4 kv = *(const LAS f32x4*)(kt + t * 64 + 4 * d4), vv = *(const LAS f32x4*)(vs + t * 128 + 4 * e4);
            a0 += kv * vv[0]; a1 += kv * vv[1]; a2 += kv * vv[2]; a3 += kv * vv[3]; }
        float* o = kvT + (size_t)idx * 8192 + (4 * e4) * 64 + 4 * d4;
        *(f32x4*)(o) = a0; *(f32x4*)(o + 64) = a1; *(f32x4*)(o + 128) = a2; *(f32x4*)(o + 192) = a3;
    }
    __syncthreads();
}

__device__ __forceinline__ void pool_item(const Params& P, int l, int item, LAS unsigned char* lds) {
    const int tid = ltid(), lane = tid & 63, wid = tid >> 6, fr = lane & 15, fq = lane >> 4;
    const bf16_t* p = (const bf16_t*)(P.ws + WS_P); bf16_t* ycat = (bf16_t*)(P.ws + WS_YCAT);
    const int T0 = item * 64, pos0 = T0 & (SEQL - 1);
    LAS bf16_t* xs = (LAS bf16_t*)lds;
    LAS bf16_t* ybf = (LAS bf16_t*)(lds + 42240);
    LAS bf16_t* pwT = (LAS bf16_t*)(lds + 42240 + 33792);
#pragma unroll
    for (int i = 0; i < 5; ++i) { const int id = tid + i * 512; const int r = id >> 5, c8 = (id & 31) * 8;
        u32x4 w = {0u, 0u, 0u, 0u};
        if (pos0 - 16 + r >= 0) w = *(const u32x4*)(p + (size_t)(T0 - 16 + r) * NP + COL_XC + c8);
        *(LAS u32x4*)(xs + r * 264 + c8) = w; }
    const float* pw = P.in[11] + (size_t)l * 4 * 64 * 64;
#pragma unroll 4
    for (int i = 0; i < 32; ++i) { const int id = tid + i * 512; const int g = id >> 12, c = (id >> 6) & 63, dd = id & 63; pwT[(g * 64 + dd) * 72 + c] = f2bf(pw[id]); }
    __syncthreads();
    {
        const int ch = tid & 255, th = tid >> 8; const int gi = ch >> 6, w = 2 << gi;
        float sum = 0.f;
        for (int j = 1; j < w; ++j) sum += bf2f(xs[(16 + th * 32 - j) * 264 + ch]);
        for (int tt = 0; tt < 32; ++tt) { const int t = th * 32 + tt; const float x = bf2f(xs[(16 + t) * 264 + ch]);
            sum += x; const int pos = pos0 + t; const float cntf = (float)min(pos + 1, w);
            ybf[t * 264 + ch] = f2bf(sum / cntf - x);
            sum -= bf2f(xs[(16 + t - w + 1) * 264 + ch]); }
    }
    __syncthreads();
#pragma unroll
    for (int q = 0; q < 8; ++q) { const int tile = wid * 8 + q; const int g = tile >> 4, ti = (tile >> 2) & 3, di = tile & 3;
        f32x4 acc = {0.f, 0.f, 0.f, 0.f};
#pragma unroll
        for (int ks = 0; ks < 2; ++ks) { const bf16x8 a = ldfrag(ybf, ti * 16 + fr, 264, g * 64 + ks * 32 + 8 * fq), b = ldfrag(pwT, g * 64 + di * 16 + fr, 72, ks * 32 + 8 * fq);
            acc = __builtin_amdgcn_mfma_f32_16x16x32_bf16(a, b, acc, 0, 0, 0); }
        const int ch = g * 64 + di * 16 + fr; const float sc = P.in[12][l * 256 + ch];
#pragma unroll
        for (int j = 0; j < 4; ++j) ycat[(size_t)(T0 + ti * 16 + 4 * fq + j) * DM + 768 + ch] = f2bf(acc[j] * sc); }
    __syncthreads();
}

__device__ __forceinline__ void phase_mixer_local(const Params& P, int l, LAS unsigned char* lds) {
    constexpr int N_SGU = 128, N_GLA = 1024, N_POOL = 256;
    if (gridDim.x == 256) {
        const int b = blockIdx.x; int first, cntn;
        if (b < N_SGU) { sgu_item(P, l, b, lds); first = b * 3; cntn = 3; } else { first = 384 + (b - N_SGU) * 7; cntn = 7; }
        for (int k = 0; k < cntn; ++k) { const int it = first + k; if (it < N_GLA) gla1_item(P, l, it, lds); else pool_item(P, l, it - N_GLA, lds); }
        return;
    }
    for (int it = blockIdx.x; it < N_SGU + N_GLA + N_POOL; it += gridDim.x) {
        if (it < N_SGU) sgu_item(P, l, it, lds);
        else if (it < N_SGU + N_GLA) gla1_item(P, l, it - N_SGU, lds);
        else pool_item(P, l, it - N_SGU - N_GLA, lds);
    }
}

__device__ __forceinline__ void phase_scan(const Params& P) {
    const float* kvT = (const float*)(P.ws + WS_KVT); const float* cdec = (const float*)(P.ws + WS_CDEC); bf16_t* sT = (bf16_t*)(P.ws + WS_ST);
    for (int g = blockIdx.x * 512 + ltid(); g < 16 * 8192; g += gridDim.x * 512) {
        const int bh = g >> 13, ed = g & 8191, d = ed & 63, b = bh >> 2, h = bh & 3;
        float S = 0.f;
#pragma unroll 8
        for (int n = 0; n < 64; ++n) { const int ci = (b * 64 + n) * 4 + h;
            sT[(size_t)ci * 8192 + ed] = f2bf(S);
            S = cdec[ci * 64 + d] * S + kvT[(size_t)ci * 8192 + ed]; }
    }
}

struct G2R { u32x4 qw, kw, vw0, vw1, sw0, sw1, r0, r1; f32x4 b0, b1; };
__device__ __forceinline__ void gla2_load(const Params& P, int idx, int tid, G2R& r) {
    const bf16_t* p = (const bf16_t*)(P.ws + WS_P); const float* bcum = (const float*)(P.ws + WS_BCUM); const bf16_t* sT = (const bf16_t*)(P.ws + WS_ST);
    const int h = idx & 3, bn = idx >> 2; const int t0 = bn * 64;
    const int t = tid >> 3, c8 = (tid & 7) * 8;
    r.qw = *(const u32x4*)(p + (size_t)(t0 + t) * NP + h * 64 + c8); r.kw = *(const u32x4*)(p + (size_t)(t0 + t) * NP + COL_K + h * 64 + c8);
    r.b0 = *(const f32x4*)(bcum + (size_t)(t0 + t) * 256 + h * 64 + c8); r.b1 = *(const f32x4*)(bcum + (size_t)(t0 + t) * 256 + h * 64 + c8 + 4);
    { const int id = tid; const int tt = id >> 4, e8 = (id & 15) * 8; r.vw0 = *(const u32x4*)(p + (size_t)(t0 + tt) * NP + COL_V + h * 128 + e8); }
    { const int id = tid + 512; const int tt = id >> 4, e8 = (id & 15) * 8; r.vw1 = *(const u32x4*)(p + (size_t)(t0 + tt) * NP + COL_V + h * 128 + e8); }
    { const int id = tid; const int e = id >> 3, d8 = (id & 7) * 8; r.sw0 = *(const u32x4*)(sT + (size_t)idx * 8192 + e * 64 + d8); }
    { const int id = tid + 512; const int e = id >> 3, d8 = (id & 7) * 8; r.sw1 = *(const u32x4*)(sT + (size_t)idx * 8192 + e * 64 + d8); }
    { const int seg = tid & 7; const bf16_t* rp = p + (size_t)(t0 + t) * NP + COL_R + h * 128 + seg * 16; r.r0 = *(const u32x4*)rp; r.r1 = *(const u32x4*)(rp + 8); }
}
__device__ __forceinline__ void gla2_item(const Params& P, int l, int idx, int nidx, const G2R& R, G2R& RN, LAS unsigned char* lds) {
    const int tid = ltid(), lane = tid & 63, wid = tid >> 6, fr = lane & 15, fq = lane >> 4;
    bf16_t* ycat = (bf16_t*)(P.ws + WS_YCAT);
    const int h = idx & 3, bn = idx >> 2; const int t0 = bn * 64;
    LAS bf16_t* qd = (LAS bf16_t*)lds;
    LAS bf16_t* kd = (LAS bf16_t*)(lds + 9216);
    LAS bf16_t* vT = (LAS bf16_t*)(lds + 18432);
    LAS bf16_t* Ps = (LAS bf16_t*)(lds + 36864);
    LAS bf16_t* sTs = (LAS bf16_t*)(lds + 46080);
    LAS float* of = (LAS float*)(lds + 64512);
    {
        const int t = tid >> 3, c8 = (tid & 7) * 8;
        const u32x4 qw = R.qw, kw = R.kw; const f32x4 b0 = R.b0, b1 = R.b1;
        float bb[8] = {b0[0], b0[1], b0[2], b0[3], b1[0], b1[1], b1[2], b1[3]}; float qv[8], kv[8];
#pragma unroll
        for (int q = 0; q < 4; ++q) { qv[2 * q] = bflo(qw[q]); qv[2 * q + 1] = bfhi(qw[q]); kv[2 * q] = bflo(kw[q]); kv[2 * q + 1] = bfhi(kw[q]); }
#pragma unroll
        for (int q = 0; q < 8; ++q) { const float e = __expf(bb[q]); qv[q] = qv[q] * 0.125f * e; kv[q] = kv[q] * __expf(-bb[q]); }
        *(LAS u32x4*)(qd + t * 72 + c8) = (u32x4){pk2(qv[0], qv[1]), pk2(qv[2], qv[3]), pk2(qv[4], qv[5]), pk2(qv[6], qv[7])};
        *(LAS u32x4*)(kd + t * 72 + c8) = (u32x4){pk2(kv[0], kv[1]), pk2(kv[2], kv[3]), pk2(kv[4], kv[5]), pk2(kv[6], kv[7])};
#pragma unroll
        for (int i = 0; i < 2; ++i) { const int id = tid + i * 512; const int tt = id >> 4, e8 = (id & 15) * 8;
            const u32x4 w = i == 0 ? R.vw0 : R.vw1;
#pragma unroll
            for (int q = 0; q < 4; ++q) { vT[(e8 + 2 * q) * 72 + tt] = (bf16_t)(w[q] & 0xffffu); vT[(e8 + 2 * q + 1) * 72 + tt] = (bf16_t)(w[q] >> 16); } }
#pragma unroll
        for (int i = 0; i < 2; ++i) { const int id = tid + i * 512; const int e = id >> 3, d8 = (id & 7) * 8;
            *(LAS u32x4*)(sTs + e * 72 + d8) = i == 0 ? R.sw0 : R.sw1; }
    }
    __syncthreads();
    if (nidx >= 0) gla2_load(P, nidx, tid, RN);
#pragma unroll
    for (int q = 0; q < 2; ++q) { const int tile = wid * 2 + q; const int ti = tile >> 2, si = tile & 3;
        f32x4 acc = {0.f, 0.f, 0.f, 0.f};
        if (si <= ti) {
#pragma unroll
            for (int ks = 0; ks < 2; ++ks) { const bf16x8 a = ldfrag(qd, ti * 16 + fr, 72, ks * 32 + 8 * fq), b = ldfrag(kd, si * 16 + fr, 72, ks * 32 + 8 * fq);
                acc = __builtin_amdgcn_mfma_f32_16x16x32_bf16(a, b, acc, 0, 0, 0); } }
        const int s = si * 16 + fr;
#pragma unroll
        for (int j = 0; j < 4; ++j) { const int t = ti * 16 + 4 * fq + j; Ps[t * 72 + s] = f2bf(s <= t ? acc[j] : 0.f); } }
    __syncthreads();
#pragma unroll
    for (int q = 0; q < 4; ++q) { const int tile = wid * 4 + q; const int ti = tile >> 3, ei = tile & 7;
        f32x4 acc = {0.f, 0.f, 0.f, 0.f};
#pragma unroll
        for (int ks = 0; ks < 2; ++ks) { const bf16x8 a = ldfrag(Ps, ti * 16 + fr, 72, ks * 32 + 8 * fq), b = ldfrag(vT, ei * 16 + fr, 72, ks * 32 + 8 * fq);
            acc = __builtin_amdgcn_mfma_f32_16x16x32_bf16(a, b, acc, 0, 0, 0); }
#pragma unroll
        for (int ks = 0; ks < 2; ++ks) { const bf16x8 a = ldfrag(qd, ti * 16 + fr, 72, ks * 32 + 8 * fq), b = ldfrag(sTs, ei * 16 + fr, 72, ks * 32 + 8 * fq);
            acc = __builtin_amdgcn_mfma_f32_16x16x32_bf16(a, b, acc, 0, 0, 0); }
#pragma unroll
        for (int j = 0; j < 4; ++j) of[(ti * 16 + 4 * fq + j) * 132 + ei * 16 + fr] = acc[j]; }
    __syncthreads();
    {
        const int t = tid >> 3, seg = tid & 7;
        float o[16]; float ss = 0.f;
#pragma unroll
        for (int q = 0; q < 4; ++q) { const f32x4 v = *(const LAS f32x4*)(of + t * 132 + seg * 16 + 4 * q); o[4 * q] = v[0]; o[4 * q + 1] = v[1]; o[4 * q + 2] = v[2]; o[4 * q + 3] = v[3]; ss += v[0] * v[0] + v[1] * v[1] + v[2] * v[2] + v[3] * v[3]; }
        ss += __shfl_xor(ss, 1); ss += __shfl_xor(ss, 2); ss += __shfl_xor(ss, 4);
        const float rstd = rsqrtf(ss * (1.f / 128.f) + LN_EPS);
        const float* gn = P.in[6] + l * 512 + h * 128 + seg * 16;
        const u32x4 r0 = R.r0, r1 = R.r1;
        float rv[16];
#pragma unroll
        for (int q = 0; q < 4; ++q) { rv[2 * q] = bflo(r0[q]); rv[2 * q + 1] = bfhi(r0[q]); rv[8 + 2 * q] = bflo(r1[q]); rv[8 + 2 * q + 1] = bfhi(r1[q]); }
        float y[16];
#pragma unroll
        for (int q = 0; q < 16; ++q) y[q] = o[q] * rstd * gn[q] * (rv[q] * sigmoid_f(rv[q]));
        bf16_t* yo = ycat + (size_t)(t0 + t) * DM + h * 128 + seg * 16;
        *(u32x4*)yo = (u32x4){pk2(y[0], y[1]), pk2(y[2], y[3]), pk2(y[4], y[5]), pk2(y[6], y[7])};
        *(u32x4*)(yo + 8) = (u32x4){pk2(y[8], y[9]), pk2(y[10], y[11]), pk2(y[12], y[13]), pk2(y[14], y[15])};
    }
    __syncthreads();
}

__device__ __forceinline__ void attn_item(const Params& P, int l, int item, LAS unsigned char* lds) {
    const int tid = ltid(), lane = tid & 63, wid = tid >> 6, fr = lane & 15, fq = lane >> 4;
    const int qt = item & 31, h = (item >> 5) & 3, b = item >> 7;
    const bf16_t* qb = (const bf16_t*)(P.ws + WS_QB) + (size_t)(b * SEQL + qt * 128) * DM + h * 256;
    const bf16_t* km = (const bf16_t*)(P.ws + WS_KM + l * SZ_SQ) + (size_t)(b * 256) * DM + h * 256;
    const bf16_t* vt = (const bf16_t*)(P.ws + WS_VT + l * SZ_SQ) + ((size_t)b * 1024 + h * 256) * 256;
    bf16_t* ob = (bf16_t*)(P.ws + WS_OB) + (size_t)(b * SEQL + qt * 128) * DM + h * 256;
    LAS bf16_t* QP = (LAS bf16_t*)lds;
    LAS bf16_t* KV = (LAS bf16_t*)(lds + 67584);
#pragma unroll
    for (int i = 0; i < 8; ++i) { const int id = tid + i * 512; const int r = id >> 5, c8 = (id & 31) * 8; *(LAS u32x4*)(QP + r * 264 + c8) = *(const u32x4*)(qb + (size_t)r * DM + c8); }
    u32x4 pre[4];
#pragma unroll
    for (int i = 0; i < 4; ++i) { const int id = tid + i * 512; const int r = id >> 5, c8 = (id & 31) * 8; pre[i] = *(const u32x4*)(km + (size_t)r * DM + c8); }
#pragma unroll
    for (int i = 0; i < 4; ++i) { const int id = tid + i * 512; const int r = id >> 5, c8 = (id & 31) * 8; *(LAS u32x4*)(KV + r * 264 + c8) = pre[i]; }
    __syncthreads();
#ifdef ATT_DBG0
    {
#if ATT_DBG0 == 1
#pragma unroll
    for (int i = 0; i < 8; ++i) { const int id = tid + i * 512; const int r = id >> 5, c8 = (id & 31) * 8; *(u32x4*)(ob + (size_t)r * DM + c8) = *(const LAS u32x4*)(QP + r * 264 + c8); }
#else
#pragma unroll
    for (int i = 0; i < 4; ++i) { const int id = tid + i * 512; const int r = id >> 5, c8 = (id & 31) * 8; *(u32x4*)(ob + (size_t)r * DM + c8) = *(const LAS u32x4*)(KV + r * 264 + c8); *(u32x4*)(ob + (size_t)(r + 64) * DM + c8) = *(const LAS u32x4*)(KV + r * 264 + c8); }
#endif
    __syncthreads(); return; }
#endif
    bf16x8 aq[8];
#pragma unroll
    for (int ks = 0; ks < 8; ++ks) aq[ks] = ldfrag(QP, wid * 16 + fr, 264, ks * 32 + 8 * fq);
    f32x4 acc[16];
#pragma unroll
    for (int i = 0; i < 16; ++i) acc[i] = (f32x4){0.f, 0.f, 0.f, 0.f};
#pragma unroll
    for (int c = 0; c < 4; ++c) {
#pragma unroll
        for (int kt = 0; kt < 4; ++kt)
#pragma unroll
            for (int ks = 0; ks < 8; ++ks) acc[c * 4 + kt] = __builtin_amdgcn_mfma_f32_16x16x32_bf16(aq[ks], ldfrag(KV, kt * 16 + fr, 264, ks * 32 + 8 * fq), acc[c * 4 + kt], 0, 0, 0);
        __syncthreads();
#pragma unroll
        for (int i = 0; i < 4; ++i) { const int id = tid + i * 512; const int r = id >> 5, c8 = (id & 31) * 8;
            *(LAS u32x4*)(KV + r * 264 + c8) = (c < 3) ? *(const u32x4*)(km + (size_t)((c + 1) * 64 + r) * DM + c8) : *(const u32x4*)(vt + (size_t)r * 256 + c8); }
        __syncthreads();
    }
#ifdef ATT_DBG1
    {
#pragma unroll
    for (int i = 0; i < 16; ++i)
#pragma unroll
        for (int j = 0; j < 4; ++j) ob[(size_t)(wid * 16 + 4 * fq + j) * DM + i * 16 + fr] = f2bf(acc[i][j]);
    return; }
#endif
#pragma unroll
    for (int j = 0; j < 4; ++j) {
        float mx = -1e30f;
#pragma unroll
        for (int i = 0; i < 16; ++i) mx = fmaxf(mx, acc[i][j]);
        mx = fmaxf(mx, __shfl_xor(mx, 1)); mx = fmaxf(mx, __shfl_xor(mx, 2)); mx = fmaxf(mx, __shfl_xor(mx, 4)); mx = fmaxf(mx, __shfl_xor(mx, 8));
        float sm = 0.f;
#pragma unroll
        for (int i = 0; i < 16; ++i) { const float e = __expf((acc[i][j] - mx) * 0.0625f); acc[i][j] = e; sm += e; }
        sm += __shfl_xor(sm, 1); sm += __shfl_xor(sm, 2); sm += __shfl_xor(sm, 4); sm += __shfl_xor(sm, 8);
        const float inv = 1.f / sm;
#pragma unroll
        for (int i = 0; i < 16; ++i) QP[(wid * 16 + 4 * fq + j) * 264 + i * 16 + fr] = f2bf(acc[i][j] * inv);
    }
    WBAR();
#pragma unroll
    for (int ks = 0; ks < 8; ++ks) aq[ks] = ldfrag(QP, wid * 16 + fr, 264, ks * 32 + 8 * fq);
#pragma unroll
    for (int i = 0; i < 16; ++i) acc[i] = (f32x4){0.f, 0.f, 0.f, 0.f};
#pragma unroll
    for (int c = 0; c < 4; ++c) {
#pragma unroll
        for (int dt = 0; dt < 4; ++dt)
#pragma unroll
            for (int ks = 0; ks < 8; ++ks) acc[c * 4 + dt] = __builtin_amdgcn_mfma_f32_16x16x32_bf16(aq[ks], ldfrag(KV, dt * 16 + fr, 264, ks * 32 + 8 * fq), acc[c * 4 + dt], 0, 0, 0);
        __syncthreads();
        if (c < 3) {
#pragma unroll
            for (int i = 0; i < 4; ++i) { const int id = tid + i * 512; const int r = id >> 5, c8 = (id & 31) * 8; *(LAS u32x4*)(KV + r * 264 + c8) = *(const u32x4*)(vt + (size_t)((c + 1) * 64 + r) * 256 + c8); } }
        __syncthreads();
    }
#pragma unroll
    for (int i = 0; i < 16; ++i)
#pragma unroll
        for (int j = 0; j < 4; ++j) ob[(size_t)(wid * 16 + 4 * fq + j) * DM + i * 16 + fr] = f2bf(acc[i][j]);
}

__device__ __forceinline__ void ln_core(f32x4 (&v)[4], const float* g, const float* b, int lane) {
    float s = 0.f;
#pragma unroll
    for (int j = 0; j < 4; ++j) s += (v[j][0] + v[j][1]) + (v[j][2] + v[j][3]);
    const float mean = wave_sum(s) * (1.f / DM);
    float s2 = 0.f;
#pragma unroll
    for (int j = 0; j < 4; ++j) { v[j] = v[j] - mean; s2 += (v[j][0] * v[j][0] + v[j][1] * v[j][1]) + (v[j][2] * v[j][2] + v[j][3] * v[j][3]); }
    const float rstd = rsqrtf(wave_sum(s2) * (1.f / DM) + LN_EPS);
#pragma unroll
    for (int j = 0; j < 4; ++j) { const f32x4 gg = *(const f32x4*)(g + j * 256 + lane * 4), bb = *(const f32x4*)(b + j * 256 + lane * 4); v[j] = v[j] * rstd * gg + bb; }
}
__device__ __forceinline__ void ln_store(const f32x4 (&v)[4], float* of, bf16_t* obf, int lane) {
#pragma unroll
    for (int j = 0; j < 4; ++j) { *(f32x4*)(of + j * 256 + lane * 4) = v[j]; if (obf) *(u32x2*)(obf + j * 256 + lane * 4) = (u32x2){pk2(v[j][0], v[j][1]), pk2(v[j][2], v[j][3])}; }
}
__device__ __forceinline__ void phase_ln1(const Params& P, int l) {
    const int tid = ltid(); const int lane = tid & 63, wid = __builtin_amdgcn_readfirstlane(tid >> 6); const int gw = blockIdx.x * 8 + wid, NGW = gridDim.x * 8;
    const float* y = (const float*)(P.ws + WS_YBUF); float* xf = (float*)(P.ws + WS_XF); bf16_t* xb = (bf16_t*)(P.ws + WS_XB);
    for (int m = gw; m < NTOK; m += NGW) { f32x4 v[4];
#pragma unroll
        for (int j = 0; j < 4; ++j) v[j] = *(const f32x4*)(y + (size_t)m * DM + j * 256 + lane * 4);
        ln_core(v, P.in[17] + l * DM, P.in[18] + l * DM, lane);
        ln_store(v, xf + (size_t)m * DM, xb + (size_t)m * DM, lane); }
}
__device__ __forceinline__ void phase_ln2_router(const Params& P, int l, LAS unsigned char* lds) {
    const int tid = ltid(); const int lane = tid & 63, wid = __builtin_amdgcn_readfirstlane(tid >> 6); const int gw = blockIdx.x * 8 + wid, NGW = gridDim.x * 8;
    const float* y = (const float*)(P.ws + WS_YBUF); float* xf = (float*)(P.ws + WS_XF); bf16_t* xb = (bf16_t*)(P.ws + WS_XB);
    int* cnt = (int*)(P.ws + WS_CTL) + l * 32; int* elist = (int*)(P.ws + WS_ELIST); float* tgate = (float*)(P.ws + WS_TGATE);
    LAS float* xs = (LAS float*)(lds + wid * 16384);
    const float* rw = P.in[25] + (size_t)l * 1024 * 32; const float* rb = P.in[26] + l * 32;
    for (int pr = gw; pr < NTOK / 4; pr += NGW) {
#pragma unroll
        for (int rr = 0; rr < 4; ++rr) { const int m = pr * 4 + rr; f32x4 v[4];
#pragma unroll
            for (int j = 0; j < 4; ++j) v[j] = *(const f32x4*)(y + (size_t)m * DM + j * 256 + lane * 4);
            ln_core(v, P.in[23] + l * DM, P.in[24] + l * DM, lane);
            ln_store(v, xf + (size_t)m * DM, xb + (size_t)m * DM, lane);
#pragma unroll
            for (int j = 0; j < 4; ++j) *(LAS f32x4*)(xs + rr * 1024 + j * 256 + lane * 4) = v[j]; }
        WBAR();
        const int e = lane & 31, hf = lane >> 5;
        float a[4] = {0.f, 0.f, 0.f, 0.f};
        for (int kb = 0; kb < 16; ++kb) { const int k0 = hf * 512 + kb * 32;
            float w[32];
#pragma unroll
            for (int j = 0; j < 32; ++j) w[j] = rw[(k0 + j) * 32 + e];
#pragma unroll
            for (int j4 = 0; j4 < 8; ++j4)
#pragma unroll
                for (int rr = 0; rr < 4; ++rr) { const f32x4 x = *(const LAS f32x4*)(xs + rr * 1024 + k0 + j4 * 4);
                    a[rr] += x[0] * w[4 * j4]; a[rr] += x[1] * w[4 * j4 + 1]; a[rr] += x[2] * w[4 * j4 + 2]; a[rr] += x[3] * w[4 * j4 + 3]; } }
        const float bias = rb[e];
#pragma unroll
        for (int rr = 0; rr < 4; ++rr) { const int m = pr * 4 + rr;
            float lg = a[rr] + __shfl_xor(a[rr], 32) + bias; lg = (lg == lg) ? fminf(fmaxf(lg, -1e30f), 1e30f) : -1e30f; float v = (lane < 32) ? lg : -3e38f;
            float tv[4]; int te[4];
#pragma unroll
            for (int k = 0; k < 4; ++k) { const float mx = wave_max(v); const unsigned long long bal = __ballot(v == mx); const int idx = (__ffsll((long long)bal) - 1) & 31; tv[k] = mx; te[k] = idx; if (lane == idx) v = -3e38f; }
            const float e1 = __expf(tv[1] - tv[0]), e2 = __expf(tv[2] - tv[0]), e3 = __expf(tv[3] - tv[0]); const float inv = 1.f / (1.f + e1 + e2 + e3);
            if (lane < 4) { const int ee = lane == 0 ? te[0] : (lane == 1 ? te[1] : (lane == 2 ? te[2] : te[3])); const float gg = (lane == 0 ? 1.f : (lane == 1 ? e1 : (lane == 2 ? e2 : e3))) * inv;
                const int pos = atomicAdd(cnt + ee, 1); elist[ee * ECAP + pos] = m * 4 + lane; tgate[ee * ECAP + pos] = gg; } }
        WBAR();
    }
}
__device__ __forceinline__ void phase_router_old(const Params& P, int l, LAS unsigned char* lds) {
    const int tid = ltid(); const int lane = tid & 63, wid = __builtin_amdgcn_readfirstlane(tid >> 6); const int gw = blockIdx.x * 8 + wid, NGW = gridDim.x * 8;
    const float* y = (const float*)(P.ws + WS_YBUF); float* xf = (float*)(P.ws + WS_XF); bf16_t* xb = (bf16_t*)(P.ws + WS_XB);
    int* cnt = (int*)(P.ws + WS_CTL) + l * 32; int* elist = (int*)(P.ws + WS_ELIST); float* tgate = (float*)(P.ws + WS_TGATE);
    LAS float* xs = (LAS float*)(lds + wid * 16384);
    const float* rw = P.in[25] + (size_t)l * 1024 * 32; const float* rb = P.in[26] + l * 32;
    for (int pr = gw; pr < NTOK / 4; pr += NGW) {
#pragma unroll
        for (int rr = 0; rr < 4; ++rr) { const int m = pr * 4 + rr; f32x4 v[4];
#pragma unroll
            for (int j = 0; j < 4; ++j) v[j] = *(const f32x4*)(xf + (size_t)m * DM + j * 256 + lane * 4);
#pragma unroll
            for (int j = 0; j < 4; ++j) *(LAS f32x4*)(xs + rr * 1024 + j * 256 + lane * 4) = v[j]; }
        WBAR();
        const int e = lane & 31, hf = lane >> 5;
        float a[4] = {0.f, 0.f, 0.f, 0.f};
        for (int kb = 0; kb < 16; ++kb) { const int k0 = hf * 512 + kb * 32;
            float w[32];
#pragma unroll
            for (int j = 0; j < 32; ++j) w[j] = rw[(k0 + j) * 32 + e];
#pragma unroll
            for (int j4 = 0; j4 < 8; ++j4)
#pragma unroll
                for (int rr = 0; rr < 4; ++rr) { const f32x4 x = *(const LAS f32x4*)(xs + rr * 1024 + k0 + j4 * 4);
                    a[rr] += x[0] * w[4 * j4]; a[rr] += x[1] * w[4 * j4 + 1]; a[rr] += x[2] * w[4 * j4 + 2]; a[rr] += x[3] * w[4 * j4 + 3]; } }
        const float bias = rb[e];
#pragma unroll
        for (int rr = 0; rr < 4; ++rr) { const int m = pr * 4 + rr;
            float lg = a[rr] + __shfl_xor(a[rr], 32) + bias; lg = (lg == lg) ? fminf(fmaxf(lg, -1e30f), 1e30f) : -1e30f; float v = (lane < 32) ? lg : -3e38f;
            float tv[4]; int te[4];
#pragma unroll
            for (int k = 0; k < 4; ++k) { const float mx = wave_max(v); const unsigned long long bal = __ballot(v == mx); const int idx = (__ffsll((long long)bal) - 1) & 31; tv[k] = mx; te[k] = idx; if (lane == idx) v = -3e38f; }
            const float e1 = __expf(tv[1] - tv[0]), e2 = __expf(tv[2] - tv[0]), e3 = __expf(tv[3] - tv[0]); const float inv = 1.f / (1.f + e1 + e2 + e3);
            if (lane < 4) { const int ee = lane == 0 ? te[0] : (lane == 1 ? te[1] : (lane == 2 ? te[2] : te[3])); const float gg = (lane == 0 ? 1.f : (lane == 1 ? e1 : (lane == 2 ? e2 : e3))) * inv;
                const int pos = atomicAdd(cnt + ee, 1); elist[ee * ECAP + pos] = m * 4 + lane; tgate[ee * ECAP + pos] = gg; } }
        WBAR();
    }
}
__device__ __forceinline__ void phase_router(const Params& P, int l, LAS unsigned char* lds) {
    if (gridDim.x != 256) { phase_router_old(P, l, lds); return; }
    const int tid = ltid(); const int lane = tid & 63, wid = __builtin_amdgcn_readfirstlane(tid >> 6); const int gw = blockIdx.x * 8 + wid, NGW = gridDim.x * 8;
    const float* xf = (const float*)(P.ws + WS_XF);
    int* cnt = (int*)(P.ws + WS_CTL) + l * 32; int* elist = (int*)(P.ws + WS_ELIST); float* tgate = (float*)(P.ws + WS_TGATE);
    LAS float* xs = (LAS float*)(lds + wid * 16384);
    LAS int* lcnt = (LAS int*)(lds + 131072 + 256); LAS int* lbase = (LAS int*)(lds + 131072 + 384);
    const float* rw = P.in[25] + (size_t)l * 1024 * 32; const float* rb = P.in[26] + l * 32;
    if (tid < 32) lcnt[tid] = 0;
    __syncthreads();
    int rec_e[2][4], rec_p[2][4]; float rec_g[2][4];
    {
        const int e = lane & 31, hf = lane >> 5;
        float a[8] = {0.f, 0.f, 0.f, 0.f, 0.f, 0.f, 0.f, 0.f};
#pragma unroll 1
        for (int ps = 0; ps < 2; ++ps) {
#pragma unroll
            for (int r8 = 0; r8 < 8; ++r8) { const int m = (gw + (r8 >> 2) * NGW) * 4 + (r8 & 3);
#pragma unroll
                for (int j = 0; j < 2; ++j) *(LAS f32x4*)(xs + r8 * 512 + j * 256 + lane * 4) = *(const f32x4*)(xf + (size_t)m * DM + ps * 512 + j * 256 + lane * 4); }
            WBAR();
            for (int kb = 0; kb < 8; ++kb) { const int kl = hf * 256 + kb * 32;
                float w[32];
#pragma unroll
                for (int j = 0; j < 32; ++j) w[j] = rw[(ps * 512 + kl + j) * 32 + e];
#pragma unroll
                for (int j4 = 0; j4 < 8; ++j4)
#pragma unroll
                    for (int r8 = 0; r8 < 8; ++r8) { const f32x4 x = *(const LAS f32x4*)(xs + r8 * 512 + kl + j4 * 4);
                        a[r8] += x[0] * w[4 * j4]; a[r8] += x[1] * w[4 * j4 + 1]; a[r8] += x[2] * w[4 * j4 + 2]; a[r8] += x[3] * w[4 * j4 + 3]; } }
            WBAR();
        }
        const float bias = rb[e];
#pragma unroll
        for (int r8 = 0; r8 < 8; ++r8) { const int q = r8 >> 2, rr = r8 & 3; const int m = (gw + q * NGW) * 4 + rr;
            float lg = a[r8] + __shfl_xor(a[r8], 32) + bias; lg = (lg == lg) ? fminf(fmaxf(lg, -1e30f), 1e30f) : -1e30f; float v = (lane < 32) ? lg : -3e38f;
            float tv[4]; int te[4];
#pragma unroll
            for (int k = 0; k < 4; ++k) { const float mx = wave_max(v); const unsigned long long bal = __ballot(v == mx); const int idx = (__ffsll((long long)bal) - 1) & 31; tv[k] = mx; te[k] = idx; if (lane == idx) v = -3e38f; }
            const float e1 = __expf(tv[1] - tv[0]), e2 = __expf(tv[2] - tv[0]), e3 = __expf(tv[3] - tv[0]); const float inv = 1.f / (1.f + e1 + e2 + e3);
            rec_e[q][rr] = 0; rec_p[q][rr] = 0; rec_g[q][rr] = 0.f;
            if (lane < 4) { const int ee = lane == 0 ? te[0] : (lane == 1 ? te[1] : (lane == 2 ? te[2] : te[3])); const float gg = (lane == 0 ? 1.f : (lane == 1 ? e1 : (lane == 2 ? e2 : e3))) * inv;
                rec_e[q][rr] = ee; rec_p[q][rr] = __hip_atomic_fetch_add(lcnt + ee, 1, __ATOMIC_RELAXED, __HIP_MEMORY_SCOPE_WORKGROUP); rec_g[q][rr] = gg; } }
    }
    __syncthreads();
    if (tid < 32) lbase[tid] = atomicAdd(cnt + tid, lcnt[tid]);
    __syncthreads();
    if (lane < 4) {
#pragma unroll
        for (int q = 0; q < 2; ++q)
#pragma unroll
            for (int rr = 0; rr < 4; ++rr) { const int m = (gw + q * NGW) * 4 + rr; const int ee = rec_e[q][rr]; const int slot = ee * ECAP + lbase[ee] + rec_p[q][rr]; elist[slot] = m * 4 + lane; tgate[slot] = rec_g[q][rr]; } }
    __syncthreads();
}
__device__ __forceinline__ void phase_ln3(const Params& P, int l) {
    const int tid = ltid(); const int lane = tid & 63, wid = __builtin_amdgcn_readfirstlane(tid >> 6); const int gw = blockIdx.x * 8 + wid, NGW = gridDim.x * 8;
    float* xf = (float*)(P.ws + WS_XF); bf16_t* xb = (bf16_t*)(P.ws + WS_XB); const bf16_t* ys = (const bf16_t*)(P.ws + WS_YS);
    for (int m = gw; m < NTOK; m += NGW) { f32x4 v[4];
#pragma unroll
        for (int j = 0; j < 4; ++j) { v[j] = *(const f32x4*)(xf + (size_t)m * DM + j * 256 + lane * 4) * ALPHA;
#pragma unroll
            for (int k = 0; k < 4; ++k) { const u32x2 w = *(const u32x2*)(ys + ((size_t)m * 4 + k) * DM + j * 256 + lane * 4); v[j] += (f32x4){bflo(w[0]), bfhi(w[0]), bflo(w[1]), bfhi(w[1])}; } }
        ln_core(v, P.in[31] + l * DM, P.in[32] + l * DM, lane);
        if (l == 1) ln_store(v, P.out + (size_t)m * DM, nullptr, lane); else ln_store(v, xf + (size_t)m * DM, xb + (size_t)m * DM, lane); }
}

__device__ __forceinline__ void set_base(ProbBase& S, const void* A, int lda, const void* Bt, int ldb, int M, int N, int K, int G, int c) { S.A = (const char*)A; S.Bt = (const char*)Bt; S.init(M, N, G, c); }

typedef const Params __attribute__((address_space(4))) CParams;
__global__ void __launch_bounds__(512, 2) mega(Params Pk) {
    extern __shared__ __attribute__((aligned(16))) unsigned char smem[];
    LAS unsigned char* lds = (LAS unsigned char*)smem;
    cg::grid_group grid = cg::this_grid();
    CParams* kp = (CParams*)__builtin_amdgcn_kernarg_segment_ptr();
    const int lo = Pk.ph_lo, hi = Pk.ph_hi;
    int nbar = 0;
#ifndef PHMASK
#define PHMASK 0xffffffffu
#endif
#define EN(k) (((PHMASK) >> (k)) & 1u)
#ifndef REPMASK
#define REPMASK 0u
#endif
#define NREP(k) ((((REPMASK) >> (k)) & 1u) ? 2 : 1)
#define RB(k) for (int rep_ = 0; rep_ < NREP(k); ++rep_) { if (rep_) GRID_BARRIER();
#define RE }
#define GRID_BARRIER() do { asm volatile("s_waitcnt vmcnt(0) lgkmcnt(0)" ::: "memory"); __syncthreads(); \
        if (nbar == 0) grid.sync(); \
        if (ltid() == 0) { unsigned* bw = (unsigned*)(kp->ws + WS_CTL + 1024) + nbar * 160; const unsigned gx = gridDim.x, sg = blockIdx.x & 7u; const unsigned nsub = (gx + 7u - sg) >> 3; const unsigned ngrp = gx < 8u ? gx : 8u; \
            __builtin_amdgcn_fence(__ATOMIC_RELEASE, "agent"); asm volatile("s_waitcnt vmcnt(0)" ::: "memory"); \
            const unsigned old = __hip_atomic_fetch_add(bw + 16 + sg * 16, 1u, __ATOMIC_RELAXED, __HIP_MEMORY_SCOPE_AGENT); \
            if (old + 1u == nsub) __hip_atomic_fetch_add(bw, 1u, __ATOMIC_RELAXED, __HIP_MEMORY_SCOPE_AGENT); \
            while (__hip_atomic_load(bw, __ATOMIC_RELAXED, __HIP_MEMORY_SCOPE_AGENT) < ngrp) __builtin_amdgcn_s_sleep(1); \
            __builtin_amdgcn_fence(__ATOMIC_ACQUIRE, "agent"); asm volatile("s_waitcnt vmcnt(0)" ::: "memory"); } \
        __syncthreads(); ++nbar; } while (0)
#define LOCAL_SYNC() do { asm volatile("s_waitcnt vmcnt(0) lgkmcnt(0)" ::: "memory"); __syncthreads(); if (ltid() < 64) { asm volatile("buffer_inv sc1\n\ts_waitcnt vmcnt(0)" ::: "memory"); } __syncthreads(); } while (0)
#define PH_BEGIN(id) if ((id) >= lo && (id) < hi) { CParams* kq = kp; asm volatile("" : "+s"(kq)); const Params& P = *(const Params*)kq; unsigned char* ws = P.ws; \
        int G = gridDim.x, bx = blockIdx.x; asm volatile("" : "+s"(G), "+s"(bx)); (void)ws; (void)G; (void)bx;
#define PH_END(id) if ((id) + 1 < hi) GRID_BARRIER(); }
    PH_BEGIN(0) if (EN(0)) RB(0) phase_convert(P, lds);  RE PH_END(0)
#define LAYER(l, B) \
    PH_BEGIN(B + 0) if (EN(1)) RB(1) { \
        { ProbInProj S; set_base(S, ws + WS_XB, 2048, ws + WS_WIN + l * SZ_WIN, 2048, NTOK, NP, 1024, G, bx); S.out = (bf16_t*)(ws + WS_P); S.bias = P.in[3] + (size_t)l * NIN; gemm_phase(lds, S); } \
        if (l == 0) { for (int ll = 0; ll < 2; ++ll) { \
          { ProbBf16 S; set_base(S, ws + WS_MEMB, 2048, ws + WS_WK + ll * SZ_SQ, 2048, 1024, 1024, 1024, G, (bx + G - 128 - 32 * ll) % G); S.out = (bf16_t*)(ws + WS_KM + ll * SZ_SQ); S.ldc = 1024; gemm_phase(lds, S); } \
          { ProbBf16 S; set_base(S, ws + WS_MEMB, 2048, ws + WS_WV + ll * SZ_SQ, 2048, 1024, 1024, 1024, G, (bx + G - 144 - 32 * ll) % G); S.out = (bf16_t*)(ws + WS_VT + ll * SZ_SQ); S.ldc = 1024; gemm_phase(lds, S); } } } }  RE PH_END(B + 0) \
    PH_BEGIN(B + 1) if (EN(2)) RB(2) phase_mixer_local(P, l, lds);  RE PH_END(B + 1) \
    PH_BEGIN(B + 2) if (EN(3)) RB(3) { phase_scan(P); \
        if (l == 0) { for (int ll = 0; ll < 2; ++ll) { \
          { ProbVW S; S.A = (const char*)(ws + WS_WXO + ll * SZ_SQ); S.Bt = (const char*)(ws + WS_VT + ll * SZ_SQ); S.G = G; S.c = (bx + G - 128 * ll) % G; S.out = (bf16_t*)(ws + WS_OB + (size_t)ll * 4 * SZ_SQ); gemm_phase(lds, S); } \
          { ProbMT S; S.A = (const char*)(ws + WS_KM + ll * SZ_SQ); S.Bt = (const char*)(ws + WS_WQ + ll * SZ_SQ); S.G = G; S.c = (bx + G - 64 - 128 * ll) % G; S.out = (bf16_t*)(ws + WS_QB + (size_t)ll * 4 * SZ_SQ); gemm_phase(lds, S); } } } }  RE PH_END(B + 2) \
    PH_BEGIN(B + 3) if (EN(4)) RB(4) { G2R ra, rb; int it = bx; if (it < 1024) { gla2_load(P, it, ltid(), ra); for (;;) { const int i2 = it + G; const bool h2 = i2 < 1024; gla2_item(P, l, it, h2 ? i2 : -1, ra, rb, lds); if (!h2) break; const int i3 = i2 + G; const bool h3 = i3 < 1024; gla2_item(P, l, i2, h3 ? i3 : -1, rb, ra, lds); if (!h3) break; it = i3; } } }  RE PH_END(B + 3) \
    PH_BEGIN(B + 4) if (EN(5)) RB(5) { { ProbMerge<512> S; S.A = (const char*)(ws + WS_YCAT); S.Bt = (const char*)(ws + WS_WUP + l * SZ_SQ); S.G = G; S.c = bx; \
            S.p = (const bf16_t*)(ws + WS_P); S.mb = (bf16_t*)(ws + WS_MRGB); gemm_phase(lds, S); } \
            asm volatile("s_waitcnt vmcnt(0)" ::: "memory"); __syncthreads(); \
            { ProbMerge<256> S; S.A = (const char*)(ws + WS_YCAT); S.Bt = (const char*)(ws + WS_WUP + l * SZ_SQ); S.G = G; S.c = bx; \
            S.p = (const bf16_t*)(ws + WS_P); S.mb = (bf16_t*)(ws + WS_MRGB); gemm_phase(lds, S); } }  RE PH_END(B + 4) \
    PH_BEGIN(B + 5) if (EN(6)) RB(6) { ProbResLN S; set_base(S, ws + WS_MRGB, 2048, ws + WS_WO + l * SZ_SQ, 2048, NTOK, 1024, 1024, G, bx); \
            S.xres = (l == 0) ? P.in[0] : (const float*)(ws + WS_XF); S.lng = P.in[17] + l * DM; S.lnb = P.in[18] + l * DM; S.xf = (float*)(ws + WS_XF); S.xb = (bf16_t*)(ws + WS_XB); \
            S.stats = (float*)(ws + WS_STATS); S.cntp = (unsigned*)(ws + WS_CTL + 24576) + (l * 2 + 0) * 64; S.bstride = 0; gemm_phase(lds, S); }  RE PH_END(B + 5) \
    PH_BEGIN(B + 7) if (EN(8)) RB(8) { ProbAttn<0, 1024> S; S.A = (const char*)(ws + WS_XB); S.Bt = (const char*)(ws + WS_QB + (size_t)l * 4 * SZ_SQ); S.G = G; S.c = bx; S.sout = nullptr; S.oout = (bf16_t*)(ws + WS_MRGF); gemm_phase(lds, S); }  RE PH_END(B + 7) \
    PH_BEGIN(B + 10) if (EN(6)) RB(6) { ProbResLN S; set_base(S, ws + WS_MRGF, 2048, ws + WS_OB + (size_t)l * 4 * SZ_SQ, 2048, NTOK, 1024, 1024, G, bx); \
            S.xres = (const float*)(ws + WS_XF); S.lng = P.in[23] + l * DM; S.lnb = P.in[24] + l * DM; S.xf = (float*)(ws + WS_XF); S.xb = (bf16_t*)(ws + WS_XB); \
            S.stats = (float*)(ws + WS_STATS); S.cntp = (unsigned*)(ws + WS_CTL + 24576) + (l * 2 + 1) * 64; S.bstride = SZ_SQ; gemm_phase(lds, S); }  RE PH_END(B + 10) \
    PH_BEGIN(B + 11) if (EN(10)) RB(10) phase_router(P, l, lds);  RE PH_END(B + 11) \
    PH_BEGIN(B + 12) if (EN(11)) RB(11) { LAS int* tstart = (LAS int*)(lds + 131072); const int* cnt = (const int*)(ws + WS_CTL) + l * 32; \
            if (ltid() == 0) { int a = 0; for (int e = 0; e < 32; ++e) { tstart[e] = a; a += (cnt[e] + 255) >> 8; } tstart[32] = a; } \
            __syncthreads(); \
            ProbMoe1 S; S.G = G; S.c = (G % 8 == 0) ? (bx % 8) * (G / 8) + bx / 8 : bx; S.nN = 8; S.tstart = tstart; S.cnt = cnt; \
            S.A = (const char*)(ws + WS_XB); S.Bt = (const char*)(ws + WS_WGU + l * SZ_WGU); \
            S.elist = (const int*)(ws + WS_ELIST); S.bgu = P.in[28] + (size_t)l * 32 * 2048; S.abuf = (bf16_t*)(ws + WS_ABUF); gemm_phase(lds, S); }  RE PH_END(B + 12) \
    PH_BEGIN(B + 13) if (EN(12)) RB(12) { LAS int* tstart = (LAS int*)(lds + 131072); const int* cnt = (const int*)(ws + WS_CTL) + l * 32; \
            if (ltid() == 0) { int a = 0; for (int e = 0; e < 32; ++e) { tstart[e] = a; a += (cnt[e] + 255) >> 8; } tstart[32] = a; } \
            __syncthreads(); \
            ProbMoe2 S; S.G = G; S.c = (G % 8 == 0) ? (bx % 8) * (G / 8) + bx / 8 : bx; S.nN = 4; S.tstart = tstart; S.cnt = cnt; \
            S.A = (const char*)(ws + WS_ABUF); S.Bt = (const char*)(ws + WS_WD + l * SZ_WD); \
            S.elist = (const int*)(ws + WS_ELIST); S.bd = P.in[30] + (size_t)l * 32 * 1024; S.tgate = (const float*)(ws + WS_TGATE); S.ys = (bf16_t*)(ws + WS_YS); gemm_phase(lds, S); }  RE PH_END(B + 13) \
    PH_BEGIN(B + 14) if (EN(13)) RB(13) phase_ln3(P, l);  RE PH_END(B + 14)
    LAYER(0, 1)
    LAYER(1, 16)
#ifdef EXTRA_BARS
    for (int xb_ = 0; xb_ < EXTRA_BARS; ++xb_) GRID_BARRIER();
#endif
#ifdef DBG_OFF
    { GRID_BARRIER(); const Params& P = *(const Params*)kp; const int G = gridDim.x, bx = blockIdx.x; const int gt = bx * 512 + ltid();
      for (size_t i = gt; i < (size_t)NTOK * DM; i += (size_t)G * 512) {
#if DBG_BF16
          { float dv = bf2f(((const bf16_t*)(P.ws + DBG_OFF))[i]); P.out[i] = (dv == dv && fabsf(dv) < 1e30f) ? dv : 1000.f; }
#else
          P.out[i] = ((const float*)(P.ws + DBG_OFF))[i];
#endif
      } }
#endif
}

extern "C" void kernel_launch(void* const* d_in, const int* in_sizes, int n_in, void* d_out, int out_size, void* d_ws, size_t ws_size, hipStream_t stream) {
    static int grid = 0;
    if (grid == 0) {
        int dev = 0, cus = 0, per_cu = 0;
        hipGetDevice(&dev);
        hipDeviceGetAttribute(&cus, hipDeviceAttributeMultiprocessorCount, dev);
        hipFuncSetAttribute((const void*)mega, hipFuncAttributeMaxDynamicSharedMemorySize, LDS_BYTES);
        hipOccupancyMaxActiveBlocksPerMultiprocessor(&per_cu, (const void*)mega, 512, LDS_BYTES);
        if (per_cu < 1) per_cu = 1;
        grid = cus < 256 ? cus : 256;
        if (ws_size < WS_END) fprintf(stderr, "kernel_launch: workspace too small: %zu < %zu\n", ws_size, (size_t)WS_END);
        if (n_in != 33) fprintf(stderr, "kernel_launch: expected 33 inputs, got %d\n", n_in);
    }
    hipMemsetAsync((char*)d_ws + WS_CTL, 0, 32768, stream);
    Params p{};
    for (int i = 0; i < 33; ++i) p.in[i] = (const float*)d_in[i];
    p.out = (float*)d_out; p.ws = (unsigned char*)d_ws; p.ph_lo = 0; p.ph_hi = PH_HI;
    void* args[] = {&p};
    hipError_t e = hipLaunchCooperativeKernel((const void*)mega, dim3(grid), dim3(512), args, LDS_BYTES, stream);
    if (e != hipSuccess) fprintf(stderr, "cooperative launch failed: %s (grid %d)\n", hipGetErrorString(e), grid);
}
```

```cpp
#include <hip/hip_runtime.h>
#include <hip/hip_cooperative_groups.h>
#include <cstdio>
namespace cg = cooperative_groups;

#define LAS __attribute__((address_space(3)))
typedef unsigned short bf16_t;
typedef short bf16x8 __attribute__((ext_vector_type(8)));
typedef float f32x4 __attribute__((ext_vector_type(4)));
typedef unsigned u32x4 __attribute__((ext_vector_type(4)));
typedef unsigned u32x2 __attribute__((ext_vector_type(2)));

constexpr int NTOK = 16384, DM = 1024, SEQL = 4096, NP = 5632;
constexpr int COL_K = 256, COL_V = 512, COL_R = 1024, COL_UV = 1536, COL_XC = 2048, COL_GATE = 2304, COL_GL = 5376, NIN = 5392;
constexpr float LN_EPS = 1e-5f;
constexpr float ALPHA = 1.41421356237f;
constexpr int ECAP = 16384;
constexpr int LDS_BYTES = 131072 + 1024;
#ifndef PH_HI
#define PH_HI 31
#endif

constexpr size_t al256(size_t x) { return (x + 255) & ~(size_t)255; }
constexpr size_t WS_CTL = 0;
constexpr size_t WS_WIN = 32768;
constexpr size_t SZ_WIN = (size_t)NP * 1024 * 2;
constexpr size_t WS_WUP = WS_WIN + 2 * SZ_WIN;
constexpr size_t SZ_SQ = (size_t)1024 * 1024 * 2;
constexpr size_t WS_WO = WS_WUP + 2 * SZ_SQ;
constexpr size_t WS_WQ = WS_WO + 2 * SZ_SQ;
constexpr size_t WS_WK = WS_WQ + 2 * SZ_SQ;
constexpr size_t WS_WV = WS_WK + 2 * SZ_SQ;
constexpr size_t WS_WXO = WS_WV + 2 * SZ_SQ;
constexpr size_t WS_WGU = WS_WXO + 2 * SZ_SQ;
constexpr size_t SZ_WGU = (size_t)32 * 2048 * 1024 * 2;
constexpr size_t WS_WD = WS_WGU + 2 * SZ_WGU;
constexpr size_t SZ_WD = (size_t)32 * 1024 * 1024 * 2;
constexpr size_t WS_XB = WS_WD + 2 * SZ_WD;
constexpr size_t SZ_ACTB = (size_t)NTOK * 1024 * 2;
constexpr size_t SZ_ACTF = (size_t)NTOK * 1024 * 4;
constexpr size_t WS_MEMB = WS_XB + SZ_ACTB;
constexpr size_t WS_XF = WS_MEMB + SZ_SQ;
constexpr size_t WS_YBUF = WS_XF + SZ_ACTF;
constexpr size_t WS_P = WS_YBUF + SZ_ACTF;
constexpr size_t WS_YCAT = WS_P + (size_t)NTOK * NP * 2;
constexpr size_t WS_BCUM = WS_YCAT + SZ_ACTB;
constexpr size_t WS_KVT = WS_BCUM + (size_t)NTOK * 256 * 4;
constexpr size_t WS_CDEC = WS_KVT + (size_t)1024 * 8192 * 4;
constexpr size_t WS_ST = WS_CDEC + (size_t)1024 * 64 * 4;
constexpr size_t WS_MRGF = WS_ST + (size_t)1024 * 8192 * 2;
constexpr size_t WS_MRGB = WS_MRGF + SZ_ACTF;
constexpr size_t WS_QB = WS_MRGB + SZ_ACTB;
constexpr size_t WS_OB = WS_QB + SZ_ACTB;
constexpr size_t WS_KM = WS_OB + SZ_ACTB;
constexpr size_t WS_VT = WS_KM + 2 * SZ_SQ;
constexpr size_t WS_ELIST = WS_VT + 8 * SZ_SQ;
constexpr size_t WS_TGATE = WS_ELIST + (size_t)32 * ECAP * 4;
constexpr size_t WS_ABUF = WS_TGATE + (size_t)32 * ECAP * 4;
constexpr size_t WS_YS = WS_ABUF + (size_t)73728 * 1024 * 2;
constexpr size_t WS_STATS = WS_YS + (size_t)65536 * 1024 * 2;
constexpr size_t WS_END = WS_STATS + (size_t)64 * 4 * 256 * 2 * 4;

__device__ __forceinline__ float bf2f(bf16_t b) { return __uint_as_float(((unsigned)b) << 16); }
__device__ __forceinline__ unsigned pk2(float lo, float hi) { unsigned r; asm("v_cvt_pk_bf16_f32 %0, %1, %2" : "=v"(r) : "v"(lo), "v"(hi)); return r; }
__device__ __forceinline__ bf16_t f2bf(float f) { return (bf16_t)(pk2(f, 0.f) & 0xffffu); }
__device__ __forceinline__ float bflo(unsigned u) { return __uint_as_float(u << 16); }
__device__ __forceinline__ float bfhi(unsigned u) { return __uint_as_float(u & 0xffff0000u); }
__device__ __forceinline__ float wave_sum(float v) {
#pragma unroll
    for (int o = 32; o; o >>= 1) v += __shfl_xor(v, o);
    return v;
}
__device__ __forceinline__ float wave_max(float v) {
#pragma unroll
    for (int o = 32; o; o >>= 1) v = fmaxf(v, __shfl_xor(v, o));
    return v;
}
__device__ __forceinline__ float gelu_f(float v) {
    const float av = fabsf(v), t = __builtin_amdgcn_rcpf(av * 0.2316418882f + 1.0f);
    float q = t * 0.5307027145f + (-0.7265760135f); q = q * t + 0.7107068705f; q = q * t + (-0.142248368f); q = q * t + 0.127414796f; q = q * t;
    const float e = __builtin_amdgcn_exp2f((v * v) * (-0.72134752044f));
    const float m = v * (q * e);
    return v < 0.f ? m : v - m;
}
__device__ __forceinline__ float sigmoid_f(float x) { return __builtin_amdgcn_rcpf(1.f + __expf(-x)); }
__device__ __forceinline__ int ltid() { int t = threadIdx.x; asm volatile("" : "+v"(t)); return t; }
#define WBAR() do { asm volatile("" ::: "memory"); __builtin_amdgcn_wave_barrier(); asm volatile("" ::: "memory"); } while (0)

struct Params { const float* in[33]; float* out; unsigned char* ws; int ph_lo, ph_hi; };

constexpr int BM = 256, BK = 64, HALF = 128, HTB = HALF * BK * 2, NXCD = 8, WGM = 8;
__device__ __forceinline__ int lds_byte(int r, int c) { const int st = (r >> 4) * 2 + (c >> 5), rr = r & 15, cc = c & 31, ob = rr * 64 + cc * 2; return st * 1024 + (ob ^ (((ob >> 9) & 1) << 5)); }
__device__ __forceinline__ void stage_rc(int b, int& R, int& C) { const int st = b / 1024, sb = b % 1024, swz = sb ^ (((sb >> 9) & 1) << 5); R = (st >> 1) * 16 + swz / 64; C = (st & 1) * 32 + (swz % 64) / 2; }
__device__ __forceinline__ int perm32(int rho) { const int n = rho >> 4, i = rho & 15; return 8 * (i >> 2) + 4 * n + (i & 3); }

struct Unit { int pm, pn, e, aux; };
typedef f32x4 Acc[2][2][4][2];

struct OrderStatic {
    int nM, nN, nwg, G, c;
    __device__ __forceinline__ void init(int M, int N, int G_, int c_) { nM = M / BM; nN = N / BM; nwg = nM * nN; G = G_; c = c_; }
    __device__ __forceinline__ bool next(int i, Unit& u) const {
        const long L = (long)i * G + c; if (L >= nwg) return false;
        int wgid = (int)L; { const int q = nwg / NXCD, r = nwg % NXCD, xcd = wgid % NXCD, off = wgid / NXCD; wgid = (xcd < r ? xcd * (q + 1) : r * (q + 1) + (xcd - r) * q) + off; }
        const int nig = WGM * nN, gid = wgid / nig, fm = gid * WGM, gsz = (nM - fm) < WGM ? (nM - fm) : WGM;
        u.pm = fm + ((wgid % nig) % gsz); u.pn = (wgid % nig) / gsz; u.e = 0; u.aux = 0; return true;
    }
};

template <class S_t>
__device__ __forceinline__ void gemm_phase(LAS unsigned char* lds, const S_t& S) {
    const int tid = ltid(), wid = __builtin_amdgcn_readfirstlane(tid >> 6), lane = tid & 63, wr = wid >> 2, wc = wid & 3, fr = lane & 15, fq = lane >> 4;
    const int nt = S.K / BK;
    int Rr[2], Cc[2]; unsigned voffB[2]; unsigned offC[2][2], offN[2][2];
#pragma unroll
    for (int i = 0; i < 2; ++i) { stage_rc(tid * 16 + i * 8192, Rr[i], Cc[i]); const int Rb = S_t::PERM ? ((Rr[i] & ~31) + perm32(Rr[i] & 31)) : Rr[i];
        voffB[i] = (unsigned)(Rb * S.ldb + Cc[i] * 2);
        offC[0][i] = (unsigned)(Rr[i] * S.lda + Cc[i] * 2); offC[1][i] = (unsigned)((Rr[i] + HALF) * S.lda + Cc[i] * 2);
        }
    const size_t kstep = (size_t)(BK * 2);
    const size_t hstepB = (size_t)HALF * S.ldb;
    const unsigned ldsw = (unsigned)wid * 1024u;
    const int aoff = lds_byte(wr * 64 + fr, fq * 8), boff = lds_byte(wc * 32 + fr, fq * 8);
#define G_SA(b, h) (((b) * 2 + (h)) * HTB)
#define G_SB(b, h) ((4 + (b) * 2 + (h)) * HTB)
#define G_STAGE_A(bufoff, kptr, OFF, h) do { _Pragma("unroll") for (int _i = 0; _i < 2; ++_i) \
        __builtin_amdgcn_global_load_lds((const unsigned*)((const char*)(kptr) + (OFF)[h][_i]), (LAS unsigned*)(lds + (bufoff) + ldsw + _i * 8192), 16, 0, 0); } while (0)
#define G_STAGE_B(bufoff, gbase) do { _Pragma("unroll") for (int _i = 0; _i < 2; ++_i) \
        __builtin_amdgcn_global_load_lds((const unsigned*)((const char*)(gbase) + voffB[_i]), (LAS unsigned*)(lds + (bufoff) + ldsw + _i * 8192), 16, 0, 0); } while (0)
#define G_LDA(dst, b, h) do { _Pragma("unroll") for (int m = 0; m < 4; ++m) _Pragma("unroll") for (int k = 0; k < 2; ++k) dst[m][k] = *(const LAS bf16x8*)(lds + G_SA(b, h) + aoff + m * 2048 + k * 1024); } while (0)
#define G_LDB(dst, b, h) do { _Pragma("unroll") for (int n = 0; n < 2; ++n) _Pragma("unroll") for (int k = 0; k < 2; ++k) dst[n][k] = *(const LAS bf16x8*)(lds + G_SB(b, h) + boff + n * 2048 + k * 1024); } while (0)
#define G_MMA(ai, bj, At, Bt) do { __builtin_amdgcn_s_setprio(1); _Pragma("unroll") for (int m = 0; m < 4; ++m) _Pragma("unroll") for (int n = 0; n < 2; ++n) _Pragma("unroll") for (int k = 0; k < 2; ++k) \
        acc[ai][bj][m][n] = __builtin_amdgcn_mfma_f32_16x16x32_bf16(Bt[n][k], At[m][k], acc[ai][bj][m][n], 0, 0, 0); __builtin_amdgcn_s_setprio(0); } while (0)
#define G_WAIT_V(n) asm volatile("s_waitcnt vmcnt(" #n ")" ::: "memory")
#define G_WAIT_L(n) asm volatile("s_waitcnt lgkmcnt(" #n ")" ::: "memory")
#define G_BAR __builtin_amdgcn_s_barrier()
#define G_SCHED __builtin_amdgcn_sched_barrier(0)
    Unit cur, nxt; int ui = 0;
    if (!S.next(0, cur)) return;
    if (S_t::GATHER) S.gather_offs(cur, tid, offC);
    Acc acc;
#pragma unroll
    for (int a = 0; a < 2; ++a)
#pragma unroll
        for (int b = 0; b < 2; ++b)
#pragma unroll
            for (int m = 0; m < 4; ++m)
#pragma unroll
                for (int n = 0; n < 2; ++n) acc[a][b][m][n] = (f32x4){0.f, 0.f, 0.f, 0.f};
    bf16x8 At[4][2], B0[2][2], B1[2][2];
    const char* cA = S.a_ptr(cur); const char* cB = S.b_ptr(cur);
    G_STAGE_B(G_SB(0, 0), cB); G_STAGE_A(G_SA(0, 0), cA, offC, 0); G_STAGE_B(G_SB(0, 1), cB + hstepB); G_STAGE_A(G_SA(0, 1), cA, offC, 1);
    if (wr == 1) G_BAR;
    G_WAIT_V(4); G_BAR;
    G_STAGE_B(G_SB(1, 0), cB + kstep); G_STAGE_A(G_SA(1, 0), cA + kstep, offC, 0); G_STAGE_B(G_SB(1, 1), cB + hstepB + kstep);
    G_WAIT_V(6); G_BAR;
    for (;;) {
        const bool has_next = S.next(ui + 1, nxt);
        const char* nA = has_next ? S.a_ptr(nxt) : cA; const char* nB = has_next ? S.b_ptr(nxt) : cB;
        if (S_t::GATHER) { if (has_next) S.gather_offs(nxt, tid, offN); else { offN[0][0] = offC[0][0]; offN[0][1] = offC[0][1]; offN[1][0] = offC[1][0]; offN[1][1] = offC[1][1]; } }
        for (int t = 0; t < nt; t += 2) {
            const bool last = (t == nt - 2);
            const char* a1 = cA + (size_t)(t + 1) * kstep;
            const char* a2 = last ? nA : cA + (size_t)(t + 2) * kstep; const char* b2 = last ? nB : cB + (size_t)(t + 2) * kstep;
            const char* a3 = a2 + kstep; const char* b3 = b2 + kstep;
            G_LDB(B0, 0, 0); G_SCHED; G_LDA(At, 0, 0); G_STAGE_A(G_SA(1, 1), a1, offC, 1);
            if (S_t::GATHER) { if (last) { offC[0][0] = offN[0][0]; offC[0][1] = offN[0][1]; offC[1][0] = offN[1][0]; offC[1][1] = offN[1][1]; } }
            G_WAIT_L(8); G_BAR; G_WAIT_L(0); G_MMA(0, 0, At, B0); G_BAR; G_SCHED;
            G_LDB(B1, 0, 1); G_STAGE_B(G_SB(0, 0), b2);
            G_BAR; G_WAIT_L(0); G_MMA(0, 1, At, B1); G_BAR;
            G_LDA(At, 0, 1); G_STAGE_A(G_SA(0, 0), a2, offC, 0);
            G_BAR; G_WAIT_L(0); G_MMA(1, 0, At, B0); G_BAR; G_SCHED;
            G_STAGE_B(G_SB(0, 1), b2 + hstepB);
            G_WAIT_V(6); G_BAR; G_MMA(1, 1, At, B1); G_BAR;
            G_LDB(B0, 1, 0); G_SCHED; G_LDA(At, 1, 0); G_STAGE_A(G_SA(0, 1), a2, offC, 1);
            G_WAIT_L(8); G_BAR; G_WAIT_L(0); G_MMA(0, 0, At, B0); G_BAR; G_SCHED;
            G_LDB(B1, 1, 1); G_STAGE_B(G_SB(1, 0), b3);
            G_BAR; G_WAIT_L(0); G_MMA(0, 1, At, B1); G_BAR;
            G_LDA(At, 1, 1); G_STAGE_A(G_SA(1, 0), a3, offC, 0);
            G_BAR; G_WAIT_L(0); G_MMA(1, 0, At, B0); G_BAR; G_SCHED;
            G_STAGE_B(G_SB(1, 1), b3 + hstepB);
            G_WAIT_V(6); G_BAR; G_MMA(1, 1, At, B1); G_BAR;
        }
        if constexpr (!S_t::AFTER) S.epi(acc, cur, wr, wc, fr, fq);
        if (!has_next) break;
#pragma unroll
        for (int a = 0; a < 2; ++a)
#pragma unroll
            for (int b = 0; b < 2; ++b)
#pragma unroll
                for (int m = 0; m < 4; ++m)
#pragma unroll
                    for (int n = 0; n < 2; ++n) acc[a][b][m][n] = (f32x4){0.f, 0.f, 0.f, 0.f};
        cur = nxt; cA = nA; cB = nB; ++ui;
    }
    G_WAIT_V(0);
    if (wr == 0) G_BAR;
    G_BAR;
    if constexpr (S_t::AFTER) S.epi_after(acc, cur, wr, wc, fr, fq, lds);
}

struct ProbBase : OrderStatic {
    static constexpr bool GATHER = false, AFTER = false;
    const char* A; const char* Bt; static constexpr int K = 1024, lda = 2048, ldb = 2048;
    __device__ __forceinline__ const char* a_ptr(const Unit& u) const { return A + (size_t)u.pm * BM * lda; }
    __device__ __forceinline__ const char* b_ptr(const Unit& u) const { return Bt + (size_t)u.pn * BM * ldb; }
    __device__ __forceinline__ void gather_offs(const Unit&, int, unsigned (&)[2][2]) const {}
};

struct ProbInProj : ProbBase {
    static constexpr bool PERM = true;
    bf16_t* out; const float* bias;
    __device__ __forceinline__ void epi(const Acc& acc, const Unit& u, int wr, int wc, int fr, int fq) const {
        const int row0 = u.pm * BM + wr * 64 + fr, colt = u.pn * BM + wc * 32 + 8 * fq;
        f32x4 bv[2][2];
#pragma unroll
        for (int bj = 0; bj < 2; ++bj) { const int c = colt + bj * HALF; int mc = c < COL_UV ? c : (c < COL_GL ? c + 16 : c - COL_GL + COL_UV);
            if (c < NIN) { bv[bj][0] = *(const f32x4*)(bias + mc); bv[bj][1] = *(const f32x4*)(bias + mc + 4); } else { bv[bj][0] = (f32x4){0.f, 0.f, 0.f, 0.f}; bv[bj][1] = bv[bj][0]; } }
#pragma unroll
        for (int ai = 0; ai < 2; ++ai)
#pragma unroll
            for (int m = 0; m < 4; ++m) { bf16_t* rowp = out + (size_t)(row0 + ai * HALF + m * 16) * NP + colt;
#pragma unroll
                for (int bj = 0; bj < 2; ++bj) { const f32x4 v0 = acc[ai][bj][m][0] + bv[bj][0], v1 = acc[ai][bj][m][1] + bv[bj][1];
                    *(u32x4*)(rowp + bj * HALF) = (u32x4){pk2(v0[0], v0[1]), pk2(v0[2], v0[3]), pk2(v1[0], v1[1]), pk2(v1[2], v1[3])}; } }
    }
};
struct ProbBf16 : ProbBase {
    static constexpr bool PERM = true;
    bf16_t* out; int ldc;
    __device__ __forceinline__ void epi(const Acc& acc, const Unit& u, int wr, int wc, int fr, int fq) const {
        const int row0 = u.pm * BM + wr * 64 + fr, colt = u.pn * BM + wc * 32 + 8 * fq;
#pragma unroll
        for (int ai = 0; ai < 2; ++ai)
#pragma unroll
            for (int m = 0; m < 4; ++m) { bf16_t* rowp = out + (size_t)(row0 + ai * HALF + m * 16) * ldc + colt;
#pragma unroll
                for (int bj = 0; bj < 2; ++bj) { const f32x4 v0 = acc[ai][bj][m][0], v1 = acc[ai][bj][m][1];
                    *(u32x4*)(rowp + bj * HALF) = (u32x4){pk2(v0[0], v0[1]), pk2(v0[2], v0[3]), pk2(v1[0], v1[1]), pk2(v1[2], v1[3])}; } }
    }
};
struct ProbQ : ProbBf16 {
    int G2, c2;
    __device__ __forceinline__ bool next(int i, Unit& u) const { const int L = i * G2 + c2; if (L >= 256) return false; const int bh = L >> 4, mt = L & 15; u.pm = (bh >> 2) * 16 + mt; u.pn = bh & 3; u.e = 0; u.aux = 0; return true; }
};
struct ProbRes : ProbBase {
    static constexpr bool PERM = false;
    float* out; const float* xres;
    __device__ __forceinline__ void epi(const Acc& acc, const Unit& u, int wr, int wc, int fr, int fq) const {
        const int row0 = u.pm * BM + wr * 64 + fr, col0 = u.pn * BM + wc * 32 + 4 * fq;
#pragma unroll
        for (int ai = 0; ai < 2; ++ai) {
            f32x4 xr[4][2][2];
#pragma unroll
            for (int m = 0; m < 4; ++m) { const size_t ro = (size_t)(row0 + ai * HALF + m * 16) * DM + col0;
#pragma unroll
                for (int bj = 0; bj < 2; ++bj)
#pragma unroll
                    for (int n = 0; n < 2; ++n) xr[m][bj][n] = *(const f32x4*)(xres + ro + bj * HALF + n * 16); }
#pragma unroll
            for (int m = 0; m < 4; ++m) { const size_t ro = (size_t)(row0 + ai * HALF + m * 16) * DM + col0;
#pragma unroll
                for (int bj = 0; bj < 2; ++bj)
#pragma unroll
                    for (int n = 0; n < 2; ++n) *(f32x4*)(out + ro + bj * HALF + n * 16) = xr[m][bj][n] * ALPHA + acc[ai][bj][m][n]; }
        }
    }
};
struct ProbMT {
    static constexpr bool PERM = true, GATHER = false, AFTER = false;
    static constexpr int K = 256, lda = 2048, ldb = 2048;
    const char* A; const char* Bt; int G, c; bf16_t* out;
    __device__ __forceinline__ bool next(int i, Unit& u) const { const int L = i * G + c; if (L >= 64) return false; u.e = L >> 2; u.pn = L & 3; u.pm = 0; u.aux = 0; return true; }
    __device__ __forceinline__ const char* a_ptr(const Unit& u) const { const int b = u.e >> 2, h = u.e & 3; return A + (size_t)(b * 256) * lda + h * 512; }
    __device__ __forceinline__ const char* b_ptr(const Unit& u) const { const int h = u.e & 3; return Bt + (size_t)u.pn * BM * ldb + h * 512; }
    __device__ __forceinline__ void gather_offs(const Unit&, int, unsigned (&)[2][2]) const {}
    __device__ __forceinline__ void epi(const Acc& acc, const Unit& u, int wr, int wc, int fr, int fq) const {
        const int row0 = wr * 64 + fr, colt = u.pn * BM + wc * 32 + 8 * fq;
#pragma unroll
        for (int ai = 0; ai < 2; ++ai)
#pragma unroll
            for (int m = 0; m < 4; ++m) { bf16_t* rowp = out + (size_t)u.e * 256 * 1024 + (size_t)(row0 + ai * HALF + m * 16) * 1024 + colt;
#pragma unroll
                for (int bj = 0; bj < 2; ++bj) { const f32x4 v0 = acc[ai][bj][m][0], v1 = acc[ai][bj][m][1];
                    *(u32x4*)(rowp + bj * HALF) = (u32x4){pk2(v0[0], v0[1]), pk2(v0[2], v0[3]), pk2(v1[0], v1[1]), pk2(v1[2], v1[3])}; } }
    }
};
struct ProbVW {
    static constexpr bool PERM = true, GATHER = false, AFTER = false;
    static constexpr int K = 256, lda = 2048, ldb = 2048;
    const char* A; const char* Bt; int G, c; bf16_t* out;
    __device__ __forceinline__ bool next(int i, Unit& u) const { const int L = i * G + c; if (L >= 64) return false; u.e = L >> 2; u.pm = L & 3; u.pn = 0; u.aux = 0; return true; }
    __device__ __forceinline__ const char* a_ptr(const Unit& u) const { const int h = u.e & 3; return A + (size_t)u.pm * BM * lda + h * 512; }
    __device__ __forceinline__ const char* b_ptr(const Unit& u) const { const int b = u.e >> 2, h = u.e & 3; return Bt + (size_t)(b * 256) * ldb + h * 512; }
    __device__ __forceinline__ void gather_offs(const Unit&, int, unsigned (&)[2][2]) const {}
    __device__ __forceinline__ void epi(const Acc& acc, const Unit& u, int wr, int wc, int fr, int fq) const {
        const int b = u.e >> 2, h = u.e & 3; const int row0 = u.pm * BM + wr * 64 + fr, colt = h * 256 + wc * 32 + 8 * fq;
#pragma unroll
        for (int ai = 0; ai < 2; ++ai)
#pragma unroll
            for (int m = 0; m < 4; ++m) { bf16_t* rowp = out + (size_t)b * 1024 * 1024 + (size_t)(row0 + ai * HALF + m * 16) * 1024 + colt;
#pragma unroll
                for (int bj = 0; bj < 2; ++bj) { const f32x4 v0 = acc[ai][bj][m][0], v1 = acc[ai][bj][m][1];
                    *(u32x4*)(rowp + bj * HALF) = (u32x4){pk2(v0[0], v0[1]), pk2(v0[2], v0[3]), pk2(v1[0], v1[1]), pk2(v1[2], v1[3])}; } }
    }
};
struct ProbResLN : ProbBase {
    static constexpr bool PERM = false, AFTER = true;
    const float* xres; const float* lng; const float* lnb; float* xf; bf16_t* xb; float* stats; unsigned* cntp; size_t bstride;
    __device__ __forceinline__ const char* b_ptr(const Unit& u) const { return Bt + (size_t)(u.pm >> 4) * bstride + (size_t)u.pn * BM * ldb; }
    __device__ __forceinline__ void epi(const Acc&, const Unit&, int, int, int, int) const {}
    __device__ __forceinline__ void epi_after(Acc& acc, const Unit& u, int wr, int wc, int fr, int fq, LAS unsigned char* lds) const {
        const int tid = ltid();
        const int col0 = u.pn * BM + wc * 32 + 4 * fq;
        LAS float* red = (LAS float*)lds;
        LAS float* tab = (LAS float*)(lds + 8192);
#pragma unroll
        for (int ai = 0; ai < 2; ++ai)
#pragma unroll
            for (int m = 0; m < 4; ++m) { const int rowl = ai * HALF + wr * 64 + m * 16 + fr; const size_t ro = (size_t)(u.pm * BM + rowl) * DM + col0;
                float sv = 0.f, sq = 0.f;
#pragma unroll
                for (int bj = 0; bj < 2; ++bj)
#pragma unroll
                    for (int n = 0; n < 2; ++n) { const f32x4 xr = *(const f32x4*)(xres + ro + bj * HALF + n * 16); const f32x4 y = xr * ALPHA + acc[ai][bj][m][n]; acc[ai][bj][m][n] = y;
                        sv += (y[0] + y[1]) + (y[2] + y[3]); sq += (y[0] * y[0] + y[1] * y[1]) + (y[2] * y[2] + y[3] * y[3]); }
                sv += __shfl_xor(sv, 16); sv += __shfl_xor(sv, 32); sq += __shfl_xor(sq, 16); sq += __shfl_xor(sq, 32);
                if (fq == 0) { red[(rowl * 4 + wc) * 2] = sv; red[(rowl * 4 + wc) * 2 + 1] = sq; } }
        __syncthreads();
        if (tid < 256) { float S = 0.f, SS = 0.f;
#pragma unroll
            for (int w = 0; w < 4; ++w) { S += red[(tid * 4 + w) * 2]; SS += red[(tid * 4 + w) * 2 + 1]; }
            float* st = stats + ((size_t)(u.pm * 4 + u.pn) * 256 + tid) * 2; st[0] = S; st[1] = SS; }
        asm volatile("s_waitcnt vmcnt(0)" ::: "memory");
        __syncthreads();
        if (tid == 0) { unsigned* cw = cntp + u.pm;
            __builtin_amdgcn_fence(__ATOMIC_RELEASE, "agent"); asm volatile("s_waitcnt vmcnt(0)" ::: "memory");
            __hip_atomic_fetch_add(cw, 1u, __ATOMIC_RELAXED, __HIP_MEMORY_SCOPE_AGENT);
            while (__hip_atomic_load(cw, __ATOMIC_RELAXED, __HIP_MEMORY_SCOPE_AGENT) < 4u) __builtin_amdgcn_s_sleep(1);
            __builtin_amdgcn_fence(__ATOMIC_ACQUIRE, "agent"); asm volatile("s_waitcnt vmcnt(0)" ::: "memory"); }
        __syncthreads();
        if (tid < 256) { float S = 0.f, SS = 0.f;
#pragma unroll
            for (int w = 0; w < 4; ++w) { const float* st = stats + ((size_t)(u.pm * 4 + w) * 256 + tid) * 2;
                S += __hip_atomic_load(st, __ATOMIC_RELAXED, __HIP_MEMORY_SCOPE_AGENT); SS += __hip_atomic_load(st + 1, __ATOMIC_RELAXED, __HIP_MEMORY_SCOPE_AGENT); }
            const float mean = S * (1.f / DM), var = fmaxf(SS * (1.f / DM) - mean * mean, 0.f);
            tab[tid * 2] = mean; tab[tid * 2 + 1] = rsqrtf(var + LN_EPS); }
        __syncthreads();
        f32x4 gv[2][2], bv[2][2];
#pragma unroll
        for (int bj = 0; bj < 2; ++bj)
#pragma unroll
            for (int n = 0; n < 2; ++n) { gv[bj][n] = *(const f32x4*)(lng + col0 + bj * HALF + n * 16); bv[bj][n] = *(const f32x4*)(lnb + col0 + bj * HALF + n * 16); }
#pragma unroll
        for (int ai = 0; ai < 2; ++ai)
#pragma unroll
            for (int m = 0; m < 4; ++m) { const int rowl = ai * HALF + wr * 64 + m * 16 + fr; const size_t ro = (size_t)(u.pm * BM + rowl) * DM + col0;
                const float mean = tab[rowl * 2], rstd = tab[rowl * 2 + 1];
#pragma unroll
                for (int bj = 0; bj < 2; ++bj)
#pragma unroll
                    for (int n = 0; n < 2; ++n) { const f32x4 v = (acc[ai][bj][m][n] - mean) * rstd * gv[bj][n] + bv[bj][n];
                        *(f32x4*)(xf + ro + bj * HALF + n * 16) = v; *(u32x2*)(xb + ro + bj * HALF + n * 16) = (u32x2){pk2(v[0], v[1]), pk2(v[2], v[3])}; } }
        __syncthreads();
    }
};
template <int KK> struct ProbMerge {
    static constexpr bool PERM = false, GATHER = false, AFTER = false;
    const char* A; const char* Bt; static constexpr int K = KK, lda = 2048, ldb = 2048; int G, c;
    const bf16_t* p; bf16_t* mb;
    __device__ __forceinline__ bool next(int i, Unit& u) const { const int tile = (KK == 512 ? i : (i >> 1)) * G + c; if (tile >= 256) return false; u.pm = tile >> 2; u.pn = tile & 3; u.e = KK == 512 ? 0 : 1 + (i & 1); u.aux = 0; return true; }
    __device__ __forceinline__ const char* a_ptr(const Unit& u) const { return A + (size_t)u.pm * BM * lda + (KK == 512 ? 0 : 1024 + (u.e - 1) * 512); }
    __device__ __forceinline__ const char* b_ptr(const Unit& u) const { return Bt + (size_t)u.pn * BM * ldb + (KK == 512 ? 0 : 1024 + (u.e - 1) * 512); }
    __device__ __forceinline__ void gather_offs(const Unit&, int, unsigned (&)[2][2]) const {}
    __device__ __forceinline__ void epi(const Acc& acc, const Unit& u, int wr, int wc, int fr, int fq) const {
        const int row0 = u.pm * BM + wr * 64 + fr, col0 = u.pn * BM + wc * 32 + 4 * fq;
        const int gi = u.e;
        const bf16_t* __restrict__ mbr = mb; bf16_t* __restrict__ mbw = mb; const bf16_t* __restrict__ pr = p;
        u32x2 gr[2][2][2]; u32x2 pv[2][2][2];
#define MRG_LOAD(q, buf) do { const int row_ = row0 + ((q) >> 2) * HALF + ((q) & 3) * 16; const size_t ro_ = (size_t)row_ * DM + col0; \
            const bf16_t* gp_ = pr + (size_t)row_ * NP + COL_GATE + gi * 1024 + col0; \
            _Pragma("unroll") for (int bj = 0; bj < 2; ++bj) _Pragma("unroll") for (int n = 0; n < 2; ++n) { gr[buf][bj][n] = *(const u32x2*)(gp_ + bj * HALF + n * 16); \
                pv[buf][bj][n] = (KK != 512) ? *(const u32x2*)(mbr + ro_ + bj * HALF + n * 16) : (u32x2){0u, 0u}; } } while (0)
        MRG_LOAD(0, 0);
#pragma unroll
        for (int q = 0; q < 8; ++q) { const int ai = q >> 2, m = q & 3, buf = q & 1;
            if (q + 1 < 8) MRG_LOAD(q + 1, buf ^ 1);
            const int row = row0 + ai * HALF + m * 16; const size_t ro = (size_t)row * DM + col0;
#pragma unroll
            for (int bj = 0; bj < 2; ++bj)
#pragma unroll
                for (int n = 0; n < 2; ++n) { const u32x2 g2 = gr[buf][bj][n], p2 = pv[buf][bj][n];
                    f32x4 g; g[0] = sigmoid_f(bflo(g2[0])); g[1] = sigmoid_f(bfhi(g2[0])); g[2] = sigmoid_f(bflo(g2[1])); g[3] = sigmoid_f(bfhi(g2[1]));
                    const f32x4 v = g * acc[ai][bj][m][n] + (f32x4){bflo(p2[0]), bfhi(p2[0]), bflo(p2[1]), bfhi(p2[1])};
                    *(u32x2*)(mbw + ro + bj * HALF + n * 16) = (u32x2){pk2(v[0], v[1]), pk2(v[2], v[3])}; } }
#undef MRG_LOAD
    }
};
struct MoeOrder {
    int G, c, nN; const LAS int* tstart; const int* cnt;
    __device__ __forceinline__ bool next(int i, Unit& u) const {
        const int L = i * G + c; const int total = tstart[32] * nN; if (L >= total) return false;
        const int mt = L / nN; u.pn = L % nN; int e = 0;
        for (int k = 1; k < 32; ++k) e += (tstart[k] <= mt) ? 1 : 0;
        u.e = e; u.pm = mt; u.aux = (mt - tstart[e]) * BM; return true;
    }
};
__device__ __forceinline__ float swiglu_f(float g, float l) { g = fminf(g, 7.f); l = fminf(fmaxf(l, -7.f), 7.f); return g * sigmoid_f(1.702f * g) * (l + 1.f); }
struct ProbMoe1 : MoeOrder {
    static constexpr bool PERM = true, GATHER = true, AFTER = false;
    const char* A; const char* Bt; static constexpr int K = 1024, lda = 2048, ldb = 2048; const int* elist; const float* bgu; bf16_t* abuf;
    __device__ __forceinline__ const char* a_ptr(const Unit&) const { return A; }
    __device__ __forceinline__ const char* b_ptr(const Unit& u) const { return Bt + (size_t)u.e * 2048 * ldb + (size_t)u.pn * BM * ldb; }
    __device__ __forceinline__ void gather_offs(const Unit& u, int tid, unsigned (&off)[2][2]) const {
        const int n = cnt[u.e];
#pragma unroll
        for (int i = 0; i < 2; ++i) { int R, C; stage_rc(tid * 16 + i * 8192, R, C);
#pragma unroll
            for (int h = 0; h < 2; ++h) { const int rr = u.aux + h * HALF + R; const int tok = rr < n ? (elist[u.e * ECAP + rr] >> 2) : 0; off[h][i] = (unsigned)(tok * lda + C * 2); } }
    }
    __device__ __forceinline__ void epi(const Acc& acc, const Unit& u, int wr, int wc, int fr, int fq) const {
        const int row0 = u.pm * BM + wr * 64 + fr;
        const float* bb = bgu + (size_t)u.e * 2048;
        const int oc = u.pn * 128 + wc * 32 + 8 * fq;
        f32x4 bg[2], bl[2];
#pragma unroll
        for (int n = 0; n < 2; ++n) { bg[n] = *(const f32x4*)(bb + oc + 4 * n); bl[n] = *(const f32x4*)(bb + 1024 + oc + 4 * n); }
#pragma unroll
        for (int ai = 0; ai < 2; ++ai)
#pragma unroll
            for (int m = 0; m < 4; ++m) { unsigned o[4];
#pragma unroll
                for (int n = 0; n < 2; ++n) { const f32x4 vg = acc[ai][0][m][n] + bg[n], vl = acc[ai][1][m][n] + bl[n];
                    o[2 * n] = pk2(swiglu_f(vg[0], vl[0]), swiglu_f(vg[1], vl[1])); o[2 * n + 1] = pk2(swiglu_f(vg[2], vl[2]), swiglu_f(vg[3], vl[3])); }
                *(u32x4*)(abuf + (size_t)(row0 + ai * HALF + m * 16) * 1024 + oc) = (u32x4){o[0], o[1], o[2], o[3]}; }
    }
};
struct ProbMoe2 : MoeOrder {
    static constexpr bool PERM = true, GATHER = false, AFTER = false;
    const char* A; const char* Bt; static constexpr int K = 1024, lda = 2048, ldb = 2048; const int* elist; const float* bd; const float* tgate; bf16_t* ys;
    __device__ __forceinline__ const char* a_ptr(const Unit& u) const { return A + (size_t)u.pm * BM * lda; }
    __device__ __forceinline__ const char* b_ptr(const Unit& u) const { return Bt + (size_t)u.e * 1024 * ldb + (size_t)u.pn * BM * ldb; }
    __device__ __forceinline__ void gather_offs(const Unit&, int, unsigned (&)[2][2]) const {}
    __device__ __forceinline__ void epi(const Acc& acc, const Unit& u, int wr, int wc, int fr, int fq) const {
        const int n = cnt[u.e]; const int col0 = u.pn * BM + wc * 32 + 8 * fq;
        const float* bb = bd + (size_t)u.e * 1024 + col0;
        f32x4 bv[2][2];
#pragma unroll
        for (int bj = 0; bj < 2; ++bj)
#pragma unroll
            for (int nn = 0; nn < 2; ++nn) bv[bj][nn] = *(const f32x4*)(bb + bj * HALF + nn * 4);
        int aidx[2][4]; float gts[2][4];
#pragma unroll
        for (int ai = 0; ai < 2; ++ai)
#pragma unroll
            for (int m = 0; m < 4; ++m) { const int rr = u.aux + ai * HALF + wr * 64 + m * 16 + fr; aidx[ai][m] = (rr < n) ? elist[u.e * ECAP + rr] : -1; gts[ai][m] = (rr < n) ? tgate[u.e * ECAP + rr] : 0.f; }
#pragma unroll
        for (int ai = 0; ai < 2; ++ai)
#pragma unroll
            for (int m = 0; m < 4; ++m) {
                if (aidx[ai][m] >= 0) { const float g = gts[ai][m]; bf16_t* rowp = ys + (size_t)aidx[ai][m] * 1024 + col0;
#pragma unroll
                    for (int bj = 0; bj < 2; ++bj) { const f32x4 v0 = (acc[ai][bj][m][0] + bv[bj][0]) * g, v1 = (acc[ai][bj][m][1] + bv[bj][1]) * g;
                        *(u32x4*)(rowp + bj * HALF) = (u32x4){pk2(v0[0], v0[1]), pk2(v0[2], v0[3]), pk2(v1[0], v1[1]), pk2(v1[2], v1[3])}; } } }
    }
};

template <int MODE, int KK = 256> struct ProbAttn {
    static constexpr bool PERM = true, GATHER = false, AFTER = (MODE == 0);
    static constexpr int K = KK, lda = 2048, ldb = 2048;
    const char* A; const char* Bt; int G, c; float* sout; bf16_t* oout;
    __device__ __forceinline__ bool next(int i, Unit& u) const { const int L = i * G + c; if (L >= 256) return false; u.e = L >> 4; u.pm = L & 15; u.pn = 0; u.aux = 0; return true; }
    __device__ __forceinline__ const char* a_ptr(const Unit& u) const { const int b = u.e >> 2, h = u.e & 3; return A + ((size_t)(b * SEQL + u.pm * BM) * DM + (KK == 1024 ? 0 : h * 256)) * 2; }
    __device__ __forceinline__ const char* b_ptr(const Unit& u) const { const int b = u.e >> 2, h = u.e & 3;
        if (KK == 1024) return Bt + (size_t)u.e * 256 * 2048;
        return MODE == 0 ? Bt + ((size_t)(b * 256) * DM + h * 256) * 2 : Bt + ((size_t)b * 1024 * 1024 + (size_t)h * 256 * 1024) * 2; }
    __device__ __forceinline__ void gather_offs(const Unit&, int, unsigned (&)[2][2]) const {}
    __device__ __forceinline__ void epi_after(Acc& acc, const Unit& u, int wr, int wc, int fr, int fq, LAS unsigned char* lds) const {
        const int b = u.e >> 2, h = u.e & 3; const int grow0 = b * SEQL + u.pm * BM;
        LAS float* redm = (LAS float*)lds; LAS float* reds = (LAS float*)(lds + 4096);
#pragma unroll
        for (int ai = 0; ai < 2; ++ai)
#pragma unroll
            for (int m = 0; m < 4; ++m) { float v = -3e38f;
#pragma unroll
                for (int bj = 0; bj < 2; ++bj)
#pragma unroll
                    for (int n = 0; n < 2; ++n) v = fmaxf(v, fmaxf(fmaxf(acc[ai][bj][m][n][0], acc[ai][bj][m][n][1]), fmaxf(acc[ai][bj][m][n][2], acc[ai][bj][m][n][3])));
                v = fmaxf(v, __shfl_xor(v, 16)); v = fmaxf(v, __shfl_xor(v, 32));
                if (fq == 0) redm[(ai * HALF + wr * 64 + m * 16 + fr) * 4 + wc] = v; }
        __syncthreads();
#pragma unroll
        for (int ai = 0; ai < 2; ++ai)
#pragma unroll
            for (int m = 0; m < 4; ++m) { const int row = ai * HALF + wr * 64 + m * 16 + fr; const f32x4 r = *(const LAS f32x4*)(redm + row * 4);
                const float M = fmaxf(fmaxf(r[0], r[1]), fmaxf(r[2], r[3])); float sm = 0.f;
#pragma unroll
                for (int bj = 0; bj < 2; ++bj)
#pragma unroll
                    for (int n = 0; n < 2; ++n)
#pragma unroll
                        for (int j = 0; j < 4; ++j) { const float e = __expf((acc[ai][bj][m][n][j] - M) * 0.0625f); acc[ai][bj][m][n][j] = e; sm += e; }
                sm += __shfl_xor(sm, 16); sm += __shfl_xor(sm, 32);
                if (fq == 0) reds[row * 4 + wc] = sm; }
        __syncthreads();
#pragma unroll
        for (int ai = 0; ai < 2; ++ai)
#pragma unroll
            for (int m = 0; m < 4; ++m) { const int row = ai * HALF + wr * 64 + m * 16 + fr; const f32x4 r = *(const LAS f32x4*)(reds + row * 4);
                const float inv = __builtin_amdgcn_rcpf((r[0] + r[1]) + (r[2] + r[3]));
                bf16_t* rowp = oout + (size_t)(grow0 + row) * DM + h * 256 + wc * 32 + 8 * fq;
#pragma unroll
                for (int bj = 0; bj < 2; ++bj) { const f32x4 v0 = acc[ai][bj][m][0] * inv, v1 = acc[ai][bj][m][1] * inv;
                    *(u32x4*)(rowp + bj * HALF) = (u32x4){pk2(v0[0], v0[1]), pk2(v0[2], v0[3]), pk2(v1[0], v1[1]), pk2(v1[2], v1[3])}; } }
        __syncthreads();
    }
    __device__ __forceinline__ void epi(const Acc& acc, const Unit& u, int wr, int wc, int fr, int fq) const {
        const int b = u.e >> 2, h = u.e & 3; const int row0 = b * SEQL + u.pm * BM + wr * 64 + fr;
        if (MODE == 0) { const int col0 = h * 256 + wc * 32 + 4 * fq;
#pragma unroll
            for (int ai = 0; ai < 2; ++ai)
#pragma unroll
                for (int m = 0; m < 4; ++m) { float* rowp = sout + (size_t)(row0 + ai * HALF + m * 16) * DM + col0;
#pragma unroll
                    for (int bj = 0; bj < 2; ++bj)
#pragma unroll
                        for (int n = 0; n < 2; ++n) *(f32x4*)(rowp + bj * HALF + n * 16) = acc[ai][bj][m][n] * 0.0625f; }
        } else { const int colt = h * 256 + wc * 32 + 8 * fq;
#pragma unroll
            for (int ai = 0; ai < 2; ++ai)
#pragma unroll
                for (int m = 0; m < 4; ++m) { bf16_t* rowp = oout + (size_t)(row0 + ai * HALF + m * 16) * DM + colt;
#pragma unroll
                    for (int bj = 0; bj < 2; ++bj) { const f32x4 v0 = acc[ai][bj][m][0], v1 = acc[ai][bj][m][1];
                        *(u32x4*)(rowp + bj * HALF) = (u32x4){pk2(v0[0], v0[1]), pk2(v0[2], v0[3]), pk2(v1[0], v1[1]), pk2(v1[2], v1[3])}; } }
        }
    }
};
__device__ __forceinline__ void phase_softmax(const Params& P) {
    const int tid = ltid(); const int lane = tid & 63, wid = __builtin_amdgcn_readfirstlane(tid >> 6); const int gw = blockIdx.x * 8 + wid, NGW = gridDim.x * 8;
    const float* S = (const float*)(P.ws + WS_MRGF); bf16_t* Pb = (bf16_t*)(P.ws + WS_QB);
    for (int r = gw; r < NTOK * 4; r += NGW) { const size_t o = (size_t)r * 256 + lane * 4;
        const f32x4 v = *(const f32x4*)(S + o);
        const float mx = wave_max(fmaxf(fmaxf(v[0], v[1]), fmaxf(v[2], v[3])));
        const float e0 = __expf(v[0] - mx), e1 = __expf(v[1] - mx), e2 = __expf(v[2] - mx), e3 = __expf(v[3] - mx);
        const float inv = 1.f / wave_sum((e0 + e1) + (e2 + e3));
        *(u32x2*)(Pb + o) = (u32x2){pk2(e0 * inv, e1 * inv), pk2(e2 * inv, e3 * inv)}; }
}

__device__ __forceinline__ void tr_item(const float* __restrict__ src, int ldn, int scol, int k0, bf16_t* dst0, int ldk, LAS unsigned char* wl, int lane) {
    float v[64];
    const bool valid = scol >= 0;
    const float* s = src + (size_t)k0 * ldn + (valid ? scol : 0);
#pragma unroll
    for (int kk = 0; kk < 64; ++kk) v[kk] = s[(size_t)kk * ldn];
#pragma unroll
    for (int c = 0; c < 8; ++c) { u32x4 w;
#pragma unroll
        for (int q = 0; q < 4; ++q) w[q] = valid ? pk2(v[8 * c + 2 * q], v[8 * c + 2 * q + 1]) : 0u;
        *(LAS u32x4*)(wl + lane * 144 + c * 16) = w; }
    WBAR();
#pragma unroll
    for (int it = 0; it < 8; ++it) { const int row = it * 8 + (lane >> 3), c16 = lane & 7; const u32x4 w = *(const LAS u32x4*)(wl + row * 144 + c16 * 16);
        *(u32x4*)(dst0 + (size_t)row * ldk + c16 * 8) = w; }
    WBAR();
}
__device__ __forceinline__ void row_to_bf16(const float* src, bf16_t* dst, int lane) {
#pragma unroll
    for (int j = 0; j < 4; ++j) { const f32x4 v = *(const f32x4*)(src + j * 256 + lane * 4); *(u32x2*)(dst + j * 256 + lane * 4) = (u32x2){pk2(v[0], v[1]), pk2(v[2], v[3])}; }
}
__device__ __forceinline__ void phase_convert(const Params& P, LAS unsigned char* lds) {
    const int tid = ltid(); const int lane = tid & 63, wid = __builtin_amdgcn_readfirstlane(tid >> 6);
    const int gw = blockIdx.x * 8 + wid, NGW = gridDim.x * 8;
    LAS unsigned char* wl = lds + wid * 9216;
    unsigned char* ws = P.ws;
    constexpr int I_WIN = 16 * 88, I_SQ = 256, I_GU = 32 * 512, I_D = 32 * 256, I_L = I_WIN + 6 * I_SQ + I_GU + I_D;
    for (int it = gw; it < 2 * I_L; it += NGW) {
        const int l = it / I_L; int r = it % I_L;
        if (r < I_WIN) { const int ntl = r % 88, kt = r / 88; const int n = ntl * 64 + lane;
            const int sc = n < COL_UV ? n : (n < COL_GL ? n + 16 : (n < NIN ? n - COL_GL + COL_UV : -1));
            tr_item(P.in[2] + (size_t)l * 1024 * NIN, NIN, sc, kt * 64, (bf16_t*)(ws + WS_WIN + l * SZ_WIN) + (size_t)ntl * 64 * 1024 + kt * 64, 1024, wl, lane); continue; }
        r -= I_WIN;
        if (r < I_SQ) {
            const int ntl = r % 16, kt = r / 16; const float* src; int kk;
            if (kt < 8) { src = P.in[13] + (size_t)l * 512 * 1024; kk = kt; } else if (kt < 12) { src = P.in[14] + (size_t)l * 256 * 1024; kk = kt - 8; } else { src = P.in[15] + (size_t)l * 256 * 1024; kk = kt - 12; }
            tr_item(src, 1024, ntl * 64 + lane, kk * 64, (bf16_t*)(ws + WS_WUP + l * SZ_SQ) + (size_t)ntl * 64 * 1024 + kt * 64, 1024, wl, lane); continue; }
        r -= I_SQ;
        if (r < 5 * I_SQ) { const int w = r / I_SQ; const int rr = r % I_SQ; const int ntl = rr % 16, kt = rr / 16;
            const int ii = w == 0 ? 16 : 18 + w;
            const size_t wso = w == 0 ? WS_WO : (w == 1 ? WS_OB : (w == 2 ? WS_WK : (w == 3 ? WS_WV : WS_WXO)));
            tr_item(P.in[ii] + (size_t)l * 1024 * 1024, 1024, ntl * 64 + lane, kt * 64, (bf16_t*)(ws + wso + l * SZ_SQ) + (size_t)ntl * 64 * 1024 + kt * 64, 1024, wl, lane); continue; }
        r -= 5 * I_SQ;
        if (r < I_GU) { const int e = r / 512; const int rr = r % 512; const int ntl = rr % 32, kt = rr / 32; const int n = ntl * 64 + lane; const int g = n >> 8, w = n & 255;
            const int sc = w < 128 ? 128 * g + w : 1024 + 128 * g + (w - 128);
            tr_item(P.in[27] + ((size_t)l * 32 + e) * 1024 * 2048, 2048, sc, kt * 64, (bf16_t*)(ws + WS_WGU + l * SZ_WGU) + ((size_t)e * 2048 + ntl * 64) * 1024 + kt * 64, 1024, wl, lane); continue; }
        r -= I_GU;
        { const int e = r / 256; const int rr = r % 256; const int ntl = rr % 16, kt = rr / 16;
            tr_item(P.in[29] + ((size_t)l * 32 + e) * 1024 * 1024, 1024, ntl * 64 + lane, kt * 64, (bf16_t*)(ws + WS_WD + l * SZ_WD) + ((size_t)e * 1024 + ntl * 64) * 1024 + kt * 64, 1024, wl, lane); }
    }
    for (int m = gw; m < NTOK + 1024 + 2048; m += NGW) {
        if (m < NTOK) row_to_bf16(P.in[0] + (size_t)m * DM, (bf16_t*)(ws + WS_XB) + (size_t)m * DM, lane);
        else if (m >= NTOK + 1024) row_to_bf16(P.in[19] + (size_t)(m - NTOK - 1024) * DM, (bf16_t*)(ws + WS_WQ) + (size_t)(m - NTOK - 1024) * DM, lane);
        else row_to_bf16(P.in[1] + (size_t)(m - NTOK) * DM, (bf16_t*)(ws + WS_MEMB) + (size_t)(m - NTOK) * DM, lane);
    }
}

__device__ __forceinline__ bf16x8 ldfrag(const LAS bf16_t* base, int row, int stride, int k) { return *(const LAS bf16x8*)(base + row * stride + k); }

__device__ __forceinline__ void sgu_item(const Params& P, int l, int item, LAS unsigned char* lds) {
    const int tid = ltid(), lane = tid & 63, wid = tid >> 6, fr = lane & 15, fq = lane >> 4;
    const bf16_t* p = (const bf16_t*)(P.ws + WS_P); bf16_t* ycat = (bf16_t*)(P.ws + WS_YCAT);
    const int t0 = item * 128;
    LAS bf16_t* vnT = (LAS bf16_t*)lds;
    LAS bf16_t* wsb = (LAS bf16_t*)(lds + 69632);
    LAS float* red = (LAS float*)(lds + 69632 + 34816);
    {
        const int t = tid & 127, qd = tid >> 7;
        const bf16_t* src = p + (size_t)(t0 + t) * NP + COL_UV + 256 + qd * 64;
        float s = 0.f, ss = 0.f;
#pragma unroll
        for (int c = 0; c < 8; ++c) { const u32x4 w = *(const u32x4*)(src + c * 8);
#pragma unroll
            for (int q = 0; q < 4; ++q) { const float a = gelu_f(bflo(w[q])), b = gelu_f(bfhi(w[q])); s += a + b; ss += a * a + b * b; } }
        red[(t * 4 + qd) * 2] = s; red[(t * 4 + qd) * 2 + 1] = ss;
        __syncthreads();
        float S = 0.f, SS = 0.f;
#pragma unroll
        for (int q = 0; q < 4; ++q) { S += red[(t * 4 + q) * 2]; SS += red[(t * 4 + q) * 2 + 1]; }
        const float mean = S * (1.f / 256.f), var = fmaxf(SS * (1.f / 256.f) - mean * mean, 0.f), rstd = rsqrtf(var + LN_EPS);
        const float* lg = P.in[7] + l * 256 + qd * 64; const float* lb = P.in[8] + l * 256 + qd * 64;
#pragma unroll 2
        for (int c = 0; c < 8; ++c) { const u32x4 w = *(const u32x4*)(src + c * 8);
#pragma unroll
            for (int q = 0; q < 4; ++q) { const float a = gelu_f(bflo(w[q])), b = gelu_f(bfhi(w[q])); const int ch = c * 8 + 2 * q;
                vnT[(qd * 64 + ch) * 136 + t] = f2bf((a - mean) * rstd * lg[ch] + lb[ch]);
                vnT[(qd * 64 + ch + 1) * 136 + t] = f2bf((b - mean) * rstd * lg[ch + 1] + lb[ch + 1]); } }
    }
    for (int g = 0; g < 4; ++g) {
        __syncthreads();
        const float* wsg = P.in[9] + ((size_t)l * 4 + g) * 128 * 128;
#pragma unroll
        for (int i = 0; i < 4; ++i) { const int id = tid + i * 512; const int t = id >> 4, s8 = (id & 15) * 8;
            const f32x4 a = *(const f32x4*)(wsg + t * 128 + s8), b = *(const f32x4*)(wsg + t * 128 + s8 + 4);
            float w[8] = {a[0], a[1], a[2], a[3], b[0], b[1], b[2], b[3]};
#pragma unroll
            for (int q = 0; q < 8; ++q) w[q] = (s8 + q <= t) ? w[q] : 0.f;
            *(LAS u32x4*)(wsb + t * 136 + s8) = (u32x4){pk2(w[0], w[1]), pk2(w[2], w[3]), pk2(w[4], w[5]), pk2(w[6], w[7])}; }
        __syncthreads();
#pragma unroll
        for (int q = 0; q < 4; ++q) { const int tile = wid * 4 + q; const int ti = tile >> 2, di = tile & 3;
            f32x4 acc = {0.f, 0.f, 0.f, 0.f};
            const int ksmax = (ti * 16 + 15) >> 5;
            for (int ks = 0; ks <= ksmax; ++ks) {
                const bf16x8 a = ldfrag(wsb, ti * 16 + fr, 136, ks * 32 + 8 * fq), b = ldfrag(vnT, g * 64 + di * 16 + fr, 136, ks * 32 + 8 * fq);
                acc = __builtin_amdgcn_mfma_f32_16x16x32_bf16(a, b, acc, 0, 0, 0); }
            const int ch = g * 64 + di * 16 + fr;
#pragma unroll
            for (int j = 0; j < 4; ++j) { const int t = ti * 16 + 4 * fq + j;
                const float sv = acc[j] + P.in[10][((size_t)l * 4 + g) * 128 + t];
                const float u = gelu_f(bf2f(p[(size_t)(t0 + t) * NP + COL_UV + ch]));
                ycat[(size_t)(t0 + t) * DM + 512 + ch] = f2bf(u * sv); } }
    }
    __syncthreads();
}

__device__ __forceinline__ void gla1_item(const Params& P, int l, int idx, LAS unsigned char* lds) {
    const int tid = ltid();
    const bf16_t* p = (const bf16_t*)(P.ws + WS_P);
    float* bcum = (float*)(P.ws + WS_BCUM); float* kvT = (float*)(P.ws + WS_KVT); float* cdec = (float*)(P.ws + WS_CDEC);
    const int h = idx & 3, bn = idx >> 2; const int t0 = bn * 64;
    LAS float* gl = (LAS float*)lds;
    LAS float* tot = (LAS float*)(lds + 4096);
    LAS float* kt = (LAS float*)(lds + 8192);
    LAS float* vs = (LAS float*)(lds + 8192 + 16384);
#pragma unroll
    for (int i = 0; i < 2; ++i) { const int id = tid + i * 512; gl[id] = bf2f(p[(size_t)(t0 + (id >> 4)) * NP + COL_GL + (id & 15)]); }
#pragma unroll
    for (int i = 0; i < 2; ++i) { const int id = tid + i * 512; const int t = id >> 4, e8 = (id & 15) * 8;
        const u32x4 w = *(const u32x4*)(p + (size_t)(t0 + t) * NP + COL_V + h * 128 + e8);
        *(LAS f32x4*)(vs + t * 128 + e8) = (f32x4){bflo(w[0]), bfhi(w[0]), bflo(w[1]), bfhi(w[1])};
        *(LAS f32x4*)(vs + t * 128 + e8 + 4) = (f32x4){bflo(w[2]), bfhi(w[2]), bflo(w[3]), bfhi(w[3])}; }
    __syncthreads();
    {
        const int tq = tid >> 6, d = tid & 63;
        float wreg[16];
#pragma unroll
        for (int r = 0; r < 16; ++r) wreg[r] = P.in[4][((size_t)l * 16 + r) * 256 + h * 64 + d];
        const float bgv = P.in[5][l * 256 + h * 64 + d];
        float pre[8]; float run = 0.f;
#pragma unroll
        for (int i = 0; i < 8; ++i) { const int t = tq * 8 + i; float z = bgv;
#pragma unroll
            for (int r = 0; r < 16; ++r) z += gl[t * 16 + r] * wreg[r];
            const float ls = fminf(z, 0.f) - log1pf(__expf(-fabsf(z)));
            run += ls * (1.f / 16.f); pre[i] = run; }
        tot[tq * 64 + d] = run;
        __syncthreads();
        float off = 0.f, total = 0.f;
#pragma unroll
        for (int g = 0; g < 8; ++g) { const float x = tot[g * 64 + d]; total += x; off += (g < tq) ? x : 0.f; }
#pragma unroll
        for (int i = 0; i < 8; ++i) { const int t = tq * 8 + i; const float bv = off + pre[i];
            bcum[(size_t)(t0 + t) * 256 + h * 64 + d] = bv;
            kt[t * 64 + d] = bf2f(p[(size_t)(t0 + t) * NP + COL_K + h * 64 + d]) * __expf(total - bv); }
        if (tq == 0) cdec[idx * 64 + d] = __expf(total);
    }
    __syncthreads();
    {
        const int d4 = tid & 15, e4 = tid >> 4;
        f32x4 a0 = {0.f, 0.f, 0.f, 0.f}, a1 = a0, a2 = a0, a3 = a0;
        for (int t = 0; t < 64; ++t) { const f32x4 kv = *(const LAS f32x4*)(kt + t * 64 + 4 * d4), vv = *(const LAS f32x4*)(vs + t * 128 + 4 * e4);
            a0 += kv * vv[0]; a1 += kv * vv[1]; a2 += kv * vv[2]; a3 += kv * vv[3]; }
        float* o = kvT + (size_t)idx * 8192 + (4 * e4) * 64 + 4 * d4;
        *(f32x4*)(o) = a0; *(f32x4*)(o + 64) = a1; *(f32x4*)(o + 128) = a2; *(f32x4*)(o + 192) = a3;
    }
    __syncthreads();
}

__device__ __forceinline__ void pool_item(const Params& P, int l, int item, LAS unsigned char* lds) {
    const int tid = ltid(), lane = tid & 63, wid = tid >> 6, fr = lane & 15, fq = lane >> 4;
    const bf16_t* p = (const bf16_t*)(P.ws + WS_P); bf16_t* ycat = (bf16_t*)(P.ws + WS_YCAT);
    const int T0 = item * 64, pos0 = T0 & (SEQL - 1);
    LAS bf16_t* xs = (LAS bf16_t*)lds;
    LAS bf16_t* ybf = (LAS bf16_t*)(lds + 42240);
    LAS bf16_t* pwT = (LAS bf16_t*)(lds + 42240 + 33792);
#pragma unroll
    for (int i = 0; i < 5; ++i) { const int id = tid + i * 512; const int r = id >> 5, c8 = (id & 31) * 8;
        u32x4 w = {0u, 0u, 0u, 0u};
        if (pos0 - 16 + r >= 0) w = *(const u32x4*)(p + (size_t)(T0 - 16 + r) * NP + COL_XC + c8);
        *(LAS u32x4*)(xs + r * 264 + c8) = w; }
    const float* pw = P.in[11] + (size_t)l * 4 * 64 * 64;
#pragma unroll 4
    for (int i = 0; i < 32; ++i) { const int id = tid + i * 512; const int g = id >> 12, c = (id >> 6) & 63, dd = id & 63; pwT[(g * 64 + dd) * 72 + c] = f2bf(pw[id]); }
    __syncthreads();
    {
        const int ch = tid & 255, th = tid >> 8; const int gi = ch >> 6, w = 2 << gi;
        float sum = 0.f;
        for (int j = 1; j < w; ++j) sum += bf2f(xs[(16 + th * 32 - j) * 264 + ch]);
        for (int tt = 0; tt < 32; ++tt) { const int t = th * 32 + tt; const float x = bf2f(xs[(16 + t) * 264 + ch]);
            sum += x; const int pos = pos0 + t; const float cntf = (float)min(pos + 1, w);
            ybf[t * 264 + ch] = f2bf(sum / cntf - x);
            sum -= bf2f(xs[(16 + t - w + 1) * 264 + ch]); }
    }
    __syncthreads();
#pragma unroll
    for (int q = 0; q < 8; ++q) { const int tile = wid * 8 + q; const int g = tile >> 4, ti = (tile >> 2) & 3, di = tile & 3;
        f32x4 acc = {0.f, 0.f, 0.f, 0.f};
#pragma unroll
        for (int ks = 0; ks < 2; ++ks) { const bf16x8 a = ldfrag(ybf, ti * 16 + fr, 264, g * 64 + ks * 32 + 8 * fq), b = ldfrag(pwT, g * 64 + di * 16 + fr, 72, ks * 32 + 8 * fq);
            acc = __builtin_amdgcn_mfma_f32_16x16x32_bf16(a, b, acc, 0, 0, 0); }
        const int ch = g * 64 + di * 16 + fr; const float sc = P.in[12][l * 256 + ch];
#pragma unroll
        for (int j = 0; j < 4; ++j) ycat[(size_t)(T0 + ti * 16 + 4 * fq + j) * DM + 768 + ch] = f2bf(acc[j] * sc); }
    __syncthreads();
}

__device__ __forceinline__ void phase_mixer_local(const Params& P, int l, LAS unsigned char* lds) {
    constexpr int N_SGU = 128, N_GLA = 1024, N_POOL = 256;
    if (gridDim.x == 256) {
        const int b = blockIdx.x; int first, cntn;
        if (b < N_SGU) { sgu_item(P, l, b, lds); first = b * 3; cntn = 3; } else { first = 384 + (b - N_SGU) * 7; cntn = 7; }
        for (int k = 0; k < cntn; ++k) { const int it = first + k; if (it < N_GLA) gla1_item(P, l, it, lds); else pool_item(P, l, it - N_GLA, lds); }
        return;
    }
    for (int it = blockIdx.x; it < N_SGU + N_GLA + N_POOL; it += gridDim.x) {
        if (it < N_SGU) sgu_item(P, l, it, lds);
        else if (it < N_SGU + N_GLA) gla1_item(P, l, it - N_SGU, lds);
        else pool_item(P, l, it - N_SGU - N_GLA, lds);
    }
}

__device__ __forceinline__ void phase_scan(const Params& P) {
    const float* kvT = (const float*)(P.ws + WS_KVT); const float* cdec = (const float*)(P.ws + WS_CDEC); bf16_t* sT = (bf16_t*)(P.ws + WS_ST);
    for (int g = blockIdx.x * 512 + ltid(); g < 16 * 8192; g += gridDim.x * 512) {
        const int bh = g >> 13, ed = g & 8191, d = ed & 63, b = bh >> 2, h = bh & 3;
        float S = 0.f;
#pragma unroll 8
        for (int n = 0; n < 64; ++n) { const int ci = (b * 64 + n) * 4 + h;
            sT[(size_t)ci * 8192 + ed] = f2bf(S);
            S = cdec[ci * 64 + d] * S + kvT[(size_t)ci * 8192 + ed]; }
    }
}

struct G2R { u32x4 qw, kw, vw0, vw1, sw0, sw1, r0, r1; f32x4 b0, b1; };
__device__ __forceinline__ void gla2_load(const Params& P, int idx, int tid, G2R& r) {
    const bf16_t* p = (const bf16_t*)(P.ws + WS_P); const float* bcum = (const float*)(P.ws + WS_BCUM); const bf16_t* sT = (const bf16_t*)(P.ws + WS_ST);
    const int h = idx & 3, bn = idx >> 2; const int t0 = bn * 64;
    const int t = tid >> 3, c8 = (tid & 7) * 8;
    r.qw = *(const u32x4*)(p + (size_t)(t0 + t) * NP + h * 64 + c8); r.kw = *(const u32x4*)(p + (size_t)(t0 + t) * NP + COL_K + h * 64 + c8);
    r.b0 = *(const f32x4*)(bcum + (size_t)(t0 + t) * 256 + h * 64 + c8); r.b1 = *(const f32x4*)(bcum + (size_t)(t0 + t) * 256 + h * 64 + c8 + 4);
    { const int id = tid; const int tt = id >> 4, e8 = (id & 15) * 8; r.vw0 = *(const u32x4*)(p + (size_t)(t0 + tt) * NP + COL_V + h * 128 + e8); }
    { const int id = tid + 512; const int tt = id >> 4, e8 = (id & 15) * 8; r.vw1 = *(const u32x4*)(p + (size_t)(t0 + tt) * NP + COL_V + h * 128 + e8); }
    { const int id = tid; const int e = id >> 3, d8 = (id & 7) * 8; r.sw0 = *(const u32x4*)(sT + (size_t)idx * 8192 + e * 64 + d8); }
    { const int id = tid + 512; const int e = id >> 3, d8 = (id & 7) * 8; r.sw1 = *(const u32x4*)(sT + (size_t)idx * 8192 + e * 64 + d8); }
    { const int seg = tid & 7; const bf16_t* rp = p + (size_t)(t0 + t) * NP + COL_R + h * 128 + seg * 16; r.r0 = *(const u32x4*)rp; r.r1 = *(const u32x4*)(rp + 8); }
}
__device__ __forceinline__ void gla2_item(const Params& P, int l, int idx, int nidx, const G2R& R, G2R& RN, LAS unsigned char* lds) {
    const int tid = ltid(), lane = tid & 63, wid = tid >> 6, fr = lane & 15, fq = lane >> 4;
    bf16_t* ycat = (bf16_t*)(P.ws + WS_YCAT);
    const int h = idx & 3, bn = idx >> 2; const int t0 = bn * 64;
    LAS bf16_t* qd = (LAS bf16_t*)lds;
    LAS bf16_t* kd = (LAS bf16_t*)(lds + 9216);
    LAS bf16_t* vT = (LAS bf16_t*)(lds + 18432);
    LAS bf16_t* Ps = (LAS bf16_t*)(lds + 36864);
    LAS bf16_t* sTs = (LAS bf16_t*)(lds + 46080);
    LAS float* of = (LAS float*)(lds + 64512);
    {
        const int t = tid >> 3, c8 = (tid & 7) * 8;
        const u32x4 qw = R.qw, kw = R.kw; const f32x4 b0 = R.b0, b1 = R.b1;
        float bb[8] = {b0[0], b0[1], b0[2], b0[3], b1[0], b1[1], b1[2], b1[3]}; float qv[8], kv[8];
#pragma unroll
        for (int q = 0; q < 4; ++q) { qv[2 * q] = bflo(qw[q]); qv[2 * q + 1] = bfhi(qw[q]); kv[2 * q] = bflo(kw[q]); kv[2 * q + 1] = bfhi(kw[q]); }
#pragma unroll
        for (int q = 0; q < 8; ++q) { const float e = __expf(bb[q]); qv[q] = qv[q] * 0.125f * e; kv[q] = kv[q] * __expf(-bb[q]); }
        *(LAS u32x4*)(qd + t * 72 + c8) = (u32x4){pk2(qv[0], qv[1]), pk2(qv[2], qv[3]), pk2(qv[4], qv[5]), pk2(qv[6], qv[7])};
        *(LAS u32x4*)(kd + t * 72 + c8) = (u32x4){pk2(kv[0], kv[1]), pk2(kv[2], kv[3]), pk2(kv[4], kv[5]), pk2(kv[6], kv[7])};
#pragma unroll
        for (int i = 0; i < 2; ++i) { const int id = tid + i * 512; const int tt = id >> 4, e8 = (id & 15) * 8;
            const u32x4 w = i == 0 ? R.vw0 : R.vw1;
#pragma unroll
            for (int q = 0; q < 4; ++q) { vT[(e8 + 2 * q) * 72 + tt] = (bf16_t)(w[q] & 0xffffu); vT[(e8 + 2 * q + 1) * 72 + tt] = (bf16_t)(w[q] >> 16); } }
#pragma unroll
        for (int i = 0; i < 2; ++i) { const int id = tid + i * 512; const int e = id >> 3, d8 = (id & 7) * 8;
            *(LAS u32x4*)(sTs + e * 72 + d8) = i == 0 ? R.sw0 : R.sw1; }
    }
    __syncthreads();
    if (nidx >= 0) gla2_load(P, nidx, tid, RN);
#pragma unroll
    for (int q = 0; q < 2; ++q) { const int tile = wid * 2 + q; const int ti = tile >> 2, si = tile & 3;
        f32x4 acc = {0.f, 0.f, 0.f, 0.f};
        if (si <= ti) {
#pragma unroll
            for (int ks = 0; ks < 2; ++ks) { const bf16x8 a = ldfrag(qd, ti * 16 + fr, 72, ks * 32 + 8 * fq), b = ldfrag(kd, si * 16 + fr, 72, ks * 32 + 8 * fq);
                acc = __builtin_amdgcn_mfma_f32_16x16x32_bf16(a, b, acc, 0, 0, 0); } }
        const int s = si * 16 + fr;
#pragma unroll
        for (int j = 0; j < 4; ++j) { const int t = ti * 16 + 4 * fq + j; Ps[t * 72 + s] = f2bf(s <= t ? acc[j] : 0.f); } }
    __syncthreads();
#pragma unroll
    for (int q = 0; q < 4; ++q) { const int tile = wid * 4 + q; const int ti = tile >> 3, ei = tile & 7;
        f32x4 acc = {0.f, 0.f, 0.f, 0.f};
#pragma unroll
        for (int ks = 0; ks < 2; ++ks) { const bf16x8 a = ldfrag(Ps, ti * 16 + fr, 72, ks * 32 + 8 * fq), b = ldfrag(vT, ei * 16 + fr, 72, ks * 32 + 8 * fq);
            acc = __builtin_amdgcn_mfma_f32_16x16x32_bf16(a, b, acc, 0, 0, 0); }
#pragma unroll
        for (int ks = 0; ks < 2; ++ks) { const bf16x8 a = ldfrag(qd, ti * 16 + fr, 72, ks * 32 + 8 * fq), b = ldfrag(sTs, ei * 16 + fr, 72, ks * 32 + 8 * fq);
            acc = __builtin_amdgcn_mfma_f32_16x16x32_bf16(a, b, acc, 0, 0, 0); }
#pragma unroll
        for (int j = 0; j < 4; ++j) of[(ti * 16 + 4 * fq + j) * 132 + ei * 16 + fr] = acc[j]; }
    __syncthreads();
    {
        const int t = tid >> 3, seg = tid & 7;
        float o[16]; float ss = 0.f;
#pragma unroll
        for (int q = 0; q < 4; ++q) { const f32x4 v = *(const LAS f32x4*)(of + t * 132 + seg * 16 + 4 * q); o[4 * q] = v[0]; o[4 * q + 1] = v[1]; o[4 * q + 2] = v[2]; o[4 * q + 3] = v[3]; ss += v[0] * v[0] + v[1] * v[1] + v[2] * v[2] + v[3] * v[3]; }
        ss += __shfl_xor(ss, 1); ss += __shfl_xor(ss, 2); ss += __shfl_xor(ss, 4);
        const float rstd = rsqrtf(ss * (1.f / 128.f) + LN_EPS);
        const float* gn = P.in[6] + l * 512 + h * 128 + seg * 16;
        const u32x4 r0 = R.r0, r1 = R.r1;
        float rv[16];
#pragma unroll
        for (int q = 0; q < 4; ++q) { rv[2 * q] = bflo(r0[q]); rv[2 * q + 1] = bfhi(r0[q]); rv[8 + 2 * q] = bflo(r1[q]); rv[8 + 2 * q + 1] = bfhi(r1[q]); }
        float y[16];
#pragma unroll
        for (int q = 0; q < 16; ++q) y[q] = o[q] * rstd * gn[q] * (rv[q] * sigmoid_f(rv[q]));
        bf16_t* yo = ycat + (size_t)(t0 + t) * DM + h * 128 + seg * 16;
        *(u32x4*)yo = (u32x4){pk2(y[0], y[1]), pk2(y[2], y[3]), pk2(y[4], y[5]), pk2(y[6], y[7])};
        *(u32x4*)(yo + 8) = (u32x4){pk2(y[8], y[9]), pk2(y[10], y[11]), pk2(y[12], y[13]), pk2(y[14], y[15])};
    }
    __syncthreads();
}

__device__ __forceinline__ void attn_item(const Params& P, int l, int item, LAS unsigned char* lds) {
    const int tid = ltid(), lane = tid & 63, wid = tid >> 6, fr = lane & 15, fq = lane >> 4;
    const int qt = item & 31, h = (item >> 5) & 3, b = item >> 7;
    const bf16_t* qb = (const bf16_t*)(P.ws + WS_QB) + (size_t)(b * SEQL + qt * 128) * DM + h * 256;
    const bf16_t* km = (const bf16_t*)(P.ws + WS_KM + l * SZ_SQ) + (size_t)(b * 256) * DM + h * 256;
    const bf16_t* vt = (const bf16_t*)(P.ws + WS_VT + l * SZ_SQ) + ((size_t)b * 1024 + h * 256) * 256;
    bf16_t* ob = (bf16_t*)(P.ws + WS_OB) + (size_t)(b * SEQL + qt * 128) * DM + h * 256;
    LAS bf16_t* QP = (LAS bf16_t*)lds;
    LAS bf16_t* KV = (LAS bf16_t*)(lds + 67584);
#pragma unroll
    for (int i = 0; i < 8; ++i) { const int id = tid + i * 512; const int r = id >> 5, c8 = (id & 31) * 8; *(LAS u32x4*)(QP + r * 264 + c8) = *(const u32x4*)(qb + (size_t)r * DM + c8); }
    u32x4 pre[4];
#pragma unroll
    for (int i = 0; i < 4; ++i) { const int id = tid + i * 512; const int r = id >> 5, c8 = (id & 31) * 8; pre[i] = *(const u32x4*)(km + (size_t)r * DM + c8); }
#pragma unroll
    for (int i = 0; i < 4; ++i) { const int id = tid + i * 512; const int r = id >> 5, c8 = (id & 31) * 8; *(LAS u32x4*)(KV + r * 264 + c8) = pre[i]; }
    __syncthreads();
#ifdef ATT_DBG0
    {
#if ATT_DBG0 == 1
#pragma unroll
    for (int i = 0; i < 8; ++i) { const int id = tid + i * 512; const int r = id >> 5, c8 = (id & 31) * 8; *(u32x4*)(ob + (size_t)r * DM + c8) = *(const LAS u32x4*)(QP + r * 264 + c8); }
#else
#pragma unroll
    for (int i = 0; i < 4; ++i) { const int id = tid + i * 512; const int r = id >> 5, c8 = (id & 31) * 8; *(u32x4*)(ob + (size_t)r * DM + c8) = *(const LAS u32x4*)(KV + r * 264 + c8); *(u32x4*)(ob + (size_t)(r + 64) * DM + c8) = *(const LAS u32x4*)(KV + r * 264 + c8); }
#endif
    __syncthreads(); return; }
#endif
    bf16x8 aq[8];
#pragma unroll
    for (int ks = 0; ks < 8; ++ks) aq[ks] = ldfrag(QP, wid * 16 + fr, 264, ks * 32 + 8 * fq);
    f32x4 acc[16];
#pragma unroll
    for (int i = 0; i < 16; ++i) acc[i] = (f32x4){0.f, 0.f, 0.f, 0.f};
#pragma unroll
    for (int c = 0; c < 4; ++c) {
#pragma unroll
        for (int kt = 0; kt < 4; ++kt)
#pragma unroll
            for (int ks = 0; ks < 8; ++ks) acc[c * 4 + kt] = __builtin_amdgcn_mfma_f32_16x16x32_bf16(aq[ks], ldfrag(KV, kt * 16 + fr, 264, ks * 32 + 8 * fq), acc[c * 4 + kt], 0, 0, 0);
        __syncthreads();
#pragma unroll
        for (int i = 0; i < 4; ++i) { const int id = tid + i * 512; const int r = id >> 5, c8 = (id & 31) * 8;
            *(LAS u32x4*)(KV + r * 264 + c8) = (c < 3) ? *(const u32x4*)(km + (size_t)((c + 1) * 64 + r) * DM + c8) : *(const u32x4*)(vt + (size_t)r * 256 + c8); }
        __syncthreads();
    }
#ifdef ATT_DBG1
    {
#pragma unroll
    for (int i = 0; i < 16; ++i)
#pragma unroll
        for (int j = 0; j < 4; ++j) ob[(size_t)(wid * 16 + 4 * fq + j) * DM + i * 16 + fr] = f2bf(acc[i][j]);
    return; }
#endif
#pragma unroll
    for (int j = 0; j < 4; ++j) {
        float mx = -1e30f;
#pragma unroll
        for (int i = 0; i < 16; ++i) mx = fmaxf(mx, acc[i][j]);
        mx = fmaxf(mx, __shfl_xor(mx, 1)); mx = fmaxf(mx, __shfl_xor(mx, 2)); mx = fmaxf(mx, __shfl_xor(mx, 4)); mx = fmaxf(mx, __shfl_xor(mx, 8));
        float sm = 0.f;
#pragma unroll
        for (int i = 0; i < 16; ++i) { const float e = __expf((acc[i][j] - mx) * 0.0625f); acc[i][j] = e; sm += e; }
        sm += __shfl_xor(sm, 1); sm += __shfl_xor(sm, 2); sm += __shfl_xor(sm, 4); sm += __shfl_xor(sm, 8);
        const float inv = 1.f / sm;
#pragma unroll
        for (int i = 0; i < 16; ++i) QP[(wid * 16 + 4 * fq + j) * 264 + i * 16 + fr] = f2bf(acc[i][j] * inv);
    }
    WBAR();
#pragma unroll
    for (int ks = 0; ks < 8; ++ks) aq[ks] = ldfrag(QP, wid * 16 + fr, 264, ks * 32 + 8 * fq);
#pragma unroll
    for (int i = 0; i < 16; ++i) acc[i] = (f32x4){0.f, 0.f, 0.f, 0.f};
#pragma unroll
    for (int c = 0; c < 4; ++c) {
#pragma unroll
        for (int dt = 0; dt < 4; ++dt)
#pragma unroll
            for (int ks = 0; ks < 8; ++ks) acc[c * 4 + dt] = __builtin_amdgcn_mfma_f32_16x16x32_bf16(aq[ks], ldfrag(KV, dt * 16 + fr, 264, ks * 32 + 8 * fq), acc[c * 4 + dt], 0, 0, 0);
        __syncthreads();
        if (c < 3) {
#pragma unroll
            for (int i = 0; i < 4; ++i) { const int id = tid + i * 512; const int r = id >> 5, c8 = (id & 31) * 8; *(LAS u32x4*)(KV + r * 264 + c8) = *(const u32x4*)(vt + (size_t)((c + 1) * 64 + r) * 256 + c8); } }
        __syncthreads();
    }
#pragma unroll
    for (int i = 0; i < 16; ++i)
#pragma unroll
        for (int j = 0; j < 4; ++j) ob[(size_t)(wid * 16 + 4 * fq + j) * DM + i * 16 + fr] = f2bf(acc[i][j]);
}

__device__ __forceinline__ void ln_core(f32x4 (&v)[4], const float* g, const float* b, int lane) {
    float s = 0.f;
#pragma unroll
    for (int j = 0; j < 4; ++j) s += (v[j][0] + v[j][1]) + (v[j][2] + v[j][3]);
    const float mean = wave_sum(s) * (1.f / DM);
    float s2 = 0.f;
#pragma unroll
    for (int j = 0; j < 4; ++j) { v[j] = v[j] - mean; s2 += (v[j][0] * v[j][0] + v[j][1] * v[j][1]) + (v[j][2] * v[j][2] + v[j][3] * v[j][3]); }
    const float rstd = rsqrtf(wave_sum(s2) * (1.f / DM) + LN_EPS);
#pragma unroll
    for (int j = 0; j < 4; ++j) { const f32x4 gg = *(const f32x4*)(g + j * 256 + lane * 4), bb = *(const f32x4*)(b + j * 256 + lane * 4); v[j] = v[j] * rstd * gg + bb; }
}
__device__ __forceinline__ void ln_store(const f32x4 (&v)[4], float* of, bf16_t* obf, int lane) {
#pragma unroll
    for (int j = 0; j < 4; ++j) { *(f32x4*)(of + j * 256 + lane * 4) = v[j]; if (obf) *(u32x2*)(obf + j * 256 + lane * 4) = (u32x2){pk2(v[j][0], v[j][1]), pk2(v[j][2], v[j][3])}; }
}
__device__ __forceinline__ void phase_ln1(const Params& P, int l) {
    const int tid = ltid(); const int lane = tid & 63, wid = __builtin_amdgcn_readfirstlane(tid >> 6); const int gw = blockIdx.x * 8 + wid, NGW = gridDim.x * 8;
    const float* y = (const float*)(P.ws + WS_YBUF); float* xf = (float*)(P.ws + WS_XF); bf16_t* xb = (bf16_t*)(P.ws + WS_XB);
    for (int m = gw; m < NTOK; m += NGW) { f32x4 v[4];
#pragma unroll
        for (int j = 0; j < 4; ++j) v[j] = *(const f32x4*)(y + (size_t)m * DM + j * 256 + lane * 4);
        ln_core(v, P.in[17] + l * DM, P.in[18] + l * DM, lane);
        ln_store(v, xf + (size_t)m * DM, xb + (size_t)m * DM, lane); }
}
__device__ __forceinline__ void phase_ln2_router(const Params& P, int l, LAS unsigned char* lds) {
    const int tid = ltid(); const int lane = tid & 63, wid = __builtin_amdgcn_readfirstlane(tid >> 6); const int gw = blockIdx.x * 8 + wid, NGW = gridDim.x * 8;
    const float* y = (const float*)(P.ws + WS_YBUF); float* xf = (float*)(P.ws + WS_XF); bf16_t* xb = (bf16_t*)(P.ws + WS_XB);
    int* cnt = (int*)(P.ws + WS_CTL) + l * 32; int* elist = (int*)(P.ws + WS_ELIST); float* tgate = (float*)(P.ws + WS_TGATE);
    LAS float* xs = (LAS float*)(lds + wid * 16384);
    const float* rw = P.in[25] + (size_t)l * 1024 * 32; const float* rb = P.in[26] + l * 32;
    for (int pr = gw; pr < NTOK / 4; pr += NGW) {
#pragma unroll
        for (int rr = 0; rr < 4; ++rr) { const int m = pr * 4 + rr; f32x4 v[4];
#pragma unroll
            for (int j = 0; j < 4; ++j) v[j] = *(const f32x4*)(y + (size_t)m * DM + j * 256 + lane * 4);
            ln_core(v, P.in[23] + l * DM, P.in[24] + l * DM, lane);
            ln_store(v, xf + (size_t)m * DM, xb + (size_t)m * DM, lane);
#pragma unroll
            for (int j = 0; j < 4; ++j) *(LAS f32x4*)(xs + rr * 1024 + j * 256 + lane * 4) = v[j]; }
        WBAR();
        const int e = lane & 31, hf = lane >> 5;
        float a[4] = {0.f, 0.f, 0.f, 0.f};
        for (int kb = 0; kb < 16; ++kb) { const int k0 = hf * 512 + kb * 32;
            float w[32];
#pragma unroll
            for (int j = 0; j < 32; ++j) w[j] = rw[(k0 + j) * 32 + e];
#pragma unroll
            for (int j4 = 0; j4 < 8; ++j4)
#pragma unroll
                for (int rr = 0; rr < 4; ++rr) { const f32x4 x = *(const LAS f32x4*)(xs + rr * 1024 + k0 + j4 * 4);
                    a[rr] += x[0] * w[4 * j4]; a[rr] += x[1] * w[4 * j4 + 1]; a[rr] += x[2] * w[4 * j4 + 2]; a[rr] += x[3] * w[4 * j4 + 3]; } }
        const float bias = rb[e];
#pragma unroll
        for (int rr = 0; rr < 4; ++rr) { const int m = pr * 4 + rr;
            float lg = a[rr] + __shfl_xor(a[rr], 32) + bias; lg = (lg == lg) ? fminf(fmaxf(lg, -1e30f), 1e30f) : -1e30f; float v = (lane < 32) ? lg : -3e38f;
            float tv[4]; int te[4];
#pragma unroll
            for (int k = 0; k < 4; ++k) { const float mx = wave_max(v); const unsigned long long bal = __ballot(v == mx); const int idx = (__ffsll((long long)bal) - 1) & 31; tv[k] = mx; te[k] = idx; if (lane == idx) v = -3e38f; }
            const float e1 = __expf(tv[1] - tv[0]), e2 = __expf(tv[2] - tv[0]), e3 = __expf(tv[3] - tv[0]); const float inv = 1.f / (1.f + e1 + e2 + e3);
            if (lane < 4) { const int ee = lane == 0 ? te[0] : (lane == 1 ? te[1] : (lane == 2 ? te[2] : te[3])); const float gg = (lane == 0 ? 1.f : (lane == 1 ? e1 : (lane == 2 ? e2 : e3))) * inv;
                const int pos = atomicAdd(cnt + ee, 1); elist[ee * ECAP + pos] = m * 4 + lane; tgate[ee * ECAP + pos] = gg; } }
        WBAR();
    }
}
__device__ __forceinline__ void phase_router_old(const Params& P, int l, LAS unsigned char* lds) {
    const int tid = ltid(); const int lane = tid & 63, wid = __builtin_amdgcn_readfirstlane(tid >> 6); const int gw = blockIdx.x * 8 + wid, NGW = gridDim.x * 8;
    const float* y = (const float*)(P.ws + WS_YBUF); float* xf = (float*)(P.ws + WS_XF); bf16_t* xb = (bf16_t*)(P.ws + WS_XB);
    int* cnt = (int*)(P.ws + WS_CTL) + l * 32; int* elist = (int*)(P.ws + WS_ELIST); float* tgate = (float*)(P.ws + WS_TGATE);
    LAS float* xs = (LAS float*)(lds + wid * 16384);
    const float* rw = P.in[25] + (size_t)l * 1024 * 32; const float* rb = P.in[26] + l * 32;
    for (int pr = gw; pr < NTOK / 4; pr += NGW) {
#pragma unroll
        for (int rr = 0; rr < 4; ++rr) { const int m = pr * 4 + rr; f32x4 v[4];
#pragma unroll
            for (int j = 0; j < 4; ++j) v[j] = *(const f32x4*)(xf + (size_t)m * DM + j * 256 + lane * 4);
#pragma unroll
            for (int j = 0; j < 4; ++j) *(LAS f32x4*)(xs + rr * 1024 + j * 256 + lane * 4) = v[j]; }
        WBAR();
        const int e = lane & 31, hf = lane >> 5;
        float a[4] = {0.f, 0.f, 0.f, 0.f};
        for (int kb = 0; kb < 16; ++kb) { const int k0 = hf * 512 + kb * 32;
            float w[32];
#pragma unroll
            for (int j = 0; j < 32; ++j) w[j] = rw[(k0 + j) * 32 + e];
#pragma unroll
            for (int j4 = 0; j4 < 8; ++j4)
#pragma unroll
                for (int rr = 0; rr < 4; ++rr) { const f32x4 x = *(const LAS f32x4*)(xs + rr * 1024 + k0 + j4 * 4);
                    a[rr] += x[0] * w[4 * j4]; a[rr] += x[1] * w[4 * j4 + 1]; a[rr] += x[2] * w[4 * j4 + 2]; a[rr] += x[3] * w[4 * j4 + 3]; } }
        const float bias = rb[e];
#pragma unroll
        for (int rr = 0; rr < 4; ++rr) { const int m = pr * 4 + rr;
            float lg = a[rr] + __shfl_xor(a[rr], 32) + bias; lg = (lg == lg) ? fminf(fmaxf(lg, -1e30f), 1e30f) : -1e30f; float v = (lane < 32) ? lg : -3e38f;
            float tv[4]; int te[4];
#pragma unroll
            for (int k = 0; k < 4; ++k) { const float mx = wave_max(v); const unsigned long long bal = __ballot(v == mx); const int idx = (__ffsll((long long)bal) - 1) & 31; tv[k] = mx; te[k] = idx; if (lane == idx) v = -3e38f; }
            const float e1 = __expf(tv[1] - tv[0]), e2 = __expf(tv[2] - tv[0]), e3 = __expf(tv[3] - tv[0]); const float inv = 1.f / (1.f + e1 + e2 + e3);
            if (lane < 4) { const int ee = lane == 0 ? te[0] : (lane == 1 ? te[1] : (lane == 2 ? te[2] : te[3])); const float gg = (lane == 0 ? 1.f : (lane == 1 ? e1 : (lane == 2 ? e2 : e3))) * inv;
                const int pos = atomicAdd(cnt + ee, 1); elist[ee * ECAP + pos] = m * 4 + lane; tgate[ee * ECAP + pos] = gg; } }
        WBAR();
    }
}
__device__ __forceinline__ void phase_router(const Params& P, int l, LAS unsigned char* lds) {
    if (gridDim.x != 256) { phase_router_old(P, l, lds); return; }
    const int tid = ltid(); const int lane = tid & 63, wid = __builtin_amdgcn_readfirstlane(tid >> 6); const int gw = blockIdx.x * 8 + wid, NGW = gridDim.x * 8;
    const float* xf = (const float*)(P.ws + WS_XF);
    int* cnt = (int*)(P.ws + WS_CTL) + l * 32; int* elist = (int*)(P.ws + WS_ELIST); float* tgate = (float*)(P.ws + WS_TGATE);
    LAS float* xs = (LAS float*)(lds + wid * 16384);
    LAS int* lcnt = (LAS int*)(lds + 131072 + 256); LAS int* lbase = (LAS int*)(lds + 131072 + 384);
    const float* rw = P.in[25] + (size_t)l * 1024 * 32; const float* rb = P.in[26] + l * 32;
    if (tid < 32) lcnt[tid] = 0;
    __syncthreads();
    int rec_e[2][4], rec_p[2][4]; float rec_g[2][4];
    {
        const int e = lane & 31, hf = lane >> 5;
        float a[8] = {0.f, 0.f, 0.f, 0.f, 0.f, 0.f, 0.f, 0.f};
#pragma unroll 1
        for (int ps = 0; ps < 2; ++ps) {
#pragma unroll
            for (int r8 = 0; r8 < 8; ++r8) { const int m = (gw + (r8 >> 2) * NGW) * 4 + (r8 & 3);
#pragma unroll
                for (int j = 0; j < 2; ++j) *(LAS f32x4*)(xs + r8 * 512 + j * 256 + lane * 4) = *(const f32x4*)(xf + (size_t)m * DM + ps * 512 + j * 256 + lane * 4); }
            WBAR();
            for (int kb = 0; kb < 8; ++kb) { const int kl = hf * 256 + kb * 32;
                float w[32];
#pragma unroll
                for (int j = 0; j < 32; ++j) w[j] = rw[(ps * 512 + kl + j) * 32 + e];
#pragma unroll
                for (int j4 = 0; j4 < 8; ++j4)
#pragma unroll
                    for (int r8 = 0; r8 < 8; ++r8) { const f32x4 x = *(const LAS f32x4*)(xs + r8 * 512 + kl + j4 * 4);
                        a[r8] += x[0] * w[4 * j4]; a[r8] += x[1] * w[4 * j4 + 1]; a[r8] += x[2] * w[4 * j4 + 2]; a[r8] += x[3] * w[4 * j4 + 3]; } }
            WBAR();
        }
        const float bias = rb[e];
#pragma unroll
        for (int r8 = 0; r8 < 8; ++r8) { const int q = r8 >> 2, rr = r8 & 3; const int m = (gw + q * NGW) * 4 + rr;
            float lg = a[r8] + __shfl_xor(a[r8], 32) + bias; lg = (lg == lg) ? fminf(fmaxf(lg, -1e30f), 1e30f) : -1e30f; float v = (lane < 32) ? lg : -3e38f;
            float tv[4]; int te[4];
#pragma unroll
            for (int k = 0; k < 4; ++k) { const float mx = wave_max(v); const unsigned long long bal = __ballot(v == mx); const int idx = (__ffsll((long long)bal) - 1) & 31; tv[k] = mx; te[k] = idx; if (lane == idx) v = -3e38f; }
            const float e1 = __expf(tv[1] - tv[0]), e2 = __expf(tv[2] - tv[0]), e3 = __expf(tv[3] - tv[0]); const float inv = 1.f / (1.f + e1 + e2 + e3);
            rec_e[q][rr] = 0; rec_p[q][rr] = 0; rec_g[q][rr] = 0.f;
            if (lane < 4) { const int ee = lane == 0 ? te[0] : (lane == 1 ? te[1] : (lane == 2 ? te[2] : te[3])); const float gg = (lane == 0 ? 1.f : (lane == 1 ? e1 : (lane == 2 ? e2 : e3))) * inv;
                rec_e[q][rr] = ee; rec_p[q][rr] = __hip_atomic_fetch_add(lcnt + ee, 1, __ATOMIC_RELAXED, __HIP_MEMORY_SCOPE_WORKGROUP); rec_g[q][rr] = gg; } }
    }
    __syncthreads();
    if (tid < 32) lbase[tid] = atomicAdd(cnt + tid, lcnt[tid]);
    __syncthreads();
    if (lane < 4) {
#pragma unroll
        for (int q = 0; q < 2; ++q)
#pragma unroll
            for (int rr = 0; rr < 4; ++rr) { const int m = (gw + q * NGW) * 4 + rr; const int ee = rec_e[q][rr]; const int slot = ee * ECAP + lbase[ee] + rec_p[q][rr]; elist[slot] = m * 4 + lane; tgate[slot] = rec_g[q][rr]; } }
    __syncthreads();
}
__device__ __forceinline__ void phase_ln3(const Params& P, int l) {
    const int tid = ltid(); const int lane = tid & 63, wid = __builtin_amdgcn_readfirstlane(tid >> 6); const int gw = blockIdx.x * 8 + wid, NGW = gridDim.x * 8;
    float* xf = (float*)(P.ws + WS_XF); bf16_t* xb = (bf16_t*)(P.ws + WS_XB); const bf16_t* ys = (const bf16_t*)(P.ws + WS_YS);
    for (int m = gw; m < NTOK; m += NGW) { f32x4 v[4];
#pragma unroll
        for (int j = 0; j < 4; ++j) { v[j] = *(const f32x4*)(xf + (size_t)m * DM + j * 256 + lane * 4) * ALPHA;
#pragma unroll
            for (int k = 0; k < 4; ++k) { const u32x2 w = *(const u32x2*)(ys + ((size_t)m * 4 + k) * DM + j * 256 + lane * 4); v[j] += (f32x4){bflo(w[0]), bfhi(w[0]), bflo(w[1]), bfhi(w[1])}; } }
        ln_core(v, P.in[31] + l * DM, P.in[32] + l * DM, lane);
        if (l == 1) ln_store(v, P.out + (size_t)m * DM, nullptr, lane); else ln_store(v, xf + (size_t)m * DM, xb + (size_t)m * DM, lane); }
}

__device__ __forceinline__ void set_base(ProbBase& S, const void* A, int lda, const void* Bt, int ldb, int M, int N, int K, int G, int c) { S.A = (const char*)A; S.Bt = (const char*)Bt; S.init(M, N, G, c); }

typedef const Params __attribute__((address_space(4))) CParams;
__global__ void __launch_bounds__(512, 2) mega(Params Pk) {
    extern __shared__ __attribute__((aligned(16))) unsigned char smem[];
    LAS unsigned char* lds = (LAS unsigned char*)smem;
    cg::grid_group grid = cg::this_grid();
    CParams* kp = (CParams*)__builtin_amdgcn_kernarg_segment_ptr();
    const int lo = Pk.ph_lo, hi = Pk.ph_hi;
    int nbar = 0;
#ifndef PHMASK
#define PHMASK 0xffffffffu
#endif
#define EN(k) (((PHMASK) >> (k)) & 1u)
#ifndef REPMASK
#define REPMASK 0u
#endif
#define NREP(k) ((((REPMASK) >> (k)) & 1u) ? 2 : 1)
#define RB(k) for (int rep_ = 0; rep_ < NREP(k); ++rep_) { if (rep_) GRID_BARRIER();
#define RE }
#define GRID_BARRIER() do { asm volatile("s_waitcnt vmcnt(0) lgkmcnt(0)" ::: "memory"); __syncthreads(); \
        if (nbar == 0) grid.sync(); \
        if (ltid() == 0) { unsigned* bw = (unsigned*)(kp->ws + WS_CTL + 1024) + nbar * 160; const unsigned gx = gridDim.x, sg = blockIdx.x & 7u; const unsigned nsub = (gx + 7u - sg) >> 3; const unsigned ngrp = gx < 8u ? gx : 8u; \
            __builtin_amdgcn_fence(__ATOMIC_RELEASE, "agent"); asm volatile("s_waitcnt vmcnt(0)" ::: "memory"); \
            const unsigned old = __hip_atomic_fetch_add(bw + 16 + sg * 16, 1u, __ATOMIC_RELAXED, __HIP_MEMORY_SCOPE_AGENT); \
            if (old + 1u == nsub) __hip_atomic_fetch_add(bw, 1u, __ATOMIC_RELAXED, __HIP_MEMORY_SCOPE_AGENT); \
            while (__hip_atomic_load(bw, __ATOMIC_RELAXED, __HIP_MEMORY_SCOPE_AGENT) < ngrp) __builtin_amdgcn_s_sleep(1); \
            __builtin_amdgcn_fence(__ATOMIC_ACQUIRE, "agent"); asm volatile("s_waitcnt vmcnt(0)" ::: "memory"); } \
        __syncthreads(); ++nbar; } while (0)
#define LOCAL_SYNC() do { asm volatile("s_waitcnt vmcnt(0) lgkmcnt(0)" ::: "memory"); __syncthreads(); if (ltid() < 64) { asm volatile("buffer_inv sc1\n\ts_waitcnt vmcnt(0)" ::: "memory"); } __syncthreads(); } while (0)
#define PH_BEGIN(id) if ((id) >= lo && (id) < hi) { CParams* kq = kp; asm volatile("" : "+s"(kq)); const Params& P = *(const Params*)kq; unsigned char* ws = P.ws; \
        int G = gridDim.x, bx = blockIdx.x; asm volatile("" : "+s"(G), "+s"(bx)); (void)ws; (void)G; (void)bx;
#define PH_END(id) if ((id) + 1 < hi) GRID_BARRIER(); }
    PH_BEGIN(0) if (EN(0)) RB(0) phase_convert(P, lds);  RE PH_END(0)
#define LAYER(l, B) \
    PH_BEGIN(B + 0) if (EN(1)) RB(1) { \
        { ProbInProj S; set_base(S, ws + WS_XB, 2048, ws + WS_WIN + l * SZ_WIN, 2048, NTOK, NP, 1024, G, bx); S.out = (bf16_t*)(ws + WS_P); S.bias = P.in[3] + (size_t)l * NIN; gemm_phase(lds, S); } \
        if (l == 0) { for (int ll = 0; ll < 2; ++ll) { \
          { ProbBf16 S; set_base(S, ws + WS_MEMB, 2048, ws + WS_WK + ll * SZ_SQ, 2048, 1024, 1024, 1024, G, (bx + G - 128 - 32 * ll) % G); S.out = (bf16_t*)(ws + WS_KM + ll * SZ_SQ); S.ldc = 1024; gemm_phase(lds, S); } \
          { ProbBf16 S; set_base(S, ws + WS_MEMB, 2048, ws + WS_WV + ll * SZ_SQ, 2048, 1024, 1024, 1024, G, (bx + G - 144 - 32 * ll) % G); S.out = (bf16_t*)(ws + WS_VT + ll * SZ_SQ); S.ldc = 1024; gemm_phase(lds, S); } } } }  RE PH_END(B + 0) \
    PH_BEGIN(B + 1) if (EN(2)) RB(2) phase_mixer_local(P, l, lds);  RE PH_END(B + 1) \
    PH_BEGIN(B + 2) if (EN(3)) RB(3) { phase_scan(P); \
        if (l == 0) { for (int ll = 0; ll < 2; ++ll) { \
          { ProbVW S; S.A = (const char*)(ws + WS_WXO + ll * SZ_SQ); S.Bt = (const char*)(ws + WS_VT + ll * SZ_SQ); S.G = G; S.c = (bx + G - 128 * ll) % G; S.out = (bf16_t*)(ws + WS_OB + (size_t)ll * 4 * SZ_SQ); gemm_phase(lds, S); } \
          { ProbMT S; S.A = (const char*)(ws + WS_KM + ll * SZ_SQ); S.Bt = (const char*)(ws + WS_WQ + ll * SZ_SQ); S.G = G; S.c = (bx + G - 64 - 128 * ll) % G; S.out = (bf16_t*)(ws + WS_QB + (size_t)ll * 4 * SZ_SQ); gemm_phase(lds, S); } } } }  RE PH_END(B + 2) \
    PH_BEGIN(B + 3) if (EN(4)) RB(4) { G2R ra, rb; int it = bx; if (it < 1024) { gla2_load(P, it, ltid(), ra); for (;;) { const int i2 = it + G; const bool h2 = i2 < 1024; gla2_item(P, l, it, h2 ? i2 : -1, ra, rb, lds); if (!h2) break; const int i3 = i2 + G; const bool h3 = i3 < 1024; gla2_item(P, l, i2, h3 ? i3 : -1, rb, ra, lds); if (!h3) break; it = i3; } } }  RE PH_END(B + 3) \
    PH_BEGIN(B + 4) if (EN(5)) RB(5) { { ProbMerge<512> S; S.A = (const char*)(ws + WS_YCAT); S.Bt = (const char*)(ws + WS_WUP + l * SZ_SQ); S.G = G; S.c = bx; \
            S.p = (const bf16_t*)(ws + WS_P); S.mb = (bf16_t*)(ws + WS_MRGB); gemm_phase(lds, S); } \
            asm volatile("s_waitcnt vmcnt(0)" ::: "memory"); __syncthreads(); \
            { ProbMerge<256> S; S.A = (const char*)(ws + WS_YCAT); S.Bt = (const char*)(ws + WS_WUP + l * SZ_SQ); S.G = G; S.c = bx; \
            S.p = (const bf16_t*)(ws + WS_P); S.mb = (bf16_t*)(ws + WS_MRGB); gemm_phase(lds, S); } }  RE PH_END(B + 4) \
    PH_BEGIN(B + 5) if (EN(6)) RB(6) { ProbResLN S; set_base(S, ws + WS_MRGB, 2048, ws + WS_WO + l * SZ_SQ, 2048, NTOK, 1024, 1024, G, bx); \
            S.xres = (l == 0) ? P.in[0] : (const float*)(ws + WS_XF); S.lng = P.in[17] + l * DM; S.lnb = P.in[18] + l * DM; S.xf = (float*)(ws + WS_XF); S.xb = (bf16_t*)(ws + WS_XB); \
            S.stats = (float*)(ws + WS_STATS); S.cntp = (unsigned*)(ws + WS_CTL + 24576) + (l * 2 + 0) * 64; S.bstride = 0; gemm_phase(lds, S); }  RE PH_END(B + 5) \
    PH_BEGIN(B + 7) if (EN(8)) RB(8) { ProbAttn<0, 1024> S; S.A = (const char*)(ws + WS_XB); S.Bt = (const char*)(ws + WS_QB + (size_t)l * 4 * SZ_SQ); S.G = G; S.c = bx; S.sout = nullptr; S.oout = (bf16_t*)(ws + WS_MRGF); gemm_phase(lds, S); }  RE PH_END(B + 7) \
    PH_BEGIN(B + 10) if (EN(6)) RB(6) { ProbResLN S; set_base(S, ws + WS_MRGF, 2048, ws + WS_OB + (size_t)l * 4 * SZ_SQ, 2048, NTOK, 1024, 1024, G, bx); \
            S.xres = (const float*)(ws + WS_XF); S.lng = P.in[23] + l * DM; S.lnb = P.in[24] + l * DM; S.xf = (float*)(ws + WS_XF); S.xb = (bf16_t*)(ws + WS_XB); \
            S.stats = (float*)(ws + WS_STATS); S.cntp = (unsigned*)(ws + WS_CTL + 24576) + (l * 2 + 1) * 64; S.bstride = SZ_SQ; gemm_phase(lds, S); }  RE PH_END(B + 10) \
    PH_BEGIN(B + 11) if (EN(10)) RB(10) phase_router(P, l, lds);  RE PH_END(B + 11) \
    PH_BEGIN(B + 12) if (EN(11)) RB(11) { LAS int* tstart = (LAS int*)(lds + 131072); const int* cnt = (const int*)(ws + WS_CTL) + l * 32; \
            if (ltid() == 0) { int a = 0; for (int e = 0; e < 32; ++e) { tstart[e] = a; a += (cnt[e] + 255) >> 8; } tstart[32] = a; } \
            __syncthreads(); \
            ProbMoe1 S; S.G = G; S.c = (G % 8 == 0) ? (bx % 8) * (G / 8) + bx / 8 : bx; S.nN = 8; S.tstart = tstart; S.cnt = cnt; \
            S.A = (const char*)(ws + WS_XB); S.Bt = (const char*)(ws + WS_WGU + l * SZ_WGU); \
            S.elist = (const int*)(ws + WS_ELIST); S.bgu = P.in[28] + (size_t)l * 32 * 2048; S.abuf = (bf16_t*)(ws + WS_ABUF); gemm_phase(lds, S); }  RE PH_END(B + 12) \
    PH_BEGIN(B + 13) if (EN(12)) RB(12) { LAS int* tstart = (LAS int*)(lds + 131072); const int* cnt = (const int*)(ws + WS_CTL) + l * 32; \
            if (ltid() == 0) { int a = 0; for (int e = 0; e < 32; ++e) { tstart[e] = a; a += (cnt[e] + 255) >> 8; } tstart[32] = a; } \
            __syncthreads(); \
            ProbMoe2 S; S.G = G; S.c = (G % 8 == 0) ? (bx % 8) * (G / 8) + bx / 8 : bx; S.nN = 4; S.tstart = tstart; S.cnt = cnt; \
            S.A = (const char*)(ws + WS_ABUF); S.Bt = (const char*)(ws + WS_WD + l * SZ_WD); \
            S.elist = (const int*)(ws + WS_ELIST); S.bd = P.in[30] + (size_t)l * 32 * 1024; S.tgate = (const float*)(ws + WS_TGATE); S.ys = (bf16_t*)(ws + WS_YS); gemm_phase(lds, S); }  RE PH_END(B + 13) \
    PH_BEGIN(B + 14) if (EN(13)) RB(13) phase_ln3(P, l);  RE PH_END(B + 14)
    LAYER(0, 1)
    LAYER(1, 16)
#ifdef EXTRA_BARS
    for (int xb_ = 0; xb_ < EXTRA_BARS; ++xb_) GRID_BARRIER();
#endif
#ifdef DBG_OFF
    { GRID_BARRIER(); const Params& P = *(const Params*)kp; const int G = gridDim.x, bx = blockIdx.x; const int gt = bx * 512 + ltid();
      for (size_t i = gt; i < (size_t)NTOK * DM; i += (size_t)G * 512) {
#if DBG_BF16
          { float dv = bf2f(((const bf16_t*)(P.ws + DBG_OFF))[i]); P.out[i] = (dv == dv && fabsf(dv) < 1e30f) ? dv : 1000.f; }
#else
          P.out[i] = ((const float*)(P.ws + DBG_OFF))[i];
#endif
      } }
#endif
}

extern "C" void kernel_launch(void* const* d_in, const int* in_sizes, int n_in, void* d_out, int out_size, void* d_ws, size_t ws_size, hipStream_t stream) {
    static int grid = 0;
    if (grid == 0) {
        int dev = 0, cus = 0, per_cu = 0;
        hipGetDevice(&dev);
        hipDeviceGetAttribute(&cus, hipDeviceAttributeMultiprocessorCount, dev);
        hipFuncSetAttribute((const void*)mega, hipFuncAttributeMaxDynamicSharedMemorySize, LDS_BYTES);
        hipOccupancyMaxActiveBlocksPerMultiprocessor(&per_cu, (const void*)mega, 512, LDS_BYTES);
        if (per_cu < 1) per_cu = 1;
        grid = cus < 256 ? cus : 256;
        if (ws_size < WS_END) fprintf(stderr, "kernel_launch: workspace too small: %zu < %zu\n", ws_size, (size_t)WS_END);
        if (n_in != 33) fprintf(stderr, "kernel_launch: expected 33 inputs, got %d\n", n_in);
    }
    hipMemsetAsync((char*)d_ws + WS_CTL, 0, 32768, stream);
    Params p{};
    for (int i = 0; i < 33; ++i) p.in[i] = (const float*)d_in[i];
    p.out = (float*)d_out; p.ws = (unsigned char*)d_ws; p.ph_lo = 0; p.ph_hi = PH_HI;
    void* args[] = {&p};
    hipError_t e = hipLaunchCooperativeKernel((const void*)mega, dim3(grid), dim3(512), args, LDS_BYTES, stream);
    if (e != hipSuccess) fprintf(stderr, "cooperative launch failed: %s (grid %d)\n", hipGetErrorString(e), grid);
}
```
